# Optimizing an MI355X kernel written in HIP

```python
import math
import jax, jax.numpy as jnp
from jax import lax
import numpy as np

D_MODEL = 1024
BATCH = 16
SEQ = 2048
DEPTH = 2

BLOCK = 128
ROPE_THETA = 500000.0
ROPE_FRACTION = 4
EPS = 1e-6
CONV_CH = 512
CONV_K = 3
DIFF_HEADS = 4
DIFF_DK = 64
DIFF_DV = 128
SWA_Q_HEADS = 16
SWA_KV_HEADS = 4
SWA_HEAD_DIM = 64
SWA_WINDOW = 128
MEM_LEN = 256
XATTN_HEADS = 4
XATTN_HEAD_DIM = 128
N_GROUPS = 4
EXPERTS_PER_GROUP = 8
N_EXPERTS = N_GROUPS * EXPERTS_PER_GROUP
TOP_K = 2
EXPERT_HIDDEN = 512

A_IN = 3 * CONV_CH
DIFF_QK = DIFF_HEADS * 2 * DIFF_DK
B_IN = 2 * DIFF_QK + DIFF_HEADS * DIFF_DV
HYB_IN = A_IN + B_IN
HYB_OUT = CONV_CH + DIFF_HEADS * DIFF_DV
SWA_QW = SWA_Q_HEADS * SWA_HEAD_DIM
SWA_KVW = SWA_KV_HEADS * SWA_HEAD_DIM
SWA_IN = SWA_QW + 2 * SWA_KVW
XATTN_W = XATTN_HEADS * XATTN_HEAD_DIM

kernel_name = "hybrid_conv_diffattn_swa_sink_xmem_hmoe"


def rmsnorm(x, g):
    xf = x.astype(jnp.float32)
    y = xf * lax.rsqrt(jnp.mean(xf * xf, axis=-1, keepdims=True) + EPS)
    return (y * g.astype(jnp.float32)).astype(x.dtype)


def rotary_tables(seq, head_dim):
    rot = head_dim // ROPE_FRACTION
    pos = jnp.arange(seq, dtype=jnp.float32)
    inv = ROPE_THETA ** (-jnp.arange(0, rot, 2, dtype=jnp.float32) / rot)
    ang = pos[:, None] * inv[None, :]
    return jnp.cos(ang), jnp.sin(ang)


def rope_partial(x, cos, sin):
    half = cos.shape[-1]
    extra = x.ndim - 3
    c = cos.reshape((cos.shape[0],) + (1,) * extra + (half,)).astype(x.dtype)
    s = sin.reshape((sin.shape[0],) + (1,) * extra + (half,)).astype(x.dtype)
    x1, x2, rest = x[..., :half], x[..., half:2 * half], x[..., 2 * half:]
    return jnp.concatenate([x1 * c - x2 * s, x2 * c + x1 * s, rest], axis=-1)


def short_conv(u, w):
    C = u.shape[-1]
    return lax.conv_general_dilated(
        u, w.astype(u.dtype)[:, None, :], window_strides=(1,), padding=[(CONV_K - 1, 0)],
        dimension_numbers=('NWC', 'WIO', 'NWC'), feature_group_count=C)


def diff_attention(q, k, v, lam):
    B, S, H, _, D = q.shape
    nb = S // BLOCK
    scale = D ** -0.5
    qb = q.reshape(B, nb, BLOCK, H, 2, D).swapaxes(0, 1)
    kpos = jnp.arange(S)

    def block(args):
        qblk, n = args
        qpos = n * BLOCK + jnp.arange(BLOCK)
        s = jnp.einsum('bqhmd,bkhmd->bhmqk', qblk, k).astype(jnp.float32) * scale
        s = jnp.where(kpos[None, :] <= qpos[:, None], s, -jnp.inf)
        p = jax.nn.softmax(s, axis=-1)
        a = p[:, :, 0] - lam * p[:, :, 1]
        return jnp.einsum('bhqk,bkhe->bqhe', a.astype(v.dtype), v)

    o = lax.map(block, (qb, jnp.arange(nb)))
    return o.swapaxes(0, 1).reshape(B, S, H, v.shape[-1])


def hybrid_mixer(h, w_in, conv_w, lam_vecs, subln_g, w_out, lambda_init, cos, sin):
    B, S, _ = h.shape
    p = h @ w_in
    a_in, b_in = p[..., :A_IN], p[..., A_IN:]
    gate_b, gate_c, u = jnp.split(a_in, 3, axis=-1)
    y_a = gate_b * short_conv(gate_c * u, conv_w)
    q = b_in[..., :DIFF_QK].reshape(B, S, DIFF_HEADS, 2, DIFF_DK)
    k = b_in[..., DIFF_QK:2 * DIFF_QK].reshape(B, S, DIFF_HEADS, 2, DIFF_DK)
    v = b_in[..., 2 * DIFF_QK:].reshape(B, S, DIFF_HEADS, DIFF_DV)
    q = rope_partial(q, cos, sin)
    k = rope_partial(k, cos, sin)
    lf = lam_vecs.astype(jnp.float32)
    lam = jnp.exp(jnp.sum(lf[0] * lf[1])) - jnp.exp(jnp.sum(lf[2] * lf[3])) + lambda_init
    o = diff_attention(q, k, v, lam)
    o = rmsnorm(o, subln_g) * (1.0 - lambda_init)
    y_b = o.reshape(B, S, DIFF_HEADS * DIFF_DV)
    return jnp.concatenate([y_a, y_b], axis=-1) @ w_out


def swa_mixer(h, w_qkv, b_qkv, sinks, w_out, b_out, cos, sin):
    B, S, _ = h.shape
    G = SWA_Q_HEADS // SWA_KV_HEADS
    nb = S // BLOCK
    p = h @ w_qkv + b_qkv
    q = p[..., :SWA_QW].reshape(B, S, SWA_Q_HEADS, SWA_HEAD_DIM)
    k = p[..., SWA_QW:SWA_QW + SWA_KVW].reshape(B, S, SWA_KV_HEADS, SWA_HEAD_DIM)
    v = p[..., SWA_QW + SWA_KVW:].reshape(B, S, SWA_KV_HEADS, SWA_HEAD_DIM)
    q = rope_partial(q, cos, sin)
    k = rope_partial(k, cos, sin)
    qb = q.reshape(B, nb, BLOCK, SWA_KV_HEADS, G, SWA_HEAD_DIM)

    def band(t):
        tb = t.reshape(B, nb, BLOCK, SWA_KV_HEADS, SWA_HEAD_DIM)
        prev = jnp.concatenate([jnp.zeros_like(tb[:, :1]), tb[:, :-1]], axis=1)
        return jnp.concatenate([prev, tb], axis=2)

    kb, vb = band(k), band(v)
    s = jnp.einsum('bnqkgd,bnskd->bnkgqs', qb, kb).astype(jnp.float32) * (SWA_HEAD_DIM ** -0.5)
    qi = jnp.arange(BLOCK)[:, None]
    si = jnp.arange(2 * BLOCK)[None, :]
    rel = si - BLOCK - qi
    in_win = (rel <= 0) & (rel > -SWA_WINDOW)
    kabs = jnp.arange(nb)[:, None, None] * BLOCK + si[None] - BLOCK
    mask = in_win[None] & (kabs >= 0)
    s = jnp.where(mask[None, :, None, None], s, -jnp.inf)
    sink = jnp.broadcast_to(sinks.astype(jnp.float32).reshape(1, 1, SWA_KV_HEADS, G, 1, 1),
                            s.shape[:-1] + (1,))
    pr = jax.nn.softmax(jnp.concatenate([s, sink], axis=-1), axis=-1)[..., :-1]
    o = jnp.einsum('bnkgqs,bnskd->bnqkgd', pr.astype(vb.dtype), vb).reshape(B, S, SWA_QW)
    return o @ w_out + b_out


def cross_attention(h, mem_k, mem_v, w_q, w_o):
    B, S, _ = h.shape
    q = (h @ w_q).reshape(B, S, XATTN_HEADS, XATTN_HEAD_DIM)
    s = jnp.einsum('bshd,bmhd->bhsm', q, mem_k).astype(jnp.float32) * (XATTN_HEAD_DIM ** -0.5)
    p = jax.nn.softmax(s, axis=-1)
    o = jnp.einsum('bhsm,bmhd->bshd', p.astype(mem_v.dtype), mem_v).reshape(B, S, XATTN_W)
    return o @ w_o


def hier_moe(h, w_group, b_group, w_router, b_router, w_gate_up, w_down):
    B, S, D = h.shape
    t = h.reshape(-1, D)
    T = t.shape[0]
    p_group = jax.nn.softmax((t @ w_group + b_group).astype(jnp.float32), axis=-1)
    g_sel = jnp.argmax(p_group, axis=-1)
    p_g = jnp.take_along_axis(p_group, g_sel[:, None], axis=1)[:, 0]
    e_logits = (t @ w_router + b_router).astype(jnp.float32).reshape(T, N_GROUPS, EXPERTS_PER_GROUP)
    e_logits = jnp.take_along_axis(e_logits, g_sel[:, None, None], axis=1)[:, 0]
    top_w, top_i = lax.top_k(jax.nn.softmax(e_logits, axis=-1), TOP_K)
    top_w = top_w / jnp.sum(top_w, axis=-1, keepdims=True) * p_g[:, None]
    expert_id = (g_sel[:, None] * EXPERTS_PER_GROUP + top_i).reshape(-1)
    flat_w = top_w.reshape(-1)
    flat_tok = jnp.repeat(jnp.arange(T), TOP_K)
    order = jnp.argsort(expert_id)
    tok_sorted = flat_tok[order]
    xs = t[tok_sorted]
    group_sizes = jnp.bincount(expert_id, length=N_EXPERTS).astype(jnp.int32)
    gu = lax.ragged_dot(xs, w_gate_up, group_sizes)
    hid = jax.nn.silu(gu[:, :EXPERT_HIDDEN]) * gu[:, EXPERT_HIDDEN:]
    y = lax.ragged_dot(hid, w_down, group_sizes) * flat_w[order][:, None].astype(hid.dtype)
    out = jax.ops.segment_sum(y, tok_sorted, num_segments=T)
    return out.reshape(B, S, D)


def setup_inputs(seed: int = 0) -> dict:
    key = jax.random.key(seed)
    ks = iter(jax.random.split(key, 32))
    n_even = (DEPTH + 1) // 2
    n_odd = DEPTH // 2
    f32 = jnp.float32

    def nrm(shape, scale):
        return jax.random.normal(next(ks), shape, f32) * scale

    def gain(shape):
        return 1.0 + 0.05 * jax.random.normal(next(ks), shape, f32)

    D = D_MODEL
    return {
        "x": nrm((BATCH, SEQ, D), 1.0),
        "mem": nrm((BATCH, MEM_LEN, D), 1.0),
        "mem_norm": gain((D,)),
        "mem_w_kv": nrm((D, 2 * XATTN_W), D ** -0.5),
        "norm_mix": gain((DEPTH, D)),
        "norm_xattn": gain((DEPTH, D)),
        "norm_ffn": gain((DEPTH, D)),
        "hyb_w_in": nrm((n_even, D, HYB_IN), D ** -0.5),
        "hyb_conv_w": nrm((n_even, CONV_K, CONV_CH), CONV_K ** -0.5),
        "diff_lambda": nrm((n_even, 4, DIFF_DK), 0.1),
        "diff_subln": gain((n_even, DIFF_DV)),
        "hyb_w_out": nrm((n_even, HYB_OUT, D), HYB_OUT ** -0.5),
        "swa_w_qkv": nrm((n_odd, D, SWA_IN), D ** -0.5),
        "swa_b_qkv": nrm((n_odd, SWA_IN), 0.02),
        "swa_sinks": nrm((n_odd, SWA_Q_HEADS), 0.5),
        "swa_w_out": nrm((n_odd, SWA_QW, D), SWA_QW ** -0.5),
        "swa_b_out": nrm((n_odd, D), 0.02),
        "xattn_w_q": nrm((DEPTH, D, XATTN_W), D ** -0.5),
        "xattn_w_o": nrm((DEPTH, XATTN_W, D), XATTN_W ** -0.5),
        "moe_w_group": nrm((DEPTH, D, N_GROUPS), D ** -0.5),
        "moe_b_group": nrm((DEPTH, N_GROUPS), 0.01),
        "moe_w_router": nrm((DEPTH, D, N_EXPERTS), D ** -0.5),
        "moe_b_router": nrm((DEPTH, N_EXPERTS), 0.01),
        "moe_w_gate_up": nrm((DEPTH, N_EXPERTS, D, 2 * EXPERT_HIDDEN), D ** -0.5),
        "moe_w_down": nrm((DEPTH, N_EXPERTS, EXPERT_HIDDEN, D), EXPERT_HIDDEN ** -0.5),
        "final_norm": gain((D,)),
    }


def reference(x, mem, mem_norm, mem_w_kv, norm_mix, norm_xattn, norm_ffn,
              hyb_w_in, hyb_conv_w, diff_lambda, diff_subln, hyb_w_out,
              swa_w_qkv, swa_b_qkv, swa_sinks, swa_w_out, swa_b_out,
              xattn_w_q, xattn_w_o, moe_w_group, moe_b_group, moe_w_router, moe_b_router,
              moe_w_gate_up, moe_w_down, final_norm):
    B, S, _ = x.shape
    M = mem.shape[1]
    mkv = rmsnorm(mem, mem_norm) @ mem_w_kv
    mem_k = mkv[..., :XATTN_W].reshape(B, M, XATTN_HEADS, XATTN_HEAD_DIM)
    mem_v = mkv[..., XATTN_W:].reshape(B, M, XATTN_HEADS, XATTN_HEAD_DIM)
    cos_d, sin_d = rotary_tables(S, DIFF_DK)
    cos_s, sin_s = rotary_tables(S, SWA_HEAD_DIM)
    for l in range(DEPTH):
        h = rmsnorm(x, norm_mix[l])
        if l % 2 == 0:
            e = l // 2
            lambda_init = 0.8 - 0.6 * math.exp(-0.3 * l)
            x = x + hybrid_mixer(h, hyb_w_in[e], hyb_conv_w[e], diff_lambda[e], diff_subln[e],
                                 hyb_w_out[e], lambda_init, cos_d, sin_d)
        else:
            o = l // 2
            x = x + swa_mixer(h, swa_w_qkv[o], swa_b_qkv[o], swa_sinks[o], swa_w_out[o],
                              swa_b_out[o], cos_s, sin_s)
        x = x + cross_attention(rmsnorm(x, norm_xattn[l]), mem_k, mem_v, xattn_w_q[l], xattn_w_o[l])
        x = x + hier_moe(rmsnorm(x, norm_ffn[l]), moe_w_group[l], moe_b_group[l], moe_w_router[l],
                         moe_b_router[l], moe_w_gate_up[l], moe_w_down[l])
    return rmsnorm(x, final_norm)
```

```cpp
#include <hip/hip_runtime.h>
#include <cstdio>
#include <cstdint>
#include <cmath>
namespace pg8 {
#define PG8_LAS __attribute__((address_space(3)))
typedef unsigned short bf16_t;
typedef short bf16x8 __attribute__((ext_vector_type(8)));
typedef float f32x4 __attribute__((ext_vector_type(4)));
typedef unsigned u32x4 __attribute__((ext_vector_type(4)));
constexpr int BM = 256, BK = 64, HALF = 128, HTB = HALF * BK * 2  , STAGE_BYTES = 8 * HTB, NXCD = 8, WGM = 8;

__host__ __device__ __forceinline__ int lds_byte(int r, int c) { const int st = (r >> 4) * 2 + (c >> 5), rr = r & 15, cc = c & 31, ob = rr * 64 + cc * 2; return st * 1024 + (ob ^ (((ob >> 9) & 1) << 5)); }
__host__ __device__ __forceinline__ void stage_rc(int b, int& R, int& C) { const int st = b / 1024, sb = b % 1024, swz = sb ^ (((sb >> 9) & 1) << 5); R = (st >> 1) * 16 + swz / 64; C = (st & 1) * 32 + (swz % 64) / 2; }
__host__ __device__ __forceinline__ int perm32(int rho) { const int n = rho >> 4, i = rho & 15; return 8 * (i >> 2) + 4 * n + (i & 3); }

struct Unit { int pm, pn, brow; };
struct Gemm { const bf16_t* A; const bf16_t* Bt; int M, N, K, pad; };

struct StaticOrder {
    int nM, nN, nwg, G, c;
    __host__ __device__ void init(int M, int N, int G_, int c_) { nM = M / BM; nN = N / BM; nwg = nM * nN; G = G_; c = c_; }
    __host__ __device__ bool next(int i, Unit& u) const {
        const long L = (long)i * G + c; if (L >= nwg) return false;
        int wgid = (int)L; { const int q = nwg / NXCD, r = nwg % NXCD, xcd = wgid % NXCD, off = wgid / NXCD; wgid = (xcd < r ? xcd * (q + 1) : r * (q + 1) + (xcd - r) * q) + off; }
        const int nig = WGM * nN, gid = wgid / nig, fm = gid * WGM, gsz = (nM - fm) < WGM ? (nM - fm) : WGM;
        u.pm = fm + ((wgid % nig) % gsz); u.pn = (wgid % nig) / gsz; u.brow = 0; return true;
    }
    __device__ __forceinline__ void a_ready(const Unit&) const {}
    __device__ __forceinline__ void done(const Unit&) const {}
};

__device__ __forceinline__ unsigned cvt_pk_bf16(float lo, float hi) { unsigned r; asm volatile("v_cvt_pk_bf16_f32 %0, %1, %2" : "=v"(r) : "v"(lo), "v"(hi)); return r; }
template <class Epi, class Sched, bool ALIGN_EPI = false, bool SP2 = false>
__device__ __forceinline__ void gemm_phase(PG8_LAS unsigned char* lds, const Gemm g, const Sched& S, const Epi& E) {
    const int tid = threadIdx.x, wid = __builtin_amdgcn_readfirstlane(tid >> 6), lane = tid & 63, wr = wid >> 2, wc = wid & 3, fr = lane & 15, fq = lane >> 4;
    const int K = g.K, nt = K / BK;
    unsigned voffA[2], voffB[2];
#pragma unroll
    for (int i = 0; i < 2; ++i) { int R, C; stage_rc(tid * 16 + i * 8192, R, C); const int Rb = Epi::PERM ? ((R & ~31) + perm32(R & 31)) : R;
        voffA[i] = (unsigned)(R * K + C) * 2u; voffB[i] = (unsigned)(Rb * K + C) * 2u; }
    const size_t kstep = (size_t)(BK * 2);
    const size_t hstep = (size_t)HALF * K * 2;
    const size_t tstep = 2 * hstep;
    const unsigned ldsw = (unsigned)wid * 1024u;
    const int aoff = lds_byte(wr * 64 + fr, fq * 8), boff = lds_byte(wc * 32 + fr, fq * 8);
#define PG8_SA(b, h) (((b) * 2 + (h)) * HTB)
#define PG8_SB(b, h) ((4 + (b) * 2 + (h)) * HTB)
#define PG8_STAGE(bufoff, gbase, voff) do { _Pragma("unroll") for (int _i = 0; _i < 2; ++_i) \
        __builtin_amdgcn_global_load_lds((const unsigned*)((const char*)(gbase) + (voff)[_i]), (PG8_LAS unsigned*)(lds + (bufoff) + ldsw + _i * 8192), 16, 0, 0); } while (0)
#define PG8_LDA(dst, b, h) do { _Pragma("unroll") for (int m = 0; m < 4; ++m) _Pragma("unroll") for (int k = 0; k < 2; ++k) dst[m][k] = *(const PG8_LAS bf16x8*)(lds + PG8_SA(b, h) + aoff + m * 2048 + k * 1024); } while (0)
#define PG8_LDB(dst, b, h) do { _Pragma("unroll") for (int n = 0; n < 2; ++n) _Pragma("unroll") for (int k = 0; k < 2; ++k) dst[n][k] = *(const PG8_LAS bf16x8*)(lds + PG8_SB(b, h) + boff + n * 2048 + k * 1024); } while (0)
#define PG8_MMA(ai, bj, At, Bt) do { __builtin_amdgcn_s_setprio(1); _Pragma("unroll") for (int m = 0; m < 4; ++m) _Pragma("unroll") for (int n = 0; n < 2; ++n) _Pragma("unroll") for (int k = 0; k < 2; ++k) \
        acc[ai][bj][m][n] = __builtin_amdgcn_mfma_f32_16x16x32_bf16(Bt[n][k], At[m][k], acc[ai][bj][m][n], 0, 0, 0); __builtin_amdgcn_s_setprio(0); } while (0)
#define PG8_WAIT_V(n) asm volatile("s_waitcnt vmcnt(" #n ")" ::: "memory")
#define PG8_WAIT_L(n) asm volatile("s_waitcnt lgkmcnt(" #n ")" ::: "memory")
#define PG8_BAR __builtin_amdgcn_s_barrier()
#define PG8_SCHED __builtin_amdgcn_sched_barrier(0)
    Unit cur, nxt; int ui = 0;
    if (!S.next(0, cur)) return;
    f32x4 acc[2][2][4][2];
#pragma unroll
    for (int a = 0; a < 2; ++a)
#pragma unroll
        for (int b = 0; b < 2; ++b)
#pragma unroll
            for (int m = 0; m < 4; ++m)
#pragma unroll
                for (int n = 0; n < 2; ++n) acc[a][b][m][n] = (f32x4){0.f, 0.f, 0.f, 0.f};
    bf16x8 At[4][2], B0[2][2], B1[2][2];
    const char* cA = (const char*)g.A + (size_t)cur.pm * tstep; const char* cB = (const char*)g.Bt + (size_t)(cur.brow + cur.pn) * tstep;
    S.a_ready(cur);
    if constexpr (SP2) {
        PG8_STAGE(PG8_SB(0, 0), cB, voffB); PG8_STAGE(PG8_SB(0, 1), cB + hstep, voffB); PG8_STAGE(PG8_SA(0, 0), cA, voffA); PG8_STAGE(PG8_SA(0, 1), cA + hstep, voffA);
        if (wr == 1) PG8_BAR;
        PG8_WAIT_V(2); PG8_BAR;
        PG8_STAGE(PG8_SB(1, 0), cB + kstep, voffB); PG8_STAGE(PG8_SA(1, 0), cA + kstep, voffA); PG8_STAGE(PG8_SB(1, 1), cB + hstep + kstep, voffB);
        PG8_WAIT_V(6); PG8_BAR;
    } else {
        PG8_STAGE(PG8_SB(0, 0), cB, voffB); PG8_STAGE(PG8_SA(0, 0), cA, voffA); PG8_STAGE(PG8_SB(0, 1), cB + hstep, voffB); PG8_STAGE(PG8_SA(0, 1), cA + hstep, voffA);
        if (wr == 1) PG8_BAR;
        PG8_WAIT_V(4); PG8_BAR;
        PG8_STAGE(PG8_SB(1, 0), cB + kstep, voffB); PG8_STAGE(PG8_SA(1, 0), cA + kstep, voffA); PG8_STAGE(PG8_SB(1, 1), cB + hstep + kstep, voffB);
        PG8_WAIT_V(6); PG8_BAR;
    }
    for (;;) {
        const bool has_next = S.next(ui + 1, nxt);
        const char* nA = has_next ? (const char*)g.A + (size_t)nxt.pm * tstep : cA; const char* nB = has_next ? (const char*)g.Bt + (size_t)(nxt.brow + nxt.pn) * tstep : cB;
        for (int t = 0; t < nt; t += 2) {
            const bool last = (t == nt - 2);
            const char* a1 = cA + (size_t)(t + 1) * kstep;
            const char* a2 = last ? nA : cA + (size_t)(t + 2) * kstep; const char* b2 = last ? nB : cB + (size_t)(t + 2) * kstep;
            const char* a3 = a2 + kstep; const char* b3 = b2 + kstep;
            if (last && has_next) S.a_ready(nxt);
            if constexpr (SP2) {
            PG8_LDB(B0, 0, 0); PG8_LDB(B1, 0, 1); PG8_SCHED; PG8_LDA(At, 0, 0); PG8_STAGE(PG8_SA(1, 1), a1 + hstep, voffA);
            PG8_WAIT_V(8); PG8_WAIT_L(0); PG8_BAR; PG8_MMA(0, 0, At, B0); PG8_MMA(0, 1, At, B1); PG8_BAR; PG8_SCHED;
            PG8_LDA(At, 0, 1); PG8_STAGE(PG8_SB(0, 0), b2, voffB); PG8_STAGE(PG8_SB(0, 1), b2 + hstep, voffB); PG8_STAGE(PG8_SA(0, 0), a2, voffA);
            PG8_WAIT_V(8); PG8_WAIT_L(0); PG8_BAR; PG8_MMA(1, 0, At, B0); PG8_MMA(1, 1, At, B1); PG8_BAR; PG8_SCHED;
            PG8_LDB(B0, 1, 0); PG8_LDB(B1, 1, 1); PG8_SCHED; PG8_LDA(At, 1, 0); PG8_STAGE(PG8_SA(0, 1), a2 + hstep, voffA);
            PG8_WAIT_V(8); PG8_WAIT_L(0); PG8_BAR; PG8_MMA(0, 0, At, B0); PG8_MMA(0, 1, At, B1); PG8_BAR; PG8_SCHED;
            PG8_LDA(At, 1, 1); PG8_STAGE(PG8_SB(1, 0), b3, voffB); PG8_STAGE(PG8_SB(1, 1), b3 + hstep, voffB); PG8_STAGE(PG8_SA(1, 0), a3, voffA);
            PG8_WAIT_V(8); PG8_WAIT_L(0); PG8_BAR; PG8_MMA(1, 0, At, B0); PG8_MMA(1, 1, At, B1); PG8_BAR; PG8_SCHED;
            } else {
            PG8_LDB(B0, 0, 0); PG8_SCHED; PG8_LDA(At, 0, 0); PG8_STAGE(PG8_SA(1, 1), a1 + hstep, voffA);
            PG8_WAIT_L(8); PG8_BAR; PG8_WAIT_L(0); PG8_MMA(0, 0, At, B0); PG8_BAR; PG8_SCHED;
            PG8_LDB(B1, 0, 1); PG8_STAGE(PG8_SB(0, 0), b2, voffB);
            PG8_BAR; PG8_WAIT_L(0); PG8_MMA(0, 1, At, B1); PG8_BAR;
            PG8_LDA(At, 0, 1); PG8_STAGE(PG8_SA(0, 0), a2, voffA);
            PG8_BAR; PG8_WAIT_L(0); PG8_MMA(1, 0, At, B0); PG8_BAR; PG8_SCHED;
            PG8_STAGE(PG8_SB(0, 1), b2 + hstep, voffB);
            PG8_WAIT_V(6); PG8_BAR; PG8_MMA(1, 1, At, B1); PG8_BAR;
            PG8_LDB(B0, 1, 0); PG8_SCHED; PG8_LDA(At, 1, 0); PG8_STAGE(PG8_SA(0, 1), a2 + hstep, voffA);
            PG8_WAIT_L(8); PG8_BAR; PG8_WAIT_L(0); PG8_MMA(0, 0, At, B0); PG8_BAR; PG8_SCHED;
            PG8_LDB(B1, 1, 1); PG8_STAGE(PG8_SB(1, 0), b3, voffB);
            PG8_BAR; PG8_WAIT_L(0); PG8_MMA(0, 1, At, B1); PG8_BAR;
            PG8_LDA(At, 1, 1); PG8_STAGE(PG8_SA(1, 0), a3, voffA);
            PG8_BAR; PG8_WAIT_L(0); PG8_MMA(1, 0, At, B0); PG8_BAR; PG8_SCHED;
            PG8_STAGE(PG8_SB(1, 1), b3 + hstep, voffB);
            PG8_WAIT_V(6); PG8_BAR; PG8_MMA(1, 1, At, B1); PG8_BAR;
            }
        }
        if constexpr (ALIGN_EPI) { if (wr == 0) PG8_BAR; }
        if constexpr (!Epi::AFTER_DRAIN) { E(acc, cur, wr, wc, fr, fq); S.done(cur); }
        if (!has_next) break;
#pragma unroll
        for (int a = 0; a < 2; ++a)
#pragma unroll
            for (int b = 0; b < 2; ++b)
#pragma unroll
                for (int m = 0; m < 4; ++m)
#pragma unroll
                    for (int n = 0; n < 2; ++n) acc[a][b][m][n] = (f32x4){0.f, 0.f, 0.f, 0.f};
        cur = nxt; cA = nA; cB = nB; ++ui;
        if constexpr (ALIGN_EPI) { if (wr == 1) PG8_BAR; }
    }
    PG8_WAIT_V(0);
    if constexpr (!ALIGN_EPI) { if (wr == 0) PG8_BAR; }
    PG8_BAR;
    if constexpr (Epi::AFTER_DRAIN) { E.fused(acc, cur, wr, wc, fr, fq, lds, wid, lane); S.done(cur); }
#undef PG8_SA
#undef PG8_SB
#undef PG8_STAGE
#undef PG8_LDA
#undef PG8_LDB
#undef PG8_MMA
#undef PG8_WAIT_V
#undef PG8_WAIT_L
#undef PG8_BAR
#undef PG8_SCHED
}
}

using pg8::bf16_t; using pg8::f32x4; using pg8::u32x4; using pg8::Unit;
constexpr int T_TOK = 32768, DM = 1024, SEQ = 2048, NBATCH = 16, MEML = 256, TMEM = 4096, SPAD = 81920;
constexpr float EPS = 1e-6f;
constexpr float LOG2E = 1.4426950408889634f;
constexpr size_t MiB = 1u << 20;
constexpr size_t WS_CTL = 0, CTL_ZERO_BYTES = 64 * 1024;
constexpr size_t WS_ROPEC = 1 * MiB, WS_ROPES = 1 * MiB + 64 * 1024, WS_WR = 1 * MiB + 128 * 1024  , WS_LAM = 1 * MiB + 512 * 1024;
constexpr size_t WS_SSQ = 2 * MiB, WS_SSQM = 4 * MiB;
constexpr size_t WS_TOKSLOT = 5 * MiB, WS_WSLOT = 5 * MiB + 512 * 1024, WS_RSSLOT = 6 * MiB;
constexpr size_t WS_ROUTE_E = 7 * MiB, WS_ROUTE_W = 7 * MiB + 512 * 1024, WS_RSTOK = 8 * MiB;
constexpr size_t WS_MEMB = 10 * MiB, WS_MKV = 18 * MiB;
constexpr size_t WS_WMEM = 26 * MiB, WS_WIN = 28 * MiB, WS_WOUT0 = 34 * MiB, WS_WQKV = 36 * MiB, WS_WOUT1 = 39 * MiB, WS_WQ = 41 * MiB, WS_WO = 43 * MiB,
                 WS_WGU = 45 * MiB, WS_WDN = 173 * MiB;
constexpr size_t WS_XA = 240 * MiB, WS_XBF = 368 * MiB, WS_Y = 432 * MiB, WS_QX = 496 * MiB, WS_OX = 528 * MiB, WS_U1 = 560 * MiB, WS_U2 = 752 * MiB, WS_END = 880 * MiB;
constexpr int CI_CNT = 0, CI_CUR = 64, CI_LBASE = 128, CI_NT = 192, CI_TEXP = 256, CI_STRIDE = 1024;

__device__ __forceinline__ unsigned f2bf(float f) { unsigned u = __builtin_bit_cast(unsigned, f); return (u + 0x7fffu + ((u >> 16) & 1u)) >> 16; }
__device__ __forceinline__ unsigned pk2(float lo, float hi) { return f2bf(lo) | (f2bf(hi) << 16); }
__device__ __forceinline__ float bflo(unsigned w) { return __builtin_bit_cast(float, w << 16); }
__device__ __forceinline__ float bfhi(unsigned w) { return __builtin_bit_cast(float, w & 0xffff0000u); }
__device__ __forceinline__ float bf2f(bf16_t h) { return __builtin_bit_cast(float, (unsigned)h << 16); }
__device__ __forceinline__ float wave_sum(float v) {
#pragma unroll
    for (int o = 1; o < 64; o <<= 1) v += __shfl_xor(v, o);
    return v;
}
__device__ __forceinline__ float row_rs(const float* ssq, int row) {
    const f32x4* p = (const f32x4*)(ssq + (size_t)row * 16);
    const f32x4 a = p[0], b = p[1], c = p[2], d = p[3];
    const float s = (((a.x + a.y) + (a.z + a.w)) + ((b.x + b.y) + (b.z + b.w))) + (((c.x + c.y) + (c.z + c.w)) + ((d.x + d.y) + (d.z + d.w)));
    return 1.0f / sqrtf(s * (1.0f / 1024.0f) + EPS);
}

struct EpiProj {
    static constexpr bool PERM = true, AFTER_DRAIN = false;
    bf16_t* O; const float* ssq; const float* bias; const float* ropeC; const float* ropeS; int ldc, rope_lo, rope_hi, pad;
    __device__ __forceinline__ void operator()(const f32x4 (&acc)[2][2][4][2], const Unit& u, int wr, int wc, int fr, int fq) const {
        const int row0 = u.pm * 256 + wr * 64 + fr;
#pragma unroll
        for (int ai = 0; ai < 2; ++ai)
#pragma unroll
            for (int m = 0; m < 4; ++m) {
                const int row = row0 + ai * 128 + m * 16;
                const float rs = row_rs(ssq, row);
                const int pos = row & (SEQ - 1);
#pragma unroll
                for (int bj = 0; bj < 2; ++bj) {
                    const int col = u.pn * 256 + bj * 128 + wc * 32 + 8 * fq;
                    float v[8], pv[8];
#pragma unroll
                    for (int i = 0; i < 8; ++i) v[i] = acc[ai][bj][m][i >> 2][i & 3] * rs;
                    if (bias) {
                        const f32x4 b0 = *(const f32x4*)(bias + col), b1 = *(const f32x4*)(bias + col + 4);
#pragma unroll
                        for (int i = 0; i < 4; ++i) { v[i] += b0[i]; v[4 + i] += b1[i]; }
                    }
#pragma unroll
                    for (int i = 0; i < 8; ++i) pv[i] = __shfl_xor(v[i], 16);
                    if (col >= rope_lo && col < rope_hi && (col & 63) < 16) {
                        const f32x4 c0 = *(const f32x4*)(ropeC + pos * 8), c1 = *(const f32x4*)(ropeC + pos * 8 + 4);
                        const f32x4 s0 = *(const f32x4*)(ropeS + pos * 8), s1 = *(const f32x4*)(ropeS + pos * 8 + 4);
                        const float sg = (col & 8) ? 1.0f : -1.0f;
#pragma unroll
                        for (int i = 0; i < 4; ++i) { v[i] = v[i] * c0[i] + sg * pv[i] * s0[i]; v[4 + i] = v[4 + i] * c1[i] + sg * pv[4 + i] * s1[i]; }
                    }
                    u32x4 w; w.x = pk2(v[0], v[1]); w.y = pk2(v[2], v[3]); w.z = pk2(v[4], v[5]); w.w = pk2(v[6], v[7]);
                    *(u32x4*)(O + (size_t)row * ldc + col) = w;
                }
            }
    }
};
struct EpiResid {
    static constexpr bool PERM = true, AFTER_DRAIN = false;
    const float* xin; float* xout; bf16_t* xb; float* ssq; const float* bias;
    __device__ __forceinline__ void operator()(const f32x4 (&acc)[2][2][4][2], const Unit& u, int wr, int wc, int fr, int fq) const {
        const int row0 = u.pm * 256 + wr * 64 + fr;
#pragma unroll
        for (int ai = 0; ai < 2; ++ai)
#pragma unroll
            for (int m = 0; m < 4; ++m) {
                const int row = row0 + ai * 128 + m * 16;
                float ss = 0.f;
#pragma unroll
                for (int bj = 0; bj < 2; ++bj) {
                    const int col = u.pn * 256 + bj * 128 + wc * 32 + 8 * fq;
                    const size_t off = (size_t)row * DM + col;
                    f32x4 x0 = *(const f32x4*)(xin + off), x1 = *(const f32x4*)(xin + off + 4);
                    x0 += acc[ai][bj][m][0]; x1 += acc[ai][bj][m][1];
                    if (bias) { x0 += *(const f32x4*)(bias + col); x1 += *(const f32x4*)(bias + col + 4); }
                    *(f32x4*)(xout + off) = x0; *(f32x4*)(xout + off + 4) = x1;
                    u32x4 w; w.x = pk2(x0[0], x0[1]); w.y = pk2(x0[2], x0[3]); w.z = pk2(x1[0], x1[1]); w.w = pk2(x1[2], x1[3]);
                    *(u32x4*)(xb + off) = w;
                    ss += (x0[0] * x0[0] + x0[1] * x0[1]) + (x0[2] * x0[2] + x0[3] * x0[3]) + (x1[0] * x1[0] + x1[1] * x1[1]) + (x1[2] * x1[2] + x1[3] * x1[3]);
                }
                ss += __shfl_xor(ss, 16); ss += __shfl_xor(ss, 32);
                if (fq == 0) ssq[(size_t)row * 16 + u.pn * 4 + wc] = ss;
            }
    }
};
struct EpiGateUp {
    static constexpr bool PERM = true, AFTER_DRAIN = false;
    bf16_t* hid; const float* rs_slot;
    __device__ __forceinline__ void operator()(const f32x4 (&acc)[2][2][4][2], const Unit& u, int wr, int wc, int fr, int fq) const {
        const int row0 = u.pm * 256 + wr * 64 + fr;
#pragma unroll
        for (int ai = 0; ai < 2; ++ai)
#pragma unroll
            for (int m = 0; m < 4; ++m) {
                const int row = row0 + ai * 128 + m * 16;
                const float rs = rs_slot[row];
                float h[8];
#pragma unroll
                for (int i = 0; i < 8; ++i) { const float g = acc[ai][0][m][i >> 2][i & 3] * rs, up = acc[ai][1][m][i >> 2][i & 3] * rs; h[i] = g / (1.0f + __expf(-g)) * up; }
                u32x4 w; w.x = pk2(h[0], h[1]); w.y = pk2(h[2], h[3]); w.z = pk2(h[4], h[5]); w.w = pk2(h[6], h[7]);
                *(u32x4*)(hid + (size_t)row * 512 + u.pn * 128 + wc * 32 + 8 * fq) = w;
            }
    }
};
struct EpiDown {
    static constexpr bool PERM = true, AFTER_DRAIN = false;
    float* x; bf16_t* xb; float* ssq; const int* tok_of_slot; const float* w_of_slot; int last, pad;
    __device__ __forceinline__ void operator()(const f32x4 (&acc)[2][2][4][2], const Unit& u, int wr, int wc, int fr, int fq) const {
        const int row0 = u.pm * 256 + wr * 64 + fr;
#pragma unroll
        for (int ai = 0; ai < 2; ++ai)
#pragma unroll
            for (int m = 0; m < 4; ++m) {
                const int slot = row0 + ai * 128 + m * 16;
                const int tok = tok_of_slot[slot];
                const float wt = w_of_slot[slot];
                float ss = 0.f;
                if (tok >= 0) {
#pragma unroll
                    for (int bj = 0; bj < 2; ++bj) {
                        const int col = u.pn * 256 + bj * 128 + wc * 32 + 8 * fq;
                        const size_t off = (size_t)tok * DM + col;
                        f32x4 x0 = *(const f32x4*)(x + off), x1 = *(const f32x4*)(x + off + 4);
                        x0 += acc[ai][bj][m][0] * wt; x1 += acc[ai][bj][m][1] * wt;
                        *(f32x4*)(x + off) = x0; *(f32x4*)(x + off + 4) = x1;
                        if (last) {
                            u32x4 w; w.x = pk2(x0[0], x0[1]); w.y = pk2(x0[2], x0[3]); w.z = pk2(x1[0], x1[1]); w.w = pk2(x1[2], x1[3]);
                            *(u32x4*)(xb + off) = w;
                            ss += (x0[0] * x0[0] + x0[1] * x0[1]) + (x0[2] * x0[2] + x0[3] * x0[3]) + (x1[0] * x1[0] + x1[1] * x1[1]) + (x1[2] * x1[2] + x1[3] * x1[3]);
                        }
                    }
                }
                ss += __shfl_xor(ss, 16); ss += __shfl_xor(ss, 32);
                if (last && tok >= 0 && fq == 0) ssq[(size_t)tok * 16 + u.pn * 4 + wc] = ss;
            }
    }
};

struct GroupedOrder {
    const int* tile_expert; int t_lo, t_hi, nN, G, c, tiles_per_expert;
    __device__ __forceinline__ bool next(int i, Unit& u) const {
        const long L = (long)i * G + c; const long n = (long)(t_hi - t_lo) * nN; if (L >= n) return false;
        u.pm = t_lo + (int)(L / nN); u.pn = (int)(L % nN); u.brow = tile_expert[u.pm] * tiles_per_expert; return true;
    }
    __device__ __forceinline__ void a_ready(const Unit&) const {}
    __device__ __forceinline__ void done(const Unit&) const {}
};

template <class Epi>
__global__ void __launch_bounds__(512, 2) k_gemm(pg8::Gemm g, Epi E) {
    extern __shared__ __attribute__((aligned(16))) unsigned char lds[];
    pg8::StaticOrder S; S.init(g.M, g.N, (int)gridDim.x, (int)blockIdx.x);
    pg8::gemm_phase<Epi, pg8::StaticOrder, true, true>((PG8_LAS unsigned char*)lds, g, S, E);
}
template <class Epi>
__global__ void __launch_bounds__(512, 2) k_gemm_grouped(pg8::Gemm g, Epi E, const int* ctl  , int pass  ) {
    extern __shared__ __attribute__((aligned(16))) unsigned char lds[];
    GroupedOrder S; S.tile_expert = ctl + CI_TEXP; S.nN = g.N / 256; S.G = (int)gridDim.x; S.c = (int)blockIdx.x; S.tiles_per_expert = 4;
    const int nt0 = ctl[CI_NT], nt1 = ctl[CI_NT + 1];
    S.t_lo = (pass == 1) ? nt0 : 0; S.t_hi = (pass == 0) ? nt0 : nt1;
    pg8::gemm_phase<Epi, GroupedOrder, true, true>((PG8_LAS unsigned char*)lds, g, S, E);
}

struct WtJob { const float* src; bf16_t* dst; const float* gain; long sstride, dstride; int K, N, perm, pad; };
__global__ void __launch_bounds__(256) k_wt(WtJob j) {
    __shared__ float tile[64][65];
    const int n0 = blockIdx.x * 64, k0 = blockIdx.y * 64, b = blockIdx.z;
    const float* s = j.src + (size_t)b * j.sstride; bf16_t* d = j.dst + (size_t)b * j.dstride;
    const int tx = threadIdx.x & 63, ty = threadIdx.x >> 6;
    for (int i = ty; i < 64; i += 4) { const int k = k0 + i; const float g = j.gain ? j.gain[k] : 1.0f; tile[i][tx] = s[(size_t)k * j.N + n0 + tx] * g; }
    __syncthreads();
    for (int c = threadIdx.x; c < 512; c += 256) {
        const int n = c >> 3, ch = c & 7;
        u32x4 w; w.x = pk2(tile[ch * 8 + 0][n], tile[ch * 8 + 1][n]); w.y = pk2(tile[ch * 8 + 2][n], tile[ch * 8 + 3][n]);
        w.z = pk2(tile[ch * 8 + 4][n], tile[ch * 8 + 5][n]); w.w = pk2(tile[ch * 8 + 6][n], tile[ch * 8 + 7][n]);
        const int ns = n0 + n; int nd = ns;
        if (j.perm) { const int half = ns >> 9, jj = ns & 511; nd = (jj >> 7) * 256 + half * 128 + (jj & 127); }
        *(u32x4*)(d + (size_t)nd * j.K + k0 + ch * 8) = w;
    }
}
__global__ void __launch_bounds__(256) k_rowprep(const float* x, bf16_t* xb, float* ssq, int rows) {
    const int lane = threadIdx.x & 63, nw = gridDim.x * 4;
    for (int row = blockIdx.x * 4 + (threadIdx.x >> 6); row < rows; row += nw) {
        const f32x4* xr = (const f32x4*)(x + (size_t)row * DM) + lane; float s = 0.f;
        unsigned long long* o8 = (unsigned long long*)(xb + (size_t)row * DM) + lane;
#pragma unroll
        for (int jx = 0; jx < 4; ++jx) { const f32x4 v = xr[64 * jx]; s += (v.x * v.x + v.y * v.y) + (v.z * v.z + v.w * v.w);
            o8[64 * jx] = (unsigned long long)pk2(v.x, v.y) | ((unsigned long long)pk2(v.z, v.w) << 32); }
        s = wave_sum(s);
        if (lane < 16) ssq[(size_t)row * 16 + lane] = (lane == 0) ? s : 0.f;
    }
}
struct MiscArgs { double inv[8]; const float* norm_ffn; const float* w_group; const float* w_router; const float* lam; float* ropeC; float* ropeS; float* WR; float* lam_out; };
__device__ __forceinline__ void sincos_d(double a, float& c, float& s) {
    const double TWO_PI = 6.283185307179586476925286766559;
    const double n = __builtin_rint(a / TWO_PI); const double r = a - n * TWO_PI;
    const double r2 = r * r;
    double sp = 1.0, cp = 1.0;
#pragma unroll
    for (int k = 15; k >= 1; --k) { sp = 1.0 - r2 / (double)((2 * k) * (2 * k + 1)) * sp; cp = 1.0 - r2 / (double)((2 * k - 1) * (2 * k)) * cp; }
    s = (float)(r * sp); c = (float)cp;
}
__global__ void __launch_bounds__(256) k_misc(MiscArgs a) {
    const int gid = blockIdx.x * 256 + threadIdx.x, nth = gridDim.x * 256;
    for (int i = gid; i < SEQ * 8; i += nth) { const int pos = i >> 3, jx = i & 7; float c, s; sincos_d((double)pos * a.inv[jx], c, s); a.ropeC[i] = c; a.ropeS[i] = s; }
    for (int i = gid; i < 2 * 1024 * 36; i += nth) { const int l = i / (1024 * 36), r = i % (1024 * 36), k = r / 36, c = r % 36;
        const float g = a.norm_ffn[l * 1024 + k];
        a.WR[i] = g * (c < 4 ? a.w_group[(size_t)(l * 1024 + k) * 4 + c] : a.w_router[(size_t)(l * 1024 + k) * 32 + (c - 4)]); }
    if (gid == 0) { float s01 = 0.f, s23 = 0.f; for (int d = 0; d < 64; ++d) { s01 += a.lam[d] * a.lam[64 + d]; s23 += a.lam[128 + d] * a.lam[192 + d]; }
        a.lam_out[0] = expf(s01) - expf(s23) + 0.2f; }
}

struct AttnArgs { const bf16_t* Q; const bf16_t* K; const bf16_t* V; void* O; const float* sinks; int qpitch, kpitch; };
template <int DK, int DV, int MODE, int KT>
__global__ void __launch_bounds__(256) k_attn_simple(AttnArgs a) {
    __shared__ __attribute__((aligned(16))) float Ks[KT * DK];
    __shared__ __attribute__((aligned(16))) float Vs[KT * DV];
    const int tid = threadIdx.x, qb = blockIdx.x, hh = blockIdx.y, b = blockIdx.z;
    const int t = qb * 256 + tid; const size_t tok = (size_t)b * SEQ + t;
    int qoff, koff, voff, ooff; size_t krow0; float m_run = -INFINITY, l = 0.f;
    int lo, hi, kbeg, kend;
    if (MODE == 0) { const int h = hh >> 1, mm = hh & 1; qoff = 1536 + h * 128 + mm * 64; koff = 2048 + h * 128 + mm * 64; voff = 2560 + h * 128; ooff = hh * 128; krow0 = (size_t)b * SEQ;
        lo = 0; hi = t; kbeg = 0; kend = qb * 256 + 255; }
    else if (MODE == 1) { const int kvh = hh >> 2; qoff = hh * 64; koff = 1024 + kvh * 64; voff = 1280 + kvh * 64; ooff = hh * 64; krow0 = (size_t)b * SEQ;
        lo = t - 127 < 0 ? 0 : t - 127; hi = t; kbeg = qb * 256 - 128 < 0 ? 0 : qb * 256 - 128; kend = qb * 256 + 255; m_run = a.sinks[hh] * LOG2E; l = 1.f; }
    else { qoff = hh * 128; koff = hh * 128; voff = 512 + hh * 128; ooff = hh * 128; krow0 = (size_t)b * MEML; lo = 0; hi = MEML - 1; kbeg = 0; kend = MEML - 1; }
    const float sc = LOG2E / sqrtf((float)DK);
    float q[DK];
    { const u32x4* qp = (const u32x4*)(a.Q + tok * a.qpitch + qoff);
#pragma unroll
      for (int i = 0; i < DK / 8; ++i) { const u32x4 w = qp[i];
          q[8 * i + 0] = bflo(w.x) * sc; q[8 * i + 1] = bfhi(w.x) * sc; q[8 * i + 2] = bflo(w.y) * sc; q[8 * i + 3] = bfhi(w.y) * sc;
          q[8 * i + 4] = bflo(w.z) * sc; q[8 * i + 5] = bfhi(w.z) * sc; q[8 * i + 6] = bflo(w.w) * sc; q[8 * i + 7] = bfhi(w.w) * sc; } }
    float o[DV];
#pragma unroll
    for (int e = 0; e < DV; ++e) o[e] = 0.f;
    for (int k0 = kbeg; k0 <= kend; k0 += KT) {
        __syncthreads();
        for (int c = tid; c < KT * DK / 8; c += 256) { const int r = c / (DK / 8), ch = c % (DK / 8);
            const u32x4 w = *(const u32x4*)(a.K + (krow0 + k0 + r) * a.kpitch + koff + ch * 8); float* dst = Ks + r * DK + ch * 8;
            dst[0] = bflo(w.x); dst[1] = bfhi(w.x); dst[2] = bflo(w.y); dst[3] = bfhi(w.y); dst[4] = bflo(w.z); dst[5] = bfhi(w.z); dst[6] = bflo(w.w); dst[7] = bfhi(w.w); }
        for (int c = tid; c < KT * DV / 8; c += 256) { const int r = c / (DV / 8), ch = c % (DV / 8);
            const u32x4 w = *(const u32x4*)(a.V + (krow0 + k0 + r) * a.kpitch + voff + ch * 8); float* dst = Vs + r * DV + ch * 8;
            dst[0] = bflo(w.x); dst[1] = bfhi(w.x); dst[2] = bflo(w.y); dst[3] = bfhi(w.y); dst[4] = bflo(w.z); dst[5] = bfhi(w.z); dst[6] = bflo(w.w); dst[7] = bfhi(w.w); }
        __syncthreads();
        float s[KT]; float mt = -INFINITY;
#pragma unroll
        for (int r = 0; r < KT; ++r) {
            float acc = 0.f;
#pragma unroll
            for (int d = 0; d < DK; d += 4) { const f32x4 kk = *(const f32x4*)(Ks + r * DK + d); acc += q[d] * kk.x + q[d + 1] * kk.y + q[d + 2] * kk.z + q[d + 3] * kk.w; }
            const int key = k0 + r; s[r] = (key >= lo && key <= hi) ? acc : -INFINITY; mt = fmaxf(mt, s[r]);
        }
        const float mn = fmaxf(m_run, mt);
        if (mn > -INFINITY) {
            const float corr = exp2f(m_run - mn);
            l *= corr;
#pragma unroll
            for (int e = 0; e < DV; ++e) o[e] *= corr;
#pragma unroll
            for (int r = 0; r < KT; ++r) {
                const float p = exp2f(s[r] - mn); l += p;
#pragma unroll
                for (int e = 0; e < DV; e += 4) { const f32x4 vv = *(const f32x4*)(Vs + r * DV + e); o[e] += p * vv.x; o[e + 1] += p * vv.y; o[e + 2] += p * vv.z; o[e + 3] += p * vv.w; }
            }
            m_run = mn;
        }
    }
    const float il = 1.0f / l;
    if (MODE == 0) { float* op = (float*)a.O + tok * 1024 + ooff;
#pragma unroll
        for (int e = 0; e < DV; e += 4) *(f32x4*)(op + e) = (f32x4){o[e] * il, o[e + 1] * il, o[e + 2] * il, o[e + 3] * il}; }
    else { bf16_t* op = (bf16_t*)a.O + tok * (MODE == 1 ? 1024 : 512) + ooff;
#pragma unroll
        for (int e = 0; e < DV; e += 8) { u32x4 w; w.x = pk2(o[e] * il, o[e + 1] * il); w.y = pk2(o[e + 2] * il, o[e + 3] * il); w.z = pk2(o[e + 4] * il, o[e + 5] * il); w.w = pk2(o[e + 6] * il, o[e + 7] * il);
            *(u32x4*)(op + e) = w; } }
}

__global__ void __launch_bounds__(256) k_mix0(const bf16_t* P, const float* oraw, const float* convw, const float* subln, const float* lam, bf16_t* Y) {
    const int lane = threadIdx.x & 63, nw = gridDim.x * 4; const float lamv = lam[0];
    for (int tok = blockIdx.x * 4 + (threadIdx.x >> 6); tok < T_TOK; tok += nw) {
        const int t = tok & (SEQ - 1);
        const bf16_t* pr = P + (size_t)tok * 3072;
#pragma unroll
        for (int i = 0; i < 8; ++i) { const int c = lane + 64 * i; float cv = 0.f;
#pragma unroll
            for (int jx = 0; jx < 3; ++jx) { const int dt = 2 - jx; if (t - dt >= 0) { const bf16_t* pp = pr - (size_t)dt * 3072; cv += convw[jx * 512 + c] * (bf2f(pp[512 + c]) * bf2f(pp[1024 + c])); } }
            Y[(size_t)tok * DM + c] = (bf16_t)f2bf(bf2f(pr[c]) * cv); }
#pragma unroll
        for (int h = 0; h < 4; ++h) { const float* o0 = oraw + (size_t)tok * 1024 + (h * 2) * 128; const float* o1 = o0 + 128;
            const float d0 = o0[lane] - lamv * o1[lane], d1 = o0[lane + 64] - lamv * o1[lane + 64];
            const float ss = wave_sum(d0 * d0 + d1 * d1); const float rs = 1.0f / sqrtf(ss * (1.0f / 128.0f) + EPS);
            Y[(size_t)tok * DM + 512 + h * 128 + lane] = (bf16_t)f2bf(d0 * rs * subln[lane] * 0.8f);
            Y[(size_t)tok * DM + 512 + h * 128 + lane + 64] = (bf16_t)f2bf(d1 * rs * subln[lane + 64] * 0.8f); }
    }
}

__global__ void __launch_bounds__(256) k_route(const float* x, const float* ssq, const float* WR, const float* bg, const float* br, int* ctl, int* route_e, float* route_w, float* rs_tok, int* tok_of_slot) {
    const int lane = threadIdx.x & 63, nw = gridDim.x * 4;
    for (int i = blockIdx.x * 256 + threadIdx.x; i < SPAD; i += gridDim.x * 256) tok_of_slot[i] = -1;
    for (int tok = blockIdx.x * 4 + (threadIdx.x >> 6); tok < T_TOK; tok += nw) {
        float acc[36];
#pragma unroll
        for (int c = 0; c < 36; ++c) acc[c] = 0.f;
        for (int i = 0; i < 16; ++i) { const int k = lane + 64 * i; const float xv = x[(size_t)tok * DM + k]; const f32x4* w = (const f32x4*)(WR + (size_t)k * 36);
#pragma unroll
            for (int c4 = 0; c4 < 9; ++c4) { const f32x4 ww = w[c4]; acc[4 * c4] += xv * ww.x; acc[4 * c4 + 1] += xv * ww.y; acc[4 * c4 + 2] += xv * ww.z; acc[4 * c4 + 3] += xv * ww.w; } }
#pragma unroll
        for (int c = 0; c < 36; ++c) acc[c] = wave_sum(acc[c]);
        const float rs = row_rs(ssq, tok);
        float lg[4];
#pragma unroll
        for (int g = 0; g < 4; ++g) lg[g] = acc[g] * rs + bg[g];
        int gs = 0; float gm = lg[0];
#pragma unroll
        for (int g = 1; g < 4; ++g) if (lg[g] > gm) { gm = lg[g]; gs = g; }
        float gsum = 0.f;
#pragma unroll
        for (int g = 0; g < 4; ++g) gsum += expf(lg[g] - gm);
        const float p_g = 1.0f / gsum;
        float le[8];
#pragma unroll
        for (int e = 0; e < 8; ++e) { const float v = (gs == 0) ? acc[4 + e] : (gs == 1) ? acc[12 + e] : (gs == 2) ? acc[20 + e] : acc[28 + e]; le[e] = v * rs + br[gs * 8 + e]; }
        int i1 = 0; float m1 = le[0];
#pragma unroll
        for (int e = 1; e < 8; ++e) if (le[e] > m1) { m1 = le[e]; i1 = e; }
        int i2 = -1; float m2 = -INFINITY;
#pragma unroll
        for (int e = 0; e < 8; ++e) if (e != i1 && le[e] > m2) { m2 = le[e]; i2 = e; }
        const float e2 = expf(m2 - m1); const float w1 = p_g / (1.0f + e2), w2 = p_g * e2 / (1.0f + e2);
        if (lane == 0) {
            const int ex1 = gs * 8 + i1, ex2 = gs * 8 + i2;
            route_e[tok * 2] = ex1; route_e[tok * 2 + 1] = ex2; route_w[tok * 2] = w1; route_w[tok * 2 + 1] = w2; rs_tok[tok] = rs;
            atomicAdd(ctl + CI_CNT + ex1, 1); atomicAdd(ctl + CI_CNT + 32 + ex2, 1);
        }
    }
}
__global__ void __launch_bounds__(64) k_offsets(int* ctl) {
    __shared__ int tiles[64];
    const int L = threadIdx.x; tiles[L] = (ctl[CI_CNT + L] + 255) >> 8;
    __syncthreads();
    int base = 0; for (int i = 0; i < L; ++i) base += tiles[i];
    ctl[CI_LBASE + L] = base * 256; ctl[CI_CUR + L] = 0;
    for (int i = 0; i < tiles[L]; ++i) ctl[CI_TEXP + base + i] = L & 31;
    if (L == 31) ctl[CI_NT] = base + tiles[L];
    if (L == 63) ctl[CI_NT + 1] = base + tiles[L];
}
__global__ void __launch_bounds__(256) k_place(const bf16_t* xb, int* ctl, const int* route_e, const float* route_w, const float* rs_tok, int* tok_of_slot, float* w_of_slot, float* rs_of_slot, bf16_t* xs) {
    const int lane = threadIdx.x & 63, nw = gridDim.x * 4;
    for (int tok = blockIdx.x * 4 + (threadIdx.x >> 6); tok < T_TOK; tok += nw) {
        const u32x4* src = (const u32x4*)(xb + (size_t)tok * DM); const u32x4 v0 = src[lane], v1 = src[lane + 64];
#pragma unroll
        for (int k = 0; k < 2; ++k) {
            const int L = k * 32 + route_e[tok * 2 + k]; int slot = 0;
            if (lane == 0) slot = ctl[CI_LBASE + L] + atomicAdd(ctl + CI_CUR + L, 1);
            slot = __shfl(slot, 0);
            if (lane == 0) { tok_of_slot[slot] = tok; w_of_slot[slot] = route_w[tok * 2 + k]; rs_of_slot[slot] = rs_tok[tok]; }
            u32x4* dst = (u32x4*)(xs + (size_t)slot * DM); dst[lane] = v0; dst[lane + 64] = v1;
        }
    }
}
__global__ void __launch_bounds__(256) k_final(const float* x, const float* g, float* out) {
    const int lane = threadIdx.x & 63, nw = gridDim.x * 4;
    for (int row = blockIdx.x * 4 + (threadIdx.x >> 6); row < T_TOK; row += nw) {
        const f32x4* xr = (const f32x4*)(x + (size_t)row * DM) + lane; f32x4 v[4]; float s = 0.f;
#pragma unroll
        for (int jx = 0; jx < 4; ++jx) { v[jx] = xr[64 * jx]; s += (v[jx].x * v[jx].x + v[jx].y * v[jx].y) + (v[jx].z * v[jx].z + v[jx].w * v[jx].w); }
        const float rs = 1.0f / sqrtf(wave_sum(s) * (1.0f / 1024.0f) + EPS);
        f32x4* orow = (f32x4*)(out + (size_t)row * DM) + lane; const f32x4* gr = (const f32x4*)g + lane;
#pragma unroll
        for (int jx = 0; jx < 4; ++jx) orow[64 * jx] = v[jx] * rs * gr[64 * jx];
    }
}

template <class Epi> static void launch_gemm(hipStream_t st, const bf16_t* A, const bf16_t* Bt, int M, int N, int K, const Epi& E) {
    static bool init = false;
    if (!init) { (void)hipFuncSetAttribute((const void*)k_gemm<Epi>, hipFuncAttributeMaxDynamicSharedMemorySize, pg8::STAGE_BYTES); init = true; }
    pg8::Gemm g{A, Bt, M, N, K, 0};
    hipLaunchKernelGGL(k_gemm<Epi>, dim3(256), dim3(512), pg8::STAGE_BYTES, st, g, E);
}
template <class Epi> static void launch_gemm_grouped(hipStream_t st, const bf16_t* A, const bf16_t* Bt, int N, int K, const Epi& E, const int* ctl, int pass) {
    static bool init = false;
    if (!init) { (void)hipFuncSetAttribute((const void*)k_gemm_grouped<Epi>, hipFuncAttributeMaxDynamicSharedMemorySize, pg8::STAGE_BYTES); init = true; }
    pg8::Gemm g{A, Bt, SPAD, N, K, 0};
    hipLaunchKernelGGL(k_gemm_grouped<Epi>, dim3(256), dim3(512), pg8::STAGE_BYTES, st, g, E, ctl, pass);
}
static void launch_wt(hipStream_t st, const float* src, bf16_t* dst, const float* gain, int K, int N, int nb, int perm) {
    WtJob j{}; j.src = src; j.dst = dst; j.gain = gain; j.sstride = (long)K * N; j.dstride = (long)K * N; j.K = K; j.N = N; j.perm = perm; j.pad = 0;
    hipLaunchKernelGGL(k_wt, dim3(N / 64, K / 64, nb), dim3(256), 0, st, j);
}

extern "C" void kernel_launch(void* const* d_in, const int* in_sizes, int n_in, void* d_out, int out_size, void* d_ws, size_t ws_size, hipStream_t stream) {
    if (n_in != 26 || ws_size < WS_END) { fprintf(stderr, "kernel_launch: unexpected n_in %d / ws %zu\n", n_in, ws_size); return; }
    const float* x = (const float*)d_in[0]; const float* mem = (const float*)d_in[1]; const float* mem_norm = (const float*)d_in[2]; const float* mem_w_kv = (const float*)d_in[3];
    const float* norm_mix = (const float*)d_in[4]; const float* norm_xattn = (const float*)d_in[5]; const float* norm_ffn = (const float*)d_in[6];
    const float* hyb_w_in = (const float*)d_in[7]; const float* hyb_conv_w = (const float*)d_in[8]; const float* diff_lambda = (const float*)d_in[9]; const float* diff_subln = (const float*)d_in[10];
    const float* hyb_w_out = (const float*)d_in[11]; const float* swa_w_qkv = (const float*)d_in[12]; const float* swa_b_qkv = (const float*)d_in[13]; const float* swa_sinks = (const float*)d_in[14];
    const float* swa_w_out = (const float*)d_in[15]; const float* swa_b_out = (const float*)d_in[16]; const float* xattn_w_q = (const float*)d_in[17]; const float* xattn_w_o = (const float*)d_in[18];
    const float* moe_w_group = (const float*)d_in[19]; const float* moe_b_group = (const float*)d_in[20]; const float* moe_w_router = (const float*)d_in[21]; const float* moe_b_router = (const float*)d_in[22];
    const float* moe_w_gate_up = (const float*)d_in[23]; const float* moe_w_down = (const float*)d_in[24]; const float* final_norm = (const float*)d_in[25];
    unsigned char* ws = (unsigned char*)d_ws; float* out = (float*)d_out;
    int* ctl = (int*)(ws + WS_CTL);
    float* ropeC = (float*)(ws + WS_ROPEC); float* ropeS = (float*)(ws + WS_ROPES); float* WR = (float*)(ws + WS_WR); float* lam = (float*)(ws + WS_LAM);
    float* ssq = (float*)(ws + WS_SSQ); float* ssqm = (float*)(ws + WS_SSQM);
    int* tok_of_slot = (int*)(ws + WS_TOKSLOT); float* w_of_slot = (float*)(ws + WS_WSLOT); float* rs_of_slot = (float*)(ws + WS_RSSLOT);
    int* route_e = (int*)(ws + WS_ROUTE_E); float* route_w = (float*)(ws + WS_ROUTE_W); float* rs_tok = (float*)(ws + WS_RSTOK);
    bf16_t* memb = (bf16_t*)(ws + WS_MEMB); bf16_t* mkv = (bf16_t*)(ws + WS_MKV);
    bf16_t* Wmem = (bf16_t*)(ws + WS_WMEM); bf16_t* Win = (bf16_t*)(ws + WS_WIN); bf16_t* Wout0 = (bf16_t*)(ws + WS_WOUT0); bf16_t* Wqkv = (bf16_t*)(ws + WS_WQKV); bf16_t* Wout1 = (bf16_t*)(ws + WS_WOUT1);
    bf16_t* Wq = (bf16_t*)(ws + WS_WQ); bf16_t* Wo = (bf16_t*)(ws + WS_WO); bf16_t* Wgu = (bf16_t*)(ws + WS_WGU); bf16_t* Wdn = (bf16_t*)(ws + WS_WDN);
    float* XA = (float*)(ws + WS_XA); bf16_t* XBF = (bf16_t*)(ws + WS_XBF); bf16_t* Y = (bf16_t*)(ws + WS_Y); bf16_t* QX = (bf16_t*)(ws + WS_QX); bf16_t* OX = (bf16_t*)(ws + WS_OX);
    bf16_t* P = (bf16_t*)(ws + WS_U1); bf16_t* XS = (bf16_t*)(ws + WS_U1); float* ORAW = (float*)(ws + WS_U2); bf16_t* HID = (bf16_t*)(ws + WS_U2);

    (void)hipMemsetAsync(ws + WS_CTL, 0, CTL_ZERO_BYTES, stream);
    launch_wt(stream, mem_w_kv, Wmem, mem_norm, 1024, 1024, 1, 0);
    launch_wt(stream, hyb_w_in, Win, norm_mix, 1024, 3072, 1, 0);
    launch_wt(stream, hyb_w_out, Wout0, nullptr, 1024, 1024, 1, 0);
    launch_wt(stream, swa_w_qkv, Wqkv, norm_mix + 1024, 1024, 1536, 1, 0);
    launch_wt(stream, swa_w_out, Wout1, nullptr, 1024, 1024, 1, 0);
    for (int l = 0; l < 2; ++l) {
        launch_wt(stream, xattn_w_q + (size_t)l * 1024 * 512, Wq + (size_t)l * 512 * 1024, norm_xattn + l * 1024, 1024, 512, 1, 0);
        launch_wt(stream, xattn_w_o + (size_t)l * 512 * 1024, Wo + (size_t)l * 1024 * 512, nullptr, 512, 1024, 1, 0);
        launch_wt(stream, moe_w_gate_up + (size_t)l * 32 * 1024 * 1024, Wgu + (size_t)l * 32 * 1024 * 1024, norm_ffn + l * 1024, 1024, 1024, 32, 1);
        launch_wt(stream, moe_w_down + (size_t)l * 32 * 512 * 1024, Wdn + (size_t)l * 32 * 1024 * 512, nullptr, 512, 1024, 32, 0);
    }
    { MiscArgs a{}; for (int jx = 0; jx < 8; ++jx) a.inv[jx] = pow(500000.0, -(double)(2 * jx) / 16.0);
      a.norm_ffn = norm_ffn; a.w_group = moe_w_group; a.w_router = moe_w_router; a.lam = diff_lambda; a.ropeC = ropeC; a.ropeS = ropeS; a.WR = WR; a.lam_out = lam;
      hipLaunchKernelGGL(k_misc, dim3(128), dim3(256), 0, stream, a); }
    hipLaunchKernelGGL(k_rowprep, dim3(2048), dim3(256), 0, stream, x, XBF, ssq, T_TOK);
    hipLaunchKernelGGL(k_rowprep, dim3(1024), dim3(256), 0, stream, mem, memb, ssqm, TMEM);
    { EpiProj E{}; E.O = mkv; E.ssq = ssqm; E.bias = nullptr; E.ropeC = ropeC; E.ropeS = ropeS; E.ldc = 1024; E.rope_lo = 0; E.rope_hi = 0; E.pad = 0;
      launch_gemm(stream, memb, Wmem, TMEM, 1024, 1024, E); }
    for (int l = 0; l < 2; ++l) {
        int* lctl = ctl + l * CI_STRIDE;
        if (l == 0) {
            { EpiProj E{}; E.O = P; E.ssq = ssq; E.bias = nullptr; E.ropeC = ropeC; E.ropeS = ropeS; E.ldc = 3072; E.rope_lo = 1536; E.rope_hi = 2560; E.pad = 0;
              launch_gemm(stream, XBF, Win, T_TOK, 3072, 1024, E); }
            { AttnArgs a{}; a.Q = P; a.K = P; a.V = P; a.O = ORAW; a.sinks = nullptr; a.qpitch = 3072; a.kpitch = 3072;
              hipLaunchKernelGGL((k_attn_simple<64, 128, 0, 32>), dim3(8, 8, 16), dim3(256), 0, stream, a); }
            hipLaunchKernelGGL(k_mix0, dim3(2048), dim3(256), 0, stream, (const bf16_t*)P, (const float*)ORAW, hyb_conv_w, diff_subln, (const float*)lam, Y);
            { EpiResid E{}; E.xin = x; E.xout = XA; E.xb = XBF; E.ssq = ssq; E.bias = nullptr;
              launch_gemm(stream, Y, Wout0, T_TOK, 1024, 1024, E); }
        } else {
            { EpiProj E{}; E.O = P; E.ssq = ssq; E.bias = swa_b_qkv; E.ropeC = ropeC; E.ropeS = ropeS; E.ldc = 1536; E.rope_lo = 0; E.rope_hi = 1280; E.pad = 0;
              launch_gemm(stream, XBF, Wqkv, T_TOK, 1536, 1024, E); }
            { AttnArgs a{}; a.Q = P; a.K = P; a.V = P; a.O = Y; a.sinks = swa_sinks; a.qpitch = 1536; a.kpitch = 1536;
              hipLaunchKernelGGL((k_attn_simple<64, 64, 1, 32>), dim3(8, 16, 16), dim3(256), 0, stream, a); }
            { EpiResid E{}; E.xin = XA; E.xout = XA; E.xb = XBF; E.ssq = ssq; E.bias = swa_b_out;
              launch_gemm(stream, Y, Wout1, T_TOK, 1024, 1024, E); }
        }
        { EpiProj E{}; E.O = QX; E.ssq = ssq; E.bias = nullptr; E.ropeC = ropeC; E.ropeS = ropeS; E.ldc = 512; E.rope_lo = 0; E.rope_hi = 0; E.pad = 0;
          launch_gemm(stream, XBF, Wq + (size_t)l * 512 * 1024, T_TOK, 512, 1024, E); }
        { AttnArgs a{}; a.Q = QX; a.K = mkv; a.V = mkv; a.O = OX; a.sinks = nullptr; a.qpitch = 512; a.kpitch = 1024;
          hipLaunchKernelGGL((k_attn_simple<128, 128, 2, 16>), dim3(8, 4, 16), dim3(256), 0, stream, a); }
        { EpiResid E{}; E.xin = XA; E.xout = XA; E.xb = XBF; E.ssq = ssq; E.bias = nullptr;
          launch_gemm(stream, OX, Wo + (size_t)l * 1024 * 512, T_TOK, 1024, 512, E); }
        hipLaunchKernelGGL(k_route, dim3(2048), dim3(256), 0, stream, (const float*)XA, (const float*)ssq, (const float*)(WR + (size_t)l * 1024 * 36), moe_b_group + l * 4, moe_b_router + l * 32,
                           lctl, route_e, route_w, rs_tok, tok_of_slot);
        hipLaunchKernelGGL(k_offsets, dim3(1), dim3(64), 0, stream, lctl);
        hipLaunchKernelGGL(k_place, dim3(2048), dim3(256), 0, stream, (const bf16_t*)XBF, lctl, (const int*)route_e, (const float*)route_w, (const float*)rs_tok, tok_of_slot, w_of_slot, rs_of_slot, XS);
        { EpiGateUp E{}; E.hid = HID; E.rs_slot = rs_of_slot;
          launch_gemm_grouped(stream, XS, Wgu + (size_t)l * 32 * 1024 * 1024, 1024, 1024, E, lctl, -1); }
        for (int pass = 0; pass < 2; ++pass) { EpiDown E{}; E.x = XA; E.xb = XBF; E.ssq = ssq; E.tok_of_slot = tok_of_slot; E.w_of_slot = w_of_slot; E.last = pass; E.pad = 0;
          launch_gemm_grouped(stream, HID, Wdn + (size_t)l * 32 * 1024 * 512, 1024, 512, E, lctl, pass); }
    }
    hipLaunchKernelGGL(k_final, dim3(2048), dim3(256), 0, stream, (const float*)XA, final_norm, out);
}
```

```cpp
#include <hip/hip_runtime.h>
#include <cstdio>
#include <cstdint>
#include <cmath>
namespace pg8 {
#define PG8_LAS __attribute__((address_space(3)))
typedef unsigned short bf16_t;
typedef short bf16x8 __attribute__((ext_vector_type(8)));
typedef float f32x4 __attribute__((ext_vector_type(4)));
typedef unsigned u32x4 __attribute__((ext_vector_type(4)));
constexpr int BM = 256, BK = 64, HALF = 128, HTB = HALF * BK * 2  , STAGE_BYTES = 8 * HTB, NXCD = 8, WGM = 8;

__host__ __device__ __forceinline__ int lds_byte(int r, int c) { const int st = (r >> 4) * 2 + (c >> 5), rr = r & 15, cc = c & 31, ob = rr * 64 + cc * 2; return st * 1024 + (ob ^ (((ob >> 9) & 1) << 5)); }
__host__ __device__ __forceinline__ void stage_rc(int b, int& R, int& C) { const int st = b / 1024, sb = b % 1024, swz = sb ^ (((sb >> 9) & 1) << 5); R = (st >> 1) * 16 + swz / 64; C = (st & 1) * 32 + (swz % 64) / 2; }
__host__ __device__ __forceinline__ int perm32(int rho) { const int n = rho >> 4, i = rho & 15; return 8 * (i >> 2) + 4 * n + (i & 3); }

struct Unit { int pm, pn, brow; };
struct Gemm { const bf16_t* A; const bf16_t* Bt; int M, N, K, pad; };

struct StaticOrder {
    int nM, nN, nwg, G, c;
    __host__ __device__ void init(int M, int N, int G_, int c_) { nM = M / BM; nN = N / BM; nwg = nM * nN; G = G_; c = c_; }
    __host__ __device__ bool next(int i, Unit& u) const {
        const long L = (long)i * G + c; if (L >= nwg) return false;
        int wgid = (int)L; { const int q = nwg / NXCD, r = nwg % NXCD, xcd = wgid % NXCD, off = wgid / NXCD; wgid = (xcd < r ? xcd * (q + 1) : r * (q + 1) + (xcd - r) * q) + off; }
        const int nig = WGM * nN, gid = wgid / nig, fm = gid * WGM, gsz = (nM - fm) < WGM ? (nM - fm) : WGM;
        u.pm = fm + ((wgid % nig) % gsz); u.pn = (wgid % nig) / gsz; u.brow = 0; return true;
    }
    __device__ __forceinline__ void a_ready(const Unit&) const {}
    __device__ __forceinline__ void done(const Unit&) const {}
};

__device__ __forceinline__ unsigned cvt_pk_bf16(float lo, float hi) { unsigned r; asm volatile("v_cvt_pk_bf16_f32 %0, %1, %2" : "=v"(r) : "v"(lo), "v"(hi)); return r; }
template <class Epi, class Sched, bool ALIGN_EPI = false, bool SP2 = false>
__device__ __forceinline__ void gemm_phase(PG8_LAS unsigned char* lds, const Gemm g, const Sched& S, const Epi& E) {
    const int tid = threadIdx.x, wid = __builtin_amdgcn_readfirstlane(tid >> 6), lane = tid & 63, wr = wid >> 2, wc = wid & 3, fr = lane & 15, fq = lane >> 4;
    const int K = g.K, nt = K / BK;
    unsigned voffA[2], voffB[2];
#pragma unroll
    for (int i = 0; i < 2; ++i) { int R, C; stage_rc(tid * 16 + i * 8192, R, C); const int Rb = Epi::PERM ? ((R & ~31) + perm32(R & 31)) : R;
        voffA[i] = (unsigned)(R * K + C) * 2u; voffB[i] = (unsigned)(Rb * K + C) * 2u; }
    const size_t kstep = (size_t)(BK * 2);
    const size_t hstep = (size_t)HALF * K * 2;
    const size_t tstep = 2 * hstep;
    const unsigned ldsw = (unsigned)wid * 1024u;
    const int aoff = lds_byte(wr * 64 + fr, fq * 8), boff = lds_byte(wc * 32 + fr, fq * 8);
#define PG8_SA(b, h) (((b) * 2 + (h)) * HTB)
#define PG8_SB(b, h) ((4 + (b) * 2 + (h)) * HTB)
#define PG8_STAGE(bufoff, gbase, voff) do { _Pragma("unroll") for (int _i = 0; _i < 2; ++_i) \
        __builtin_amdgcn_global_load_lds((const unsigned*)((const char*)(gbase) + (voff)[_i]), (PG8_LAS unsigned*)(lds + (bufoff) + ldsw + _i * 8192), 16, 0, 0); } while (0)
#define PG8_LDA(dst, b, h) do { _Pragma("unroll") for (int m = 0; m < 4; ++m) _Pragma("unroll") for (int k = 0; k < 2; ++k) dst[m][k] = *(const PG8_LAS bf16x8*)(lds + PG8_SA(b, h) + aoff + m * 2048 + k * 1024); } while (0)
#define PG8_LDB(dst, b, h) do { _Pragma("unroll") for (int n = 0; n < 2; ++n) _Pragma("unroll") for (int k = 0; k < 2; ++k) dst[n][k] = *(const PG8_LAS bf16x8*)(lds + PG8_SB(b, h) + boff + n * 2048 + k * 1024); } while (0)
#define PG8_MMA(ai, bj, At, Bt) do { __builtin_amdgcn_s_setprio(1); _Pragma("unroll") for (int m = 0; m < 4; ++m) _Pragma("unroll") for (int n = 0; n < 2; ++n) _Pragma("unroll") for (int k = 0; k < 2; ++k) \
        acc[ai][bj][m][n] = __builtin_amdgcn_mfma_f32_16x16x32_bf16(Bt[n][k], At[m][k], acc[ai][bj][m][n], 0, 0, 0); __builtin_amdgcn_s_setprio(0); } while (0)
#define PG8_WAIT_V(n) asm volatile("s_waitcnt vmcnt(" #n ")" ::: "memory")
#define PG8_WAIT_L(n) asm volatile("s_waitcnt lgkmcnt(" #n ")" ::: "memory")
#define PG8_BAR __builtin_amdgcn_s_barrier()
#define PG8_SCHED __builtin_amdgcn_sched_barrier(0)
    Unit cur, nxt; int ui = 0;
    if (!S.next(0, cur)) return;
    f32x4 acc[2][2][4][2];
#pragma unroll
    for (int a = 0; a < 2; ++a)
#pragma unroll
        for (int b = 0; b < 2; ++b)
#pragma unroll
            for (int m = 0; m < 4; ++m)
#pragma unroll
                for (int n = 0; n < 2; ++n) acc[a][b][m][n] = (f32x4){0.f, 0.f, 0.f, 0.f};
    bf16x8 At[4][2], B0[2][2], B1[2][2];
    const char* cA = (const char*)g.A + (size_t)cur.pm * tstep; const char* cB = (const char*)g.Bt + (size_t)(cur.brow + cur.pn) * tstep;
    S.a_ready(cur);
    if constexpr (SP2) {
        PG8_STAGE(PG8_SB(0, 0), cB, voffB); PG8_STAGE(PG8_SB(0, 1), cB + hstep, voffB); PG8_STAGE(PG8_SA(0, 0), cA, voffA); PG8_STAGE(PG8_SA(0, 1), cA + hstep, voffA);
        if (wr == 1) PG8_BAR;
        PG8_WAIT_V(2); PG8_BAR;
        PG8_STAGE(PG8_SB(1, 0), cB + kstep, voffB); PG8_STAGE(PG8_SA(1, 0), cA + kstep, voffA); PG8_STAGE(PG8_SB(1, 1), cB + hstep + kstep, voffB);
        PG8_WAIT_V(6); PG8_BAR;
    } else {
        PG8_STAGE(PG8_SB(0, 0), cB, voffB); PG8_STAGE(PG8_SA(0, 0), cA, voffA); PG8_STAGE(PG8_SB(0, 1), cB + hstep, voffB); PG8_STAGE(PG8_SA(0, 1), cA + hstep, voffA);
        if (wr == 1) PG8_BAR;
        PG8_WAIT_V(4); PG8_BAR;
        PG8_STAGE(PG8_SB(1, 0), cB + kstep, voffB); PG8_STAGE(PG8_SA(1, 0), cA + kstep, voffA); PG8_STAGE(PG8_SB(1, 1), cB + hstep + kstep, voffB);
        PG8_WAIT_V(6); PG8_BAR;
    }
    for (;;) {
        const bool has_next = S.next(ui + 1, nxt);
        const char* nA = has_next ? (const char*)g.A + (size_t)nxt.pm * tstep : cA; const char* nB = has_next ? (const char*)g.Bt + (size_t)(nxt.brow + nxt.pn) * tstep : cB;
        for (int t = 0; t < nt; t += 2) {
            const bool last = (t == nt - 2);
            const char* a1 = cA + (size_t)(t + 1) * kstep;
            const char* a2 = last ? nA : cA + (size_t)(t + 2) * kstep; const char* b2 = last ? nB : cB + (size_t)(t + 2) * kstep;
            const char* a3 = a2 + kstep; const char* b3 = b2 + kstep;
            if (last && has_next) S.a_ready(nxt);
            if constexpr (SP2) {
            PG8_LDB(B0, 0, 0); PG8_LDB(B1, 0, 1); PG8_SCHED; PG8_LDA(At, 0, 0); PG8_STAGE(PG8_SA(1, 1), a1 + hstep, voffA);
            PG8_WAIT_V(8); PG8_WAIT_L(0); PG8_BAR; PG8_MMA(0, 0, At, B0); PG8_MMA(0, 1, At, B1); PG8_BAR; PG8_SCHED;
            PG8_LDA(At, 0, 1); PG8_STAGE(PG8_SB(0, 0), b2, voffB); PG8_STAGE(PG8_SB(0, 1), b2 + hstep, voffB); PG8_STAGE(PG8_SA(0, 0), a2, voffA);
            PG8_WAIT_V(8); PG8_WAIT_L(0); PG8_BAR; PG8_MMA(1, 0, At, B0); PG8_MMA(1, 1, At, B1); PG8_BAR; PG8_SCHED;
            PG8_LDB(B0, 1, 0); PG8_LDB(B1, 1, 1); PG8_SCHED; PG8_LDA(At, 1, 0); PG8_STAGE(PG8_SA(0, 1), a2 + hstep, voffA);
            PG8_WAIT_V(8); PG8_WAIT_L(0); PG8_BAR; PG8_MMA(0, 0, At, B0); PG8_MMA(0, 1, At, B1); PG8_BAR; PG8_SCHED;
            PG8_LDA(At, 1, 1); PG8_STAGE(PG8_SB(1, 0), b3, voffB); PG8_STAGE(PG8_SB(1, 1), b3 + hstep, voffB); PG8_STAGE(PG8_SA(1, 0), a3, voffA);
            PG8_WAIT_V(8); PG8_WAIT_L(0); PG8_BAR; PG8_MMA(1, 0, At, B0); PG8_MMA(1, 1, At, B1); PG8_BAR; PG8_SCHED;
            } else {
            PG8_LDB(B0, 0, 0); PG8_SCHED; PG8_LDA(At, 0, 0); PG8_STAGE(PG8_SA(1, 1), a1 + hstep, voffA);
            PG8_WAIT_L(8); PG8_BAR; PG8_WAIT_L(0); PG8_MMA(0, 0, At, B0); PG8_BAR; PG8_SCHED;
            PG8_LDB(B1, 0, 1); PG8_STAGE(PG8_SB(0, 0), b2, voffB);
            PG8_BAR; PG8_WAIT_L(0); PG8_MMA(0, 1, At, B1); PG8_BAR;
            PG8_LDA(At, 0, 1); PG8_STAGE(PG8_SA(0, 0), a2, voffA);
            PG8_BAR; PG8_WAIT_L(0); PG8_MMA(1, 0, At, B0); PG8_BAR; PG8_SCHED;
            PG8_STAGE(PG8_SB(0, 1), b2 + hstep, voffB);
            PG8_WAIT_V(6); PG8_BAR; PG8_MMA(1, 1, At, B1); PG8_BAR;
            PG8_LDB(B0, 1, 0); PG8_SCHED; PG8_LDA(At, 1, 0); PG8_STAGE(PG8_SA(0, 1), a2 + hstep, voffA);
            PG8_WAIT_L(8); PG8_BAR; PG8_WAIT_L(0); PG8_MMA(0, 0, At, B0); PG8_BAR; PG8_SCHED;
            PG8_LDB(B1, 1, 1); PG8_STAGE(PG8_SB(1, 0), b3, voffB);
            PG8_BAR; PG8_WAIT_L(0); PG8_MMA(0, 1, At, B1); PG8_BAR;
            PG8_LDA(At, 1, 1); PG8_STAGE(PG8_SA(1, 0), a3, voffA);
            PG8_BAR; PG8_WAIT_L(0); PG8_MMA(1, 0, At, B0); PG8_BAR; PG8_SCHED;
            PG8_STAGE(PG8_SB(1, 1), b3 + hstep, voffB);
            PG8_WAIT_V(6); PG8_BAR; PG8_MMA(1, 1, At, B1); PG8_BAR;
            }
        }
        if constexpr (ALIGN_EPI) { if (wr == 0) PG8_BAR; }
        if constexpr (!Epi::AFTER_DRAIN) { E(acc, cur, wr, wc, fr, fq); S.done(cur); }
        if (!has_next) break;
#pragma unroll
        for (int a = 0; a < 2; ++a)
#pragma unroll
            for (int b = 0; b < 2; ++b)
#pragma unroll
                for (int m = 0; m < 4; ++m)
#pragma unroll
                    for (int n = 0; n < 2; ++n) acc[a][b][m][n] = (f32x4){0.f, 0.f, 0.f, 0.f};
        cur = nxt; cA = nA; cB = nB; ++ui;
        if constexpr (ALIGN_EPI) { if (wr == 1) PG8_BAR; }
    }
    PG8_WAIT_V(0);
    if constexpr (!ALIGN_EPI) { if (wr == 0) PG8_BAR; }
    PG8_BAR;
    if constexpr (Epi::AFTER_DRAIN) { E.fused(acc, cur, wr, wc, fr, fq, lds, wid, lane); S.done(cur); }
#undef PG8_SA
#undef PG8_SB
#undef PG8_STAGE
#undef PG8_LDA
#undef PG8_LDB
#undef PG8_MMA
#undef PG8_WAIT_V
#undef PG8_WAIT_L
#undef PG8_BAR
#undef PG8_SCHED
}
}

using pg8::bf16_t; using pg8::f32x4; using pg8::u32x4; using pg8::Unit;
constexpr int T_TOK = 32768, DM = 1024, SEQ = 2048, NBATCH = 16, MEML = 256, TMEM = 4096, SPAD = 81920;
constexpr float EPS = 1e-6f;
constexpr float LOG2E = 1.4426950408889634f;
constexpr size_t MiB = 1u << 20;
constexpr size_t WS_CTL = 0, CTL_ZERO_BYTES = 64 * 1024;
constexpr size_t WS_ROPEC = 1 * MiB, WS_ROPES = 1 * MiB + 64 * 1024, WS_WR = 1 * MiB + 128 * 1024  , WS_LAM = 1 * MiB + 512 * 1024;
constexpr size_t WS_SSQ = 2 * MiB, WS_SSQM = 4 * MiB;
constexpr size_t WS_TOKSLOT = 5 * MiB, WS_WSLOT = 5 * MiB + 512 * 1024, WS_RSSLOT = 6 * MiB;
constexpr size_t WS_ROUTE_E = 7 * MiB, WS_ROUTE_W = 7 * MiB + 512 * 1024, WS_RSTOK = 8 * MiB;
constexpr size_t WS_MEMB = 10 * MiB, WS_MKV = 18 * MiB;
constexpr size_t WS_WMEM = 26 * MiB, WS_WIN = 28 * MiB, WS_WOUT0 = 34 * MiB, WS_WQKV = 36 * MiB, WS_WOUT1 = 39 * MiB, WS_WQ = 41 * MiB, WS_WO = 43 * MiB,
                 WS_WGU = 45 * MiB, WS_WDN = 173 * MiB;
constexpr size_t WS_XA = 240 * MiB, WS_XBF = 368 * MiB, WS_Y = 432 * MiB, WS_QX = 496 * MiB, WS_OX = 528 * MiB, WS_U1 = 560 * MiB, WS_U2 = 752 * MiB, WS_END = 880 * MiB;
constexpr int CI_CNT = 0, CI_CUR = 64, CI_LBASE = 128, CI_NT = 192, CI_TEXP = 256, CI_STRIDE = 1024;

__device__ __forceinline__ unsigned f2bf(float f) { unsigned u = __builtin_bit_cast(unsigned, f); return (u + 0x7fffu + ((u >> 16) & 1u)) >> 16; }
__device__ __forceinline__ unsigned pk2(float lo, float hi) { return f2bf(lo) | (f2bf(hi) << 16); }
__device__ __forceinline__ float bflo(unsigned w) { return __builtin_bit_cast(float, w << 16); }
__device__ __forceinline__ float bfhi(unsigned w) { return __builtin_bit_cast(float, w & 0xffff0000u); }
__device__ __forceinline__ float bf2f(bf16_t h) { return __builtin_bit_cast(float, (unsigned)h << 16); }
__device__ __forceinline__ float wave_sum(float v) {
#pragma unroll
    for (int o = 1; o < 64; o <<= 1) v += __shfl_xor(v, o);
    return v;
}
__device__ __forceinline__ float row_rs(const float* ssq, int row) {
    const f32x4* p = (const f32x4*)(ssq + (size_t)row * 16);
    const f32x4 a = p[0], b = p[1], c = p[2], d = p[3];
    const float s = (((a.x + a.y) + (a.z + a.w)) + ((b.x + b.y) + (b.z + b.w))) + (((c.x + c.y) + (c.z + c.w)) + ((d.x + d.y) + (d.z + d.w)));
    return 1.0f / sqrtf(s * (1.0f / 1024.0f) + EPS);
}

struct EpiProj {
    static constexpr bool PERM = true, AFTER_DRAIN = false;
    bf16_t* O; const float* ssq; const float* bias; const float* ropeC; const float* ropeS; int ldc, rope_lo, rope_hi, pad;
    __device__ __forceinline__ void operator()(const f32x4 (&acc)[2][2][4][2], const Unit& u, int wr, int wc, int fr, int fq) const {
        const int row0 = u.pm * 256 + wr * 64 + fr;
#pragma unroll
        for (int ai = 0; ai < 2; ++ai)
#pragma unroll
            for (int m = 0; m < 4; ++m) {
                const int row = row0 + ai * 128 + m * 16;
                const float rs = row_rs(ssq, row);
                const int pos = row & (SEQ - 1);
#pragma unroll
                for (int bj = 0; bj < 2; ++bj) {
                    const int col = u.pn * 256 + bj * 128 + wc * 32 + 8 * fq;
                    float v[8], pv[8];
#pragma unroll
                    for (int i = 0; i < 8; ++i) v[i] = acc[ai][bj][m][i >> 2][i & 3] * rs;
                    if (bias) {
                        const f32x4 b0 = *(const f32x4*)(bias + col), b1 = *(const f32x4*)(bias + col + 4);
#pragma unroll
                        for (int i = 0; i < 4; ++i) { v[i] += b0[i]; v[4 + i] += b1[i]; }
                    }
#pragma unroll
                    for (int i = 0; i < 8; ++i) pv[i] = __shfl_xor(v[i], 16);
                    if (col >= rope_lo && col < rope_hi && (col & 63) < 16) {
                        const f32x4 c0 = *(const f32x4*)(ropeC + pos * 8), c1 = *(const f32x4*)(ropeC + pos * 8 + 4);
                        const f32x4 s0 = *(const f32x4*)(ropeS + pos * 8), s1 = *(const f32x4*)(ropeS + pos * 8 + 4);
                        const float sg = (col & 8) ? 1.0f : -1.0f;
#pragma unroll
                        for (int i = 0; i < 4; ++i) { v[i] = v[i] * c0[i] + sg * pv[i] * s0[i]; v[4 + i] = v[4 + i] * c1[i] + sg * pv[4 + i] * s1[i]; }
                    }
                    u32x4 w; w.x = pk2(v[0], v[1]); w.y = pk2(v[2], v[3]); w.z = pk2(v[4], v[5]); w.w = pk2(v[6], v[7]);
                    *(u32x4*)(O + (size_t)row * ldc + col) = w;
                }
            }
    }
};
struct EpiResid {
    static constexpr bool PERM = true, AFTER_DRAIN = false;
    const float* xin; float* xout; bf16_t* xb; float* ssq; const float* bias;
    __device__ __forceinline__ void operator()(const f32x4 (&acc)[2][2][4][2], const Unit& u, int wr, int wc, int fr, int fq) const {
        const int row0 = u.pm * 256 + wr * 64 + fr;
#pragma unroll
        for (int ai = 0; ai < 2; ++ai)
#pragma unroll
            for (int m = 0; m < 4; ++m) {
                const int row = row0 + ai * 128 + m * 16;
                float ss = 0.f;
#pragma unroll
                for (int bj = 0; bj < 2; ++bj) {
                    const int col = u.pn * 256 + bj * 128 + wc * 32 + 8 * fq;
                    const size_t off = (size_t)row * DM + col;
                    f32x4 x0 = *(const f32x4*)(xin + off), x1 = *(const f32x4*)(xin + off + 4);
                    x0 += acc[ai][bj][m][0]; x1 += acc[ai][bj][m][1];
                    if (bias) { x0 += *(const f32x4*)(bias + col); x1 += *(const f32x4*)(bias + col + 4); }
                    *(f32x4*)(xout + off) = x0; *(f32x4*)(xout + off + 4) = x1;
                    u32x4 w; w.x = pk2(x0[0], x0[1]); w.y = pk2(x0[2], x0[3]); w.z = pk2(x1[0], x1[1]); w.w = pk2(x1[2], x1[3]);
                    *(u32x4*)(xb + off) = w;
                    ss += (x0[0] * x0[0] + x0[1] * x0[1]) + (x0[2] * x0[2] + x0[3] * x0[3]) + (x1[0] * x1[0] + x1[1] * x1[1]) + (x1[2] * x1[2] + x1[3] * x1[3]);
                }
                ss += __shfl_xor(ss, 16); ss += __shfl_xor(ss, 32);
                if (fq == 0) ssq[(size_t)row * 16 + u.pn * 4 + wc] = ss;
            }
    }
};
struct EpiGateUp {
    static constexpr bool PERM = true, AFTER_DRAIN = false;
    bf16_t* hid; const float* rs_slot;
    __device__ __forceinline__ void operator()(const f32x4 (&acc)[2][2][4][2], const Unit& u, int wr, int wc, int fr, int fq) const {
        const int row0 = u.pm * 256 + wr * 64 + fr;
#pragma unroll
        for (int ai = 0; ai < 2; ++ai)
#pragma unroll
            for (int m = 0; m < 4; ++m) {
                const int row = row0 + ai * 128 + m * 16;
                const float rs = rs_slot[row];
                float h[8];
#pragma unroll
                for (int i = 0; i < 8; ++i) { const float g = acc[ai][0][m][i >> 2][i & 3] * rs, up = acc[ai][1][m][i >> 2][i & 3] * rs; h[i] = g / (1.0f + __expf(-g)) * up; }
                u32x4 w; w.x = pk2(h[0], h[1]); w.y = pk2(h[2], h[3]); w.z = pk2(h[4], h[5]); w.w = pk2(h[6], h[7]);
                *(u32x4*)(hid + (size_t)row * 512 + u.pn * 128 + wc * 32 + 8 * fq) = w;
            }
    }
};
struct EpiDown {
    static constexpr bool PERM = true, AFTER_DRAIN = false;
    float* x; bf16_t* xb; float* ssq; const int* tok_of_slot; const float* w_of_slot; int last, pad;
    __device__ __forceinline__ void operator()(const f32x4 (&acc)[2][2][4][2], const Unit& u, int wr, int wc, int fr, int fq) const {
        const int row0 = u.pm * 256 + wr * 64 + fr;
#pragma unroll
        for (int ai = 0; ai < 2; ++ai)
#pragma unroll
            for (int m = 0; m < 4; ++m) {
                const int slot = row0 + ai * 128 + m * 16;
                const int tok = tok_of_slot[slot];
                const float wt = w_of_slot[slot];
                float ss = 0.f;
                if (tok >= 0) {
#pragma unroll
                    for (int bj = 0; bj < 2; ++bj) {
                        const int col = u.pn * 256 + bj * 128 + wc * 32 + 8 * fq;
                        const size_t off = (size_t)tok * DM + col;
                        f32x4 x0 = *(const f32x4*)(x + off), x1 = *(const f32x4*)(x + off + 4);
                        x0 += acc[ai][bj][m][0] * wt; x1 += acc[ai][bj][m][1] * wt;
                        *(f32x4*)(x + off) = x0; *(f32x4*)(x + off + 4) = x1;
                        if (last) {
                            u32x4 w; w.x = pk2(x0[0], x0[1]); w.y = pk2(x0[2], x0[3]); w.z = pk2(x1[0], x1[1]); w.w = pk2(x1[2], x1[3]);
                            *(u32x4*)(xb + off) = w;
                            ss += (x0[0] * x0[0] + x0[1] * x0[1]) + (x0[2] * x0[2] + x0[3] * x0[3]) + (x1[0] * x1[0] + x1[1] * x1[1]) + (x1[2] * x1[2] + x1[3] * x1[3]);
                        }
                    }
                }
                ss += __shfl_xor(ss, 16); ss += __shfl_xor(ss, 32);
                if (last && tok >= 0 && fq == 0) ssq[(size_t)tok * 16 + u.pn * 4 + wc] = ss;
            }
    }
};

struct GroupedOrder {
    const int* tile_expert; int t_lo, t_hi, nN, G, c, tiles_per_expert;
    __device__ __forceinline__ bool next(int i, Unit& u) const {
        const long L = (long)i * G + c; const long n = (long)(t_hi - t_lo) * nN; if (L >= n) return false;
        u.pm = t_lo + (int)(L / nN); u.pn = (int)(L % nN); u.brow = tile_expert[u.pm] * tiles_per_expert; return true;
    }
    __device__ __forceinline__ void a_ready(const Unit&) const {}
    __device__ __forceinline__ void done(const Unit&) const {}
};

template <class Epi>
__global__ void __launch_bounds__(512, 2) k_gemm(pg8::Gemm g, Epi E) {
    extern __shared__ __attribute__((aligned(16))) unsigned char lds[];
    pg8::StaticOrder S; S.init(g.M, g.N, (int)gridDim.x, (int)blockIdx.x);
    pg8::gemm_phase<Epi, pg8::StaticOrder, true, true>((PG8_LAS unsigned char*)lds, g, S, E);
}
template <class Epi>
__global__ void __launch_bounds__(512, 2) k_gemm_grouped(pg8::Gemm g, Epi E, const int* ctl  , int pass  ) {
    extern __shared__ __attribute__((aligned(16))) unsigned char lds[];
    GroupedOrder S; S.tile_expert = ctl + CI_TEXP; S.nN = g.N / 256; S.G = (int)gridDim.x; S.c = (int)blockIdx.x; S.tiles_per_expert = 4;
    const int nt0 = ctl[CI_NT], nt1 = ctl[CI_NT + 1];
    S.t_lo = (pass == 1) ? nt0 : 0; S.t_hi = (pass == 0) ? nt0 : nt1;
    pg8::gemm_phase<Epi, GroupedOrder, true, true>((PG8_LAS unsigned char*)lds, g, S, E);
}

struct WtJob { const float* src; bf16_t* dst; const float* gain; long sstride, dstride; int K, N, perm, pad; };
__global__ void __launch_bounds__(256) k_wt(WtJob j) {
    __shared__ float tile[64][65];
    const int n0 = blockIdx.x * 64, k0 = blockIdx.y * 64, b = blockIdx.z;
    const float* s = j.src + (size_t)b * j.sstride; bf16_t* d = j.dst + (size_t)b * j.dstride;
    const int tx = threadIdx.x & 63, ty = threadIdx.x >> 6;
    for (int i = ty; i < 64; i += 4) { const int k = k0 + i; const float g = j.gain ? j.gain[k] : 1.0f; tile[i][tx] = s[(size_t)k * j.N + n0 + tx] * g; }
    __syncthreads();
    for (int c = threadIdx.x; c < 512; c += 256) {
        const int n = c >> 3, ch = c & 7;
        u32x4 w; w.x = pk2(tile[ch * 8 + 0][n], tile[ch * 8 + 1][n]); w.y = pk2(tile[ch * 8 + 2][n], tile[ch * 8 + 3][n]);
        w.z = pk2(tile[ch * 8 + 4][n], tile[ch * 8 + 5][n]); w.w = pk2(tile[ch * 8 + 6][n], tile[ch * 8 + 7][n]);
        const int ns = n0 + n; int nd = ns;
        if (j.perm) { const int half = ns >> 9, jj = ns & 511; nd = (jj >> 7) * 256 + half * 128 + (jj & 127); }
        *(u32x4*)(d + (size_t)nd * j.K + k0 + ch * 8) = w;
    }
}
__global__ void __launch_bounds__(256) k_rowprep(const float* x, bf16_t* xb, float* ssq, int rows) {
    const int lane = threadIdx.x & 63, nw = gridDim.x * 4;
    for (int row = blockIdx.x * 4 + (threadIdx.x >> 6); row < rows; row += nw) {
        const f32x4* xr = (const f32x4*)(x + (size_t)row * DM) + lane; float s = 0.f;
        unsigned long long* o8 = (unsigned long long*)(xb + (size_t)row * DM) + lane;
#pragma unroll
        for (int jx = 0; jx < 4; ++jx) { const f32x4 v = xr[64 * jx]; s += (v.x * v.x + v.y * v.y) + (v.z * v.z + v.w * v.w);
            o8[64 * jx] = (unsigned long long)pk2(v.x, v.y) | ((unsigned long long)pk2(v.z, v.w) << 32); }
        s = wave_sum(s);
        if (lane < 16) ssq[(size_t)row * 16 + lane] = (lane == 0) ? s : 0.f;
    }
}
struct MiscArgs { double inv[8]; const float* norm_ffn; const float* w_group; const float* w_router; const float* lam; float* ropeC; float* ropeS; float* WR; float* lam_out; };
__device__ __forceinline__ void sincos_d(double a, float& c, float& s) {
    const double TWO_PI = 6.283185307179586476925286766559;
    const double n = __builtin_rint(a / TWO_PI); const double r = a - n * TWO_PI;
    const double r2 = r * r;
    double sp = 1.0, cp = 1.0;
#pragma unroll
    for (int k = 15; k >= 1; --k) { sp = 1.0 - r2 / (double)((2 * k) * (2 * k + 1)) * sp; cp = 1.0 - r2 / (double)((2 * k - 1) * (2 * k)) * cp; }
    s = (float)(r * sp); c = (float)cp;
}
__global__ void __launch_bounds__(256) k_misc(MiscArgs a) {
    const int gid = blockIdx.x * 256 + threadIdx.x, nth = gridDim.x * 256;
    for (int i = gid; i < SEQ * 8; i += nth) { const int pos = i >> 3, jx = i & 7; float c, s; sincos_d((double)pos * a.inv[jx], c, s); a.ropeC[i] = c; a.ropeS[i] = s; }
    for (int i = gid; i < 2 * 1024 * 36; i += nth) { const int l = i / (1024 * 36), r = i % (1024 * 36), k = r / 36, c = r % 36;
        const float g = a.norm_ffn[l * 1024 + k];
        a.WR[i] = g * (c < 4 ? a.w_group[(size_t)(l * 1024 + k) * 4 + c] : a.w_router[(size_t)(l * 1024 + k) * 32 + (c - 4)]); }
    if (gid == 0) { float s01 = 0.f, s23 = 0.f; for (int d = 0; d < 64; ++d) { s01 += a.lam[d] * a.lam[64 + d]; s23 += a.lam[128 + d] * a.lam[192 + d]; }
        a.lam_out[0] = expf(s01) - expf(s23) + 0.2f; }
}


namespace att {
#define ATT_LAS __attribute__((address_space(3)))
#define ATT_DI __device__ __forceinline__
typedef short bf16x8 __attribute__((ext_vector_type(8)));
typedef short s16x4 __attribute__((ext_vector_type(4)));
typedef float f32x16 __attribute__((ext_vector_type(16)));
typedef short v4i16_t __attribute__((ext_vector_type(4)));
typedef float f32x2_t __attribute__((ext_vector_type(2)));
typedef __bf16 bf16x2_t __attribute__((ext_vector_type(2)));
ATT_DI int crow(int reg, int h) { return (reg & 3) + 8 * (reg >> 2) + 4 * h; }
ATT_DI unsigned cvtpk(float lo, float hi) { f32x2_t v = {lo, hi}; bf16x2_t b = __builtin_convertvector(v, bf16x2_t); return __builtin_bit_cast(unsigned, b); }
ATT_DI s16x4 vtr(const ATT_LAS char* p) { return __builtin_bit_cast(s16x4, __builtin_amdgcn_ds_read_tr16_b64_v4i16((ATT_LAS v4i16_t*)p)); }
ATT_DI bf16x8 pack8(const f32x16& x, int s) {
    u32x4 p; p.x = cvtpk(x[8 * s + 0], x[8 * s + 1]); p.y = cvtpk(x[8 * s + 2], x[8 * s + 3]); p.z = cvtpk(x[8 * s + 4], x[8 * s + 5]); p.w = cvtpk(x[8 * s + 6], x[8 * s + 7]);
    return __builtin_bit_cast(bf16x8, p);
}
struct L256 { static constexpr int PITCH = 256; static ATT_DI int addr(int row, int byte) { return row * 256 + ((((byte >> 4) ^ (row & 15)) << 4) | (byte & 15)); } };
struct LPAD { static constexpr int PITCH = 144; static ATT_DI int addr(int row, int byte) { return row * 144 + byte; } };

template <int NKS, int NDB, class KLay, class Lay, bool MASK>
ATT_DI void tile64(const ATT_LAS char* kt, const ATT_LAS char* vt, int kcb, int vcb, const bf16x8 (&qf)[NKS], float& m, float& l, f32x16 (&O)[NDB], float c,
                   int r, int h, int g1, int tq, int tp, int qpos, int kpos0, int win) {
    f32x16 p0, p1;
#pragma unroll
    for (int i = 0; i < 16; ++i) { p0[i] = 0.f; p1[i] = 0.f; }
#pragma unroll
    for (int s = 0; s < NKS; ++s) {
        const bf16x8 a0 = *(const ATT_LAS bf16x8*)(kt + KLay::addr(r, kcb + 32 * s + 16 * h));
        const bf16x8 a1 = *(const ATT_LAS bf16x8*)(kt + KLay::addr(32 + r, kcb + 32 * s + 16 * h));
        p0 = __builtin_amdgcn_mfma_f32_32x32x16_bf16(a0, qf[s], p0, 0, 0, 0);
        p1 = __builtin_amdgcn_mfma_f32_32x32x16_bf16(a1, qf[s], p1, 0, 0, 0);
    }
    if (MASK) {
#pragma unroll
        for (int i = 0; i < 16; ++i) {
            const int k0 = kpos0 + crow(i, h), k1 = k0 + 32;
            if (k0 > qpos || k0 <= qpos - win || k0 < 0) p0[i] = -INFINITY;
            if (k1 > qpos || k1 <= qpos - win || k1 < 0) p1[i] = -INFINITY;
        }
    }
    float mx = fmaxf(p0[0], p1[0]);
#pragma unroll
    for (int i = 1; i < 16; ++i) mx = fmaxf(mx, fmaxf(p0[i], p1[i]));
    mx = fmaxf(mx, __shfl_xor(mx, 32));
    const float mn = fmaxf(m, mx * c);
    const float ms = (mn == -INFINITY) ? 0.f : mn;
    const float corr = __builtin_amdgcn_exp2f(m - ms);
    m = mn;
    float ls = 0.f;
#pragma unroll
    for (int i = 0; i < 16; ++i) { p0[i] = __builtin_amdgcn_exp2f(fmaf(p0[i], c, -ms)); p1[i] = __builtin_amdgcn_exp2f(fmaf(p1[i], c, -ms)); ls += p0[i] + p1[i]; }
    l = l * corr + ls;
#pragma unroll
    for (int db = 0; db < NDB; ++db) O[db] = O[db] * corr;
    bf16x8 pf[4]; pf[0] = pack8(p0, 0); pf[1] = pack8(p0, 1); pf[2] = pack8(p1, 0); pf[3] = pack8(p1, 1);
#pragma unroll
    for (int db = 0; db < NDB; ++db)
#pragma unroll
        for (int ks = 0; ks < 4; ++ks) {
            const int rowl = (ks >> 1) * 32 + (ks & 1) * 16 + 4 * h + tq, colb = vcb + (db * 32 + 16 * g1 + 4 * tp) * 2;
            const s16x4 lo = vtr(vt + Lay::addr(rowl, colb)), hi = vtr(vt + Lay::addr(rowl + 8, colb));
            const bf16x8 a = __builtin_shufflevector(lo, hi, 0, 1, 2, 3, 4, 5, 6, 7);
            O[db] = __builtin_amdgcn_mfma_f32_32x32x16_bf16(a, pf[ks], O[db], 0, 0, 0);
        }
}
template <int NKS> ATT_DI void load_q(bf16x8 (&qf)[NKS], const bf16_t* qrow  , int h) {
#pragma unroll
    for (int s = 0; s < NKS; ++s) qf[s] = *(const bf16x8*)(qrow + 16 * s + 8 * h);
}
template <int NDB> ATT_DI void store_o(const f32x16 (&O)[NDB], float l, bf16_t* orow, int h) {
    const float il = 1.0f / (l + __shfl_xor(l, 32));
#pragma unroll
    for (int db = 0; db < NDB; ++db)
#pragma unroll
        for (int g = 0; g < 4; ++g) {
            const unsigned w0 = cvtpk(O[db][4 * g] * il, O[db][4 * g + 1] * il), w1 = cvtpk(O[db][4 * g + 2] * il, O[db][4 * g + 3] * il);
            *(unsigned long long*)(orow + db * 32 + 8 * g + 4 * h) = (unsigned long long)w0 | ((unsigned long long)w1 << 32);
        }
}

ATT_DI void xattn_unit(ATT_LAS char* lds, const bf16_t* QX, const bf16_t* MKV, bf16_t* OX, int unit) {
    const int tid = threadIdx.x, lane = tid & 63, w = tid >> 6, r = lane & 31, h = lane >> 5, g1 = (lane >> 4) & 1, tq = (lane & 15) >> 2, tp = lane & 3;
    const int b = unit >> 4, hd = (unit >> 2) & 3, part = unit & 3;
    __syncthreads();
    for (int cidx = tid; cidx < 256 * 16; cidx += 512) { const int row = cidx >> 4, ch = cidx & 15;
        const bf16_t* src = MKV + (size_t)(b * MEML + row) * 1024 + hd * 128 + ch * 8;
        const u32x4 kv = *(const u32x4*)src, vv = *(const u32x4*)(src + 512);
        *(ATT_LAS u32x4*)(lds + L256::addr(row, ch * 16)) = kv; *(ATT_LAS u32x4*)(lds + 65536 + L256::addr(row, ch * 16)) = vv; }
    __syncthreads();
    const float c = LOG2E * 0.08838834764831845f;
#pragma unroll 1
    for (int qb = 0; qb < 2; ++qb) {
        const size_t tok = (size_t)b * SEQ + part * 512 + qb * 256 + w * 32 + r;
        bf16x8 qf[8]; load_q<8>(qf, QX + tok * 512 + hd * 128, h);
        float m = -INFINITY, l = 0.f; f32x16 O[4];
#pragma unroll
        for (int db = 0; db < 4; ++db)
#pragma unroll
            for (int i = 0; i < 16; ++i) O[db][i] = 0.f;
#pragma unroll 1
        for (int kt = 0; kt < 4; ++kt)
            tile64<8, 4, L256, L256, false>(lds + kt * 64 * 256, lds + 65536 + kt * 64 * 256, 0, 0, qf, m, l, O, c, r, h, g1, tq, tp, 0, 0, 0);
        store_o<4>(O, l, OX + tok * 512 + hd * 128, h);
    }
}
ATT_DI void swa_unit(ATT_LAS char* lds, const bf16_t* P  , const float* sinks, bf16_t* Y, int unit) {
    const int tid = threadIdx.x, lane = tid & 63, w = tid >> 6, r = lane & 31, h = lane >> 5, g1 = (lane >> 4) & 1, tq = (lane & 15) >> 2, tp = lane & 3;
    const int b = unit >> 5, kvh = (unit >> 3) & 3, qb = unit & 7, q0 = qb * 256;
    constexpr int VOFF = 384 * 144;
    __syncthreads();
    for (int cidx = tid; cidx < 384 * 8; cidx += 512) { const int row = cidx >> 3, ch = cidx & 7; const int kpos = q0 - 128 + row;
        u32x4 kv = (u32x4){0u, 0u, 0u, 0u}, vv = kv;
        if (kpos >= 0) { const bf16_t* src = P + (size_t)(b * SEQ + kpos) * 1536 + 1024 + kvh * 64 + ch * 8; kv = *(const u32x4*)src; vv = *(const u32x4*)(src + 256); }
        *(ATT_LAS u32x4*)(lds + LPAD::addr(row, ch * 16)) = kv; *(ATT_LAS u32x4*)(lds + VOFF + LPAD::addr(row, ch * 16)) = vv; }
    __syncthreads();
    const float c = LOG2E * 0.125f;
    const int qpos = q0 + w * 32 + r; const size_t tok = (size_t)b * SEQ + qpos;
    const int t0 = (32 * w + 1) >> 6;
#pragma unroll 1
    for (int g = 0; g < 4; ++g) {
        const int hq = kvh * 4 + g;
        bf16x8 qf[4]; load_q<4>(qf, P + tok * 1536 + hq * 64, h);
        float m = sinks[hq] * LOG2E, l = (h == 0) ? 1.f : 0.f; f32x16 O[2];
#pragma unroll
        for (int db = 0; db < 2; ++db)
#pragma unroll
            for (int i = 0; i < 16; ++i) O[db][i] = 0.f;
#pragma unroll 1
        for (int t = t0; t < t0 + 3; ++t)
            tile64<4, 2, LPAD, LPAD, true>(lds + t * 64 * 144, lds + VOFF + t * 64 * 144, 0, 0, qf, m, l, O, c, r, h, g1, tq, tp, qpos, q0 - 128 + t * 64, 128);
        store_o<2>(O, l, Y + tok * 1024 + hq * 64, h);
    }
}
constexpr int DKB = 64 * 144, DBUF = DKB + 16384;
ATT_DI void diff_pass(ATT_LAS char* lds, const bf16_t* P, int b, int hd, int qb, int mp, f32x16 (&O)[4], float& lsum) {
    const int tid = threadIdx.x, lane = tid & 63, w = tid >> 6, r = lane & 31, h = lane >> 5, g1 = (lane >> 4) & 1, tq = (lane & 15) >> 2, tp = lane & 3;
    const int q0 = qb * 256, NT = 4 * (qb + 1);
    const int qpos = q0 + w * 32 + r; const size_t tok = (size_t)b * SEQ + qpos;
    const int qmax_w = q0 + w * 32 + 31, qmin_w = q0 + w * 32;
    const float c = LOG2E * 0.125f;
    bf16x8 qf[4]; load_q<4>(qf, P + tok * 3072 + 1536 + hd * 128 + mp * 64, h);
    float m = -INFINITY, l = 0.f;
#pragma unroll
    for (int db = 0; db < 4; ++db)
#pragma unroll
        for (int i = 0; i < 16; ++i) O[db][i] = 0.f;
    const int srow = tid >> 3, sc1 = tid & 7;
    const bf16_t* sbase = P + (size_t)(b * SEQ + srow) * 3072 + hd * 128;
    u32x4 st[3];
    st[0] = *(const u32x4*)(sbase + 2048 + mp * 64 + sc1 * 8); st[1] = *(const u32x4*)(sbase + 2560 + sc1 * 16); st[2] = *(const u32x4*)(sbase + 2560 + sc1 * 16 + 8);
    __syncthreads();
    *(ATT_LAS u32x4*)(lds + LPAD::addr(srow, sc1 * 16)) = st[0];
    *(ATT_LAS u32x4*)(lds + DKB + L256::addr(srow, sc1 * 32)) = st[1]; *(ATT_LAS u32x4*)(lds + DKB + L256::addr(srow, sc1 * 32 + 16)) = st[2];
    __syncthreads();
#pragma unroll 1
    for (int kt = 0; kt < NT; ++kt) {
        const bool more = (kt + 1 < NT);
        if (more) { const bf16_t* s2 = sbase + (size_t)(kt + 1) * 64 * 3072;
            st[0] = *(const u32x4*)(s2 + 2048 + mp * 64 + sc1 * 8); st[1] = *(const u32x4*)(s2 + 2560 + sc1 * 16); st[2] = *(const u32x4*)(s2 + 2560 + sc1 * 16 + 8); }
        const ATT_LAS char* kb = lds + (kt & 1) * DBUF; const ATT_LAS char* vb = kb + DKB;
        if (kt * 64 <= qmax_w) {
            if (kt * 64 + 63 > qmin_w) tile64<4, 4, LPAD, L256, true>(kb, vb, 0, 0, qf, m, l, O, c, r, h, g1, tq, tp, qpos, kt * 64, 1 << 30);
            else                       tile64<4, 4, LPAD, L256, false>(kb, vb, 0, 0, qf, m, l, O, c, r, h, g1, tq, tp, qpos, kt * 64, 1 << 30);
        }
        if (more) { ATT_LAS char* d = lds + ((kt + 1) & 1) * DBUF;
            *(ATT_LAS u32x4*)(d + LPAD::addr(srow, sc1 * 16)) = st[0];
            *(ATT_LAS u32x4*)(d + DKB + L256::addr(srow, sc1 * 32)) = st[1]; *(ATT_LAS u32x4*)(d + DKB + L256::addr(srow, sc1 * 32 + 16)) = st[2]; }
        __syncthreads();
    }
    lsum = l + __shfl_xor(l, 32);
}
ATT_DI void diff_unit(ATT_LAS char* lds, const bf16_t* P  , const float* subln, float lam, bf16_t* Y, float* park  , int b, int hd, int qb) {
    const int tid = threadIdx.x, lane = tid & 63, w = tid >> 6, r = lane & 31, h = lane >> 5;
    const size_t tok = (size_t)b * SEQ + qb * 256 + w * 32 + r;
    f32x4* pk = (f32x4*)(park + ((tok * 4 + hd) * 2 + h) * 64);
    f32x16 O0[4], O1[4]; float l0, l1;
    diff_pass(lds, P, b, hd, qb, 0, O0, l0);
    { const float i0 = 1.0f / l0;
#pragma unroll
      for (int db = 0; db < 4; ++db)
#pragma unroll
          for (int g = 0; g < 4; ++g) pk[db * 4 + g] = (f32x4){O0[db][4 * g] * i0, O0[db][4 * g + 1] * i0, O0[db][4 * g + 2] * i0, O0[db][4 * g + 3] * i0}; }
    diff_pass(lds, P, b, hd, qb, 1, O1, l1);
#pragma unroll
    for (int db = 0; db < 4; ++db)
#pragma unroll
        for (int g = 0; g < 4; ++g) { const f32x4 v = pk[db * 4 + g]; O0[db][4 * g] = v.x; O0[db][4 * g + 1] = v.y; O0[db][4 * g + 2] = v.z; O0[db][4 * g + 3] = v.w; }
    const float i1 = lam / l1;
    float ss = 0.f;
#pragma unroll
    for (int db = 0; db < 4; ++db)
#pragma unroll
        for (int i = 0; i < 16; ++i) { const float o = O0[db][i] - O1[db][i] * i1; O0[db][i] = o; ss += o * o; }
    ss += __shfl_xor(ss, 32);
    const float rs = 0.8f / sqrtf(ss * (1.0f / 128.0f) + EPS);
    bf16_t* orow = Y + tok * 1024 + 512 + hd * 128;
#pragma unroll
    for (int db = 0; db < 4; ++db)
#pragma unroll
        for (int g = 0; g < 4; ++g) { const int d = db * 32 + 8 * g + 4 * h; const f32x4 gg = *(const f32x4*)(subln + d);
            const unsigned w0 = cvtpk(O0[db][4 * g] * rs * gg.x, O0[db][4 * g + 1] * rs * gg.y), w1 = cvtpk(O0[db][4 * g + 2] * rs * gg.z, O0[db][4 * g + 3] * rs * gg.w);
            *(unsigned long long*)(orow + d) = (unsigned long long)w0 | ((unsigned long long)w1 << 32); }
}
ATT_DI void conv_tokens(const bf16_t* P, const float* convw, bf16_t* Y, int tok0  ) {
    const int tid = threadIdx.x, cg = tid & 63, run = tid >> 6, c0 = cg * 8;
    float w[3][8];
#pragma unroll
    for (int j = 0; j < 3; ++j) { const f32x4 a = *(const f32x4*)(convw + j * 512 + c0), b2 = *(const f32x4*)(convw + j * 512 + c0 + 4);
        w[j][0] = a.x; w[j][1] = a.y; w[j][2] = a.z; w[j][3] = a.w; w[j][4] = b2.x; w[j][5] = b2.y; w[j][6] = b2.z; w[j][7] = b2.w; }
    const int tfirst = tok0 + run * 16;
    float z1[8], z2[8];
#pragma unroll
    for (int i = 0; i < 8; ++i) { z1[i] = 0.f; z2[i] = 0.f; }
#pragma unroll 1
    for (int tt = -2; tt < 16; ++tt) {
        const int tok = tfirst + tt;
        float z0[8];
        const bool inseq = ((tfirst & (SEQ - 1)) + tt) >= 0;
        if (inseq) { const bf16_t* pr = P + (size_t)tok * 3072; const u32x4 gc = *(const u32x4*)(pr + 512 + c0), uu = *(const u32x4*)(pr + 1024 + c0);
            z0[0] = bflo(gc.x) * bflo(uu.x); z0[1] = bfhi(gc.x) * bfhi(uu.x); z0[2] = bflo(gc.y) * bflo(uu.y); z0[3] = bfhi(gc.y) * bfhi(uu.y);
            z0[4] = bflo(gc.z) * bflo(uu.z); z0[5] = bfhi(gc.z) * bfhi(uu.z); z0[6] = bflo(gc.w) * bflo(uu.w); z0[7] = bfhi(gc.w) * bfhi(uu.w); }
        else {
#pragma unroll
            for (int i = 0; i < 8; ++i) z0[i] = 0.f; }
        if (tt >= 0) { const u32x4 gb = *(const u32x4*)(P + (size_t)tok * 3072 + c0); float y[8];
            const float gbf[8] = {bflo(gb.x), bfhi(gb.x), bflo(gb.y), bfhi(gb.y), bflo(gb.z), bfhi(gb.z), bflo(gb.w), bfhi(gb.w)};
#pragma unroll
            for (int i = 0; i < 8; ++i) y[i] = gbf[i] * (w[0][i] * z2[i] + w[1][i] * z1[i] + w[2][i] * z0[i]);
            u32x4 o; o.x = pk2(y[0], y[1]); o.y = pk2(y[2], y[3]); o.z = pk2(y[4], y[5]); o.w = pk2(y[6], y[7]);
            *(u32x4*)(Y + (size_t)tok * 1024 + c0) = o; }
#pragma unroll
        for (int i = 0; i < 8; ++i) { z2[i] = z1[i]; z1[i] = z0[i]; }
    }
}
}

__global__ void __launch_bounds__(512, 2) k_xattn(const bf16_t* QX, const bf16_t* MKV, bf16_t* OX) {
    extern __shared__ __attribute__((aligned(16))) unsigned char lds[];
    for (int u = blockIdx.x; u < 256; u += gridDim.x) att::xattn_unit((ATT_LAS char*)lds, QX, MKV, OX, u);
}
__global__ void __launch_bounds__(512, 2) k_swa(const bf16_t* P, const float* sinks, bf16_t* Y) {
    extern __shared__ __attribute__((aligned(16))) unsigned char lds[];
    for (int u = blockIdx.x; u < 512; u += gridDim.x) att::swa_unit((ATT_LAS char*)lds, P, sinks, Y, u);
}
__global__ void __launch_bounds__(512, 2) k_diff(const bf16_t* P, const float* subln, const float* lam, const float* convw, bf16_t* Y, float* park) {
    extern __shared__ __attribute__((aligned(16))) unsigned char lds[];
    const float lamv = lam[0];
    for (int cu = blockIdx.x; cu < 256; cu += gridDim.x) {
        const int bh = cu >> 2, j = cu & 3;
        att::diff_unit((ATT_LAS char*)lds, P, subln, lamv, Y, park, bh >> 2, bh & 3, 7 - j);
        att::diff_unit((ATT_LAS char*)lds, P, subln, lamv, Y, park, bh >> 2, bh & 3, j);
        att::conv_tokens(P, convw, Y, cu * 128);
    }
}

__global__ void __launch_bounds__(256) k_route(const float* x, const float* ssq, const float* WR, const float* bg, const float* br, int* ctl, int* route_e, float* route_w, float* rs_tok, int* tok_of_slot) {
    const int lane = threadIdx.x & 63, nw = gridDim.x * 4;
    for (int i = blockIdx.x * 256 + threadIdx.x; i < SPAD; i += gridDim.x * 256) tok_of_slot[i] = -1;
    for (int tok = blockIdx.x * 4 + (threadIdx.x >> 6); tok < T_TOK; tok += nw) {
        float acc[36];
#pragma unroll
        for (int c = 0; c < 36; ++c) acc[c] = 0.f;
        for (int i = 0; i < 16; ++i) { const int k = lane + 64 * i; const float xv = x[(size_t)tok * DM + k]; const f32x4* w = (const f32x4*)(WR + (size_t)k * 36);
#pragma unroll
            for (int c4 = 0; c4 < 9; ++c4) { const f32x4 ww = w[c4]; acc[4 * c4] += xv * ww.x; acc[4 * c4 + 1] += xv * ww.y; acc[4 * c4 + 2] += xv * ww.z; acc[4 * c4 + 3] += xv * ww.w; } }
#pragma unroll
        for (int c = 0; c < 36; ++c) acc[c] = wave_sum(acc[c]);
        const float rs = row_rs(ssq, tok);
        float lg[4];
#pragma unroll
        for (int g = 0; g < 4; ++g) lg[g] = acc[g] * rs + bg[g];
        int gs = 0; float gm = lg[0];
#pragma unroll
        for (int g = 1; g < 4; ++g) if (lg[g] > gm) { gm = lg[g]; gs = g; }
        float gsum = 0.f;
#pragma unroll
        for (int g = 0; g < 4; ++g) gsum += expf(lg[g] - gm);
        const float p_g = 1.0f / gsum;
        float le[8];
#pragma unroll
        for (int e = 0; e < 8; ++e) { const float v = (gs == 0) ? acc[4 + e] : (gs == 1) ? acc[12 + e] : (gs == 2) ? acc[20 + e] : acc[28 + e]; le[e] = v * rs + br[gs * 8 + e]; }
        int i1 = 0; float m1 = le[0];
#pragma unroll
        for (int e = 1; e < 8; ++e) if (le[e] > m1) { m1 = le[e]; i1 = e; }
        int i2 = -1; float m2 = -INFINITY;
#pragma unroll
        for (int e = 0; e < 8; ++e) if (e != i1 && le[e] > m2) { m2 = le[e]; i2 = e; }
        const float e2 = expf(m2 - m1); const float w1 = p_g / (1.0f + e2), w2 = p_g * e2 / (1.0f + e2);
        if (lane == 0) {
            const int ex1 = gs * 8 + i1, ex2 = gs * 8 + i2;
            route_e[tok * 2] = ex1; route_e[tok * 2 + 1] = ex2; route_w[tok * 2] = w1; route_w[tok * 2 + 1] = w2; rs_tok[tok] = rs;
            atomicAdd(ctl + CI_CNT + ex1, 1); atomicAdd(ctl + CI_CNT + 32 + ex2, 1);
        }
    }
}
__global__ void __launch_bounds__(64) k_offsets(int* ctl) {
    __shared__ int tiles[64];
    const int L = threadIdx.x; tiles[L] = (ctl[CI_CNT + L] + 255) >> 8;
    __syncthreads();
    int base = 0; for (int i = 0; i < L; ++i) base += tiles[i];
    ctl[CI_LBASE + L] = base * 256; ctl[CI_CUR + L] = 0;
    for (int i = 0; i < tiles[L]; ++i) ctl[CI_TEXP + base + i] = L & 31;
    if (L == 31) ctl[CI_NT] = base + tiles[L];
    if (L == 63) ctl[CI_NT + 1] = base + tiles[L];
}
__global__ void __launch_bounds__(256) k_place(const bf16_t* xb, int* ctl, const int* route_e, const float* route_w, const float* rs_tok, int* tok_of_slot, float* w_of_slot, float* rs_of_slot, bf16_t* xs) {
    const int lane = threadIdx.x & 63, nw = gridDim.x * 4;
    for (int tok = blockIdx.x * 4 + (threadIdx.x >> 6); tok < T_TOK; tok += nw) {
        const u32x4* src = (const u32x4*)(xb + (size_t)tok * DM); const u32x4 v0 = src[lane], v1 = src[lane + 64];
#pragma unroll
        for (int k = 0; k < 2; ++k) {
            const int L = k * 32 + route_e[tok * 2 + k]; int slot = 0;
            if (lane == 0) slot = ctl[CI_LBASE + L] + atomicAdd(ctl + CI_CUR + L, 1);
            slot = __shfl(slot, 0);
            if (lane == 0) { tok_of_slot[slot] = tok; w_of_slot[slot] = route_w[tok * 2 + k]; rs_of_slot[slot] = rs_tok[tok]; }
            u32x4* dst = (u32x4*)(xs + (size_t)slot * DM); dst[lane] = v0; dst[lane + 64] = v1;
        }
    }
}
__global__ void __launch_bounds__(256) k_final(const float* x, const float* g, float* out) {
    const int lane = threadIdx.x & 63, nw = gridDim.x * 4;
    for (int row = blockIdx.x * 4 + (threadIdx.x >> 6); row < T_TOK; row += nw) {
        const f32x4* xr = (const f32x4*)(x + (size_t)row * DM) + lane; f32x4 v[4]; float s = 0.f;
#pragma unroll
        for (int jx = 0; jx < 4; ++jx) { v[jx] = xr[64 * jx]; s += (v[jx].x * v[jx].x + v[jx].y * v[jx].y) + (v[jx].z * v[jx].z + v[jx].w * v[jx].w); }
        const float rs = 1.0f / sqrtf(wave_sum(s) * (1.0f / 1024.0f) + EPS);
        f32x4* orow = (f32x4*)(out + (size_t)row * DM) + lane; const f32x4* gr = (const f32x4*)g + lane;
#pragma unroll
        for (int jx = 0; jx < 4; ++jx) orow[64 * jx] = v[jx] * rs * gr[64 * jx];
    }
}

template <class Epi> static void launch_gemm(hipStream_t st, const bf16_t* A, const bf16_t* Bt, int M, int N, int K, const Epi& E) {
    static bool init = false;
    if (!init) { (void)hipFuncSetAttribute((const void*)k_gemm<Epi>, hipFuncAttributeMaxDynamicSharedMemorySize, pg8::STAGE_BYTES); init = true; }
    pg8::Gemm g{A, Bt, M, N, K, 0};
    hipLaunchKernelGGL(k_gemm<Epi>, dim3(256), dim3(512), pg8::STAGE_BYTES, st, g, E);
}
template <class Epi> static void launch_gemm_grouped(hipStream_t st, const bf16_t* A, const bf16_t* Bt, int N, int K, const Epi& E, const int* ctl, int pass) {
    static bool init = false;
    if (!init) { (void)hipFuncSetAttribute((const void*)k_gemm_grouped<Epi>, hipFuncAttributeMaxDynamicSharedMemorySize, pg8::STAGE_BYTES); init = true; }
    pg8::Gemm g{A, Bt, SPAD, N, K, 0};
    hipLaunchKernelGGL(k_gemm_grouped<Epi>, dim3(256), dim3(512), pg8::STAGE_BYTES, st, g, E, ctl, pass);
}
static void launch_wt(hipStream_t st, const float* src, bf16_t* dst, const float* gain, int K, int N, int nb, int perm) {
    WtJob j{}; j.src = src; j.dst = dst; j.gain = gain; j.sstride = (long)K * N; j.dstride = (long)K * N; j.K = K; j.N = N; j.perm = perm; j.pad = 0;
    hipLaunchKernelGGL(k_wt, dim3(N / 64, K / 64, nb), dim3(256), 0, st, j);
}

extern "C" void kernel_launch(void* const* d_in, const int* in_sizes, int n_in, void* d_out, int out_size, void* d_ws, size_t ws_size, hipStream_t stream) {
    if (n_in != 26 || ws_size < WS_END) { fprintf(stderr, "kernel_launch: unexpected n_in %d / ws %zu\n", n_in, ws_size); return; }
    const float* x = (const float*)d_in[0]; const float* mem = (const float*)d_in[1]; const float* mem_norm = (const float*)d_in[2]; const float* mem_w_kv = (const float*)d_in[3];
    const float* norm_mix = (const float*)d_in[4]; const float* norm_xattn = (const float*)d_in[5]; const float* norm_ffn = (const float*)d_in[6];
    const float* hyb_w_in = (const float*)d_in[7]; const float* hyb_conv_w = (const float*)d_in[8]; const float* diff_lambda = (const float*)d_in[9]; const float* diff_subln = (const float*)d_in[10];
    const float* hyb_w_out = (const float*)d_in[11]; const float* swa_w_qkv = (const float*)d_in[12]; const float* swa_b_qkv = (const float*)d_in[13]; const float* swa_sinks = (const float*)d_in[14];
    const float* swa_w_out = (const float*)d_in[15]; const float* swa_b_out = (const float*)d_in[16]; const float* xattn_w_q = (const float*)d_in[17]; const float* xattn_w_o = (const float*)d_in[18];
    const float* moe_w_group = (const float*)d_in[19]; const float* moe_b_group = (const float*)d_in[20]; const float* moe_w_router = (const float*)d_in[21]; const float* moe_b_router = (const float*)d_in[22];
    const float* moe_w_gate_up = (const float*)d_in[23]; const float* moe_w_down = (const float*)d_in[24]; const float* final_norm = (const float*)d_in[25];
    unsigned char* ws = (unsigned char*)d_ws; float* out = (float*)d_out;
    int* ctl = (int*)(ws + WS_CTL);
    float* ropeC = (float*)(ws + WS_ROPEC); float* ropeS = (float*)(ws + WS_ROPES); float* WR = (float*)(ws + WS_WR); float* lam = (float*)(ws + WS_LAM);
    float* ssq = (float*)(ws + WS_SSQ); float* ssqm = (float*)(ws + WS_SSQM);
    int* tok_of_slot = (int*)(ws + WS_TOKSLOT); float* w_of_slot = (float*)(ws + WS_WSLOT); float* rs_of_slot = (float*)(ws + WS_RSSLOT);
    int* route_e = (int*)(ws + WS_ROUTE_E); float* route_w = (float*)(ws + WS_ROUTE_W); float* rs_tok = (float*)(ws + WS_RSTOK);
    bf16_t* memb = (bf16_t*)(ws + WS_MEMB); bf16_t* mkv = (bf16_t*)(ws + WS_MKV);
    bf16_t* Wmem = (bf16_t*)(ws + WS_WMEM); bf16_t* Win = (bf16_t*)(ws + WS_WIN); bf16_t* Wout0 = (bf16_t*)(ws + WS_WOUT0); bf16_t* Wqkv = (bf16_t*)(ws + WS_WQKV); bf16_t* Wout1 = (bf16_t*)(ws + WS_WOUT1);
    bf16_t* Wq = (bf16_t*)(ws + WS_WQ); bf16_t* Wo = (bf16_t*)(ws + WS_WO); bf16_t* Wgu = (bf16_t*)(ws + WS_WGU); bf16_t* Wdn = (bf16_t*)(ws + WS_WDN);
    float* XA = (float*)(ws + WS_XA); bf16_t* XBF = (bf16_t*)(ws + WS_XBF); bf16_t* Y = (bf16_t*)(ws + WS_Y); bf16_t* QX = (bf16_t*)(ws + WS_QX); bf16_t* OX = (bf16_t*)(ws + WS_OX);
    bf16_t* P = (bf16_t*)(ws + WS_U1); bf16_t* XS = (bf16_t*)(ws + WS_U1); float* ORAW = (float*)(ws + WS_U2); bf16_t* HID = (bf16_t*)(ws + WS_U2);

    { static bool init = false; if (!init) { init = true;
        (void)hipFuncSetAttribute((const void*)k_xattn, hipFuncAttributeMaxDynamicSharedMemorySize, 131072);
        (void)hipFuncSetAttribute((const void*)k_swa, hipFuncAttributeMaxDynamicSharedMemorySize, 2 * 384 * 144);
        (void)hipFuncSetAttribute((const void*)k_diff, hipFuncAttributeMaxDynamicSharedMemorySize, 65536); } }
    (void)hipMemsetAsync(ws + WS_CTL, 0, CTL_ZERO_BYTES, stream);
    launch_wt(stream, mem_w_kv, Wmem, mem_norm, 1024, 1024, 1, 0);
    launch_wt(stream, hyb_w_in, Win, norm_mix, 1024, 3072, 1, 0);
    launch_wt(stream, hyb_w_out, Wout0, nullptr, 1024, 1024, 1, 0);
    launch_wt(stream, swa_w_qkv, Wqkv, norm_mix + 1024, 1024, 1536, 1, 0);
    launch_wt(stream, swa_w_out, Wout1, nullptr, 1024, 1024, 1, 0);
    for (int l = 0; l < 2; ++l) {
        launch_wt(stream, xattn_w_q + (size_t)l * 1024 * 512, Wq + (size_t)l * 512 * 1024, norm_xattn + l * 1024, 1024, 512, 1, 0);
        launch_wt(stream, xattn_w_o + (size_t)l * 512 * 1024, Wo + (size_t)l * 1024 * 512, nullptr, 512, 1024, 1, 0);
        launch_wt(stream, moe_w_gate_up + (size_t)l * 32 * 1024 * 1024, Wgu + (size_t)l * 32 * 1024 * 1024, norm_ffn + l * 1024, 1024, 1024, 32, 1);
        launch_wt(stream, moe_w_down + (size_t)l * 32 * 512 * 1024, Wdn + (size_t)l * 32 * 1024 * 512, nullptr, 512, 1024, 32, 0);
    }
    { MiscArgs a{}; for (int jx = 0; jx < 8; ++jx) a.inv[jx] = pow(500000.0, -(double)(2 * jx) / 16.0);
      a.norm_ffn = norm_ffn; a.w_group = moe_w_group; a.w_router = moe_w_router; a.lam = diff_lambda; a.ropeC = ropeC; a.ropeS = ropeS; a.WR = WR; a.lam_out = lam;
      hipLaunchKernelGGL(k_misc, dim3(128), dim3(256), 0, stream, a); }
    hipLaunchKernelGGL(k_rowprep, dim3(2048), dim3(256), 0, stream, x, XBF, ssq, T_TOK);
    hipLaunchKernelGGL(k_rowprep, dim3(1024), dim3(256), 0, stream, mem, memb, ssqm, TMEM);
    { EpiProj E{}; E.O = mkv; E.ssq = ssqm; E.bias = nullptr; E.ropeC = ropeC; E.ropeS = ropeS; E.ldc = 1024; E.rope_lo = 0; E.rope_hi = 0; E.pad = 0;
      launch_gemm(stream, memb, Wmem, TMEM, 1024, 1024, E); }
    for (int l = 0; l < 2; ++l) {
        int* lctl = ctl + l * CI_STRIDE;
        if (l == 0) {
            { EpiProj E{}; E.O = P; E.ssq = ssq; E.bias = nullptr; E.ropeC = ropeC; E.ropeS = ropeS; E.ldc = 3072; E.rope_lo = 1536; E.rope_hi = 2560; E.pad = 0;
              launch_gemm(stream, XBF, Win, T_TOK, 3072, 1024, E); }
            hipLaunchKernelGGL(k_diff, dim3(256), dim3(512), 65536, stream, (const bf16_t*)P, diff_subln, (const float*)lam, hyb_conv_w, Y, ORAW);
            { EpiResid E{}; E.xin = x; E.xout = XA; E.xb = XBF; E.ssq = ssq; E.bias = nullptr;
              launch_gemm(stream, Y, Wout0, T_TOK, 1024, 1024, E); }
        } else {
            { EpiProj E{}; E.O = P; E.ssq = ssq; E.bias = swa_b_qkv; E.ropeC = ropeC; E.ropeS = ropeS; E.ldc = 1536; E.rope_lo = 0; E.rope_hi = 1280; E.pad = 0;
              launch_gemm(stream, XBF, Wqkv, T_TOK, 1536, 1024, E); }
            hipLaunchKernelGGL(k_swa, dim3(256), dim3(512), 2 * 384 * 144, stream, (const bf16_t*)P, swa_sinks, Y);
            { EpiResid E{}; E.xin = XA; E.xout = XA; E.xb = XBF; E.ssq = ssq; E.bias = swa_b_out;
              launch_gemm(stream, Y, Wout1, T_TOK, 1024, 1024, E); }
        }
        { EpiProj E{}; E.O = QX; E.ssq = ssq; E.bias = nullptr; E.ropeC = ropeC; E.ropeS = ropeS; E.ldc = 512; E.rope_lo = 0; E.rope_hi = 0; E.pad = 0;
          launch_gemm(stream, XBF, Wq + (size_t)l * 512 * 1024, T_TOK, 512, 1024, E); }
        hipLaunchKernelGGL(k_xattn, dim3(256), dim3(512), 131072, stream, (const bf16_t*)QX, (const bf16_t*)mkv, OX);
        { EpiResid E{}; E.xin = XA; E.xout = XA; E.xb = XBF; E.ssq = ssq; E.bias = nullptr;
          launch_gemm(stream, OX, Wo + (size_t)l * 1024 * 512, T_TOK, 1024, 512, E); }
        hipLaunchKernelGGL(k_route, dim3(2048), dim3(256), 0, stream, (const float*)XA, (const float*)ssq, (const float*)(WR + (size_t)l * 1024 * 36), moe_b_group + l * 4, moe_b_router + l * 32,
                           lctl, route_e, route_w, rs_tok, tok_of_slot);
        hipLaunchKernelGGL(k_offsets, dim3(1), dim3(64), 0, stream, lctl);
        hipLaunchKernelGGL(k_place, dim3(2048), dim3(256), 0, stream, (const bf16_t*)XBF, lctl, (const int*)route_e, (const float*)route_w, (const float*)rs_tok, tok_of_slot, w_of_slot, rs_of_slot, XS);
        { EpiGateUp E{}; E.hid = HID; E.rs_slot = rs_of_slot;
          launch_gemm_grouped(stream, XS, Wgu + (size_t)l * 32 * 1024 * 1024, 1024, 1024, E, lctl, -1); }
        for (int pass = 0; pass < 2; ++pass) { EpiDown E{}; E.x = XA; E.xb = XBF; E.ssq = ssq; E.tok_of_slot = tok_of_slot; E.w_of_slot = w_of_slot; E.last = pass; E.pad = 0;
          launch_gemm_grouped(stream, HID, Wdn + (size_t)l * 32 * 1024 * 512, 1024, 512, E, lctl, pass); }
    }
    hipLaunchKernelGGL(k_final, dim3(2048), dim3(256), 0, stream, (const float*)XA, final_norm, out);
}
```

```cpp
#include <hip/hip_runtime.h>
#include <cstdio>
#include <cstdint>
#include <cmath>
namespace pg8 {
#define PG8_LAS __attribute__((address_space(3)))
typedef unsigned short bf16_t;
typedef short bf16x8 __attribute__((ext_vector_type(8)));
typedef float f32x4 __attribute__((ext_vector_type(4)));
typedef unsigned u32x4 __attribute__((ext_vector_type(4)));
constexpr int BM = 256, BK = 64, HALF = 128, HTB = HALF * BK * 2  , STAGE_BYTES = 8 * HTB, NXCD = 8, WGM = 8;

__host__ __device__ __forceinline__ int lds_byte(int r, int c) { const int st = (r >> 4) * 2 + (c >> 5), rr = r & 15, cc = c & 31, ob = rr * 64 + cc * 2; return st * 1024 + (ob ^ (((ob >> 9) & 1) << 5)); }
__host__ __device__ __forceinline__ void stage_rc(int b, int& R, int& C) { const int st = b / 1024, sb = b % 1024, swz = sb ^ (((sb >> 9) & 1) << 5); R = (st >> 1) * 16 + swz / 64; C = (st & 1) * 32 + (swz % 64) / 2; }
__host__ __device__ __forceinline__ int perm32(int rho) { const int n = rho >> 4, i = rho & 15; return 8 * (i >> 2) + 4 * n + (i & 3); }

struct Unit { int pm, pn, brow; };
struct Gemm { const bf16_t* A; const bf16_t* Bt; int M, N, K, pad; };

struct StaticOrder {
    int nM, nN, nwg, G, c;
    __host__ __device__ void init(int M, int N, int G_, int c_) { nM = M / BM; nN = N / BM; nwg = nM * nN; G = G_; c = c_; }
    __host__ __device__ bool next(int i, Unit& u) const {
        const long L = (long)i * G + c; if (L >= nwg) return false;
        int wgid = (int)L; { const int q = nwg / NXCD, r = nwg % NXCD, xcd = wgid % NXCD, off = wgid / NXCD; wgid = (xcd < r ? xcd * (q + 1) : r * (q + 1) + (xcd - r) * q) + off; }
        const int nig = WGM * nN, gid = wgid / nig, fm = gid * WGM, gsz = (nM - fm) < WGM ? (nM - fm) : WGM;
        u.pm = fm + ((wgid % nig) % gsz); u.pn = (wgid % nig) / gsz; u.brow = 0; return true;
    }
    __device__ __forceinline__ void a_ready(const Unit&) const {}
    __device__ __forceinline__ void done(const Unit&) const {}
};

__device__ __forceinline__ unsigned cvt_pk_bf16(float lo, float hi) { unsigned r; asm volatile("v_cvt_pk_bf16_f32 %0, %1, %2" : "=v"(r) : "v"(lo), "v"(hi)); return r; }
template <class Epi, class Sched, bool ALIGN_EPI = false, bool SP2 = false>
__device__ __forceinline__ void gemm_phase(PG8_LAS unsigned char* lds, const Gemm g, const Sched& S, const Epi& E) {
    int tid_l = threadIdx.x; asm volatile("" : "+v"(tid_l));
    const int tid = tid_l, wid = __builtin_amdgcn_readfirstlane(tid >> 6), lane = tid & 63, wr = wid >> 2, wc = wid & 3, fr = lane & 15, fq = lane >> 4;
    const int K = g.K, nt = K / BK;
    unsigned voffA[2], voffB[2];
#pragma unroll
    for (int i = 0; i < 2; ++i) { int R, C; stage_rc(tid * 16 + i * 8192, R, C); const int Rb = Epi::PERM ? ((R & ~31) + perm32(R & 31)) : R;
        voffA[i] = (unsigned)(R * K + C) * 2u; voffB[i] = (unsigned)(Rb * K + C) * 2u; }
    const size_t kstep = (size_t)(BK * 2);
    const size_t hstep = (size_t)HALF * K * 2;
    const size_t tstep = 2 * hstep;
    const unsigned ldsw = (unsigned)wid * 1024u;
    const int aoff = lds_byte(wr * 64 + fr, fq * 8), boff = lds_byte(wc * 32 + fr, fq * 8);
#define PG8_SA(b, h) (((b) * 2 + (h)) * HTB)
#define PG8_SB(b, h) ((4 + (b) * 2 + (h)) * HTB)
#define PG8_STAGE(bufoff, gbase, voff) do { _Pragma("unroll") for (int _i = 0; _i < 2; ++_i) \
        __builtin_amdgcn_global_load_lds((const unsigned*)((const char*)(gbase) + (voff)[_i]), (PG8_LAS unsigned*)(lds + (bufoff) + ldsw + _i * 8192), 16, 0, 0); } while (0)
#define PG8_LDA(dst, b, h) do { _Pragma("unroll") for (int m = 0; m < 4; ++m) _Pragma("unroll") for (int k = 0; k < 2; ++k) dst[m][k] = *(const PG8_LAS bf16x8*)(lds + PG8_SA(b, h) + aoff + m * 2048 + k * 1024); } while (0)
#define PG8_LDB(dst, b, h) do { _Pragma("unroll") for (int n = 0; n < 2; ++n) _Pragma("unroll") for (int k = 0; k < 2; ++k) dst[n][k] = *(const PG8_LAS bf16x8*)(lds + PG8_SB(b, h) + boff + n * 2048 + k * 1024); } while (0)
#define PG8_MMA(ai, bj, At, Bt) do { __builtin_amdgcn_s_setprio(1); _Pragma("unroll") for (int m = 0; m < 4; ++m) _Pragma("unroll") for (int n = 0; n < 2; ++n) _Pragma("unroll") for (int k = 0; k < 2; ++k) \
        acc[ai][bj][m][n] = __builtin_amdgcn_mfma_f32_16x16x32_bf16(Bt[n][k], At[m][k], acc[ai][bj][m][n], 0, 0, 0); __builtin_amdgcn_s_setprio(0); } while (0)
#define PG8_WAIT_V(n) asm volatile("s_waitcnt vmcnt(" #n ")" ::: "memory")
#define PG8_WAIT_L(n) asm volatile("s_waitcnt lgkmcnt(" #n ")" ::: "memory")
#define PG8_BAR __builtin_amdgcn_s_barrier()
#define PG8_SCHED __builtin_amdgcn_sched_barrier(0)
    Unit cur, nxt; int ui = 0;
    if (!S.next(0, cur)) return;
    f32x4 acc[2][2][4][2];
#pragma unroll
    for (int a = 0; a < 2; ++a)
#pragma unroll
        for (int b = 0; b < 2; ++b)
#pragma unroll
            for (int m = 0; m < 4; ++m)
#pragma unroll
                for (int n = 0; n < 2; ++n) acc[a][b][m][n] = (f32x4){0.f, 0.f, 0.f, 0.f};
    bf16x8 At[4][2], B0[2][2], B1[2][2];
    const char* cA = (const char*)g.A + (size_t)cur.pm * tstep; const char* cB = (const char*)g.Bt + (size_t)(cur.brow + cur.pn) * tstep;
    S.a_ready(cur);
    if constexpr (SP2) {
        PG8_STAGE(PG8_SB(0, 0), cB, voffB); PG8_STAGE(PG8_SB(0, 1), cB + hstep, voffB); PG8_STAGE(PG8_SA(0, 0), cA, voffA); PG8_STAGE(PG8_SA(0, 1), cA + hstep, voffA);
        if (wr == 1) PG8_BAR;
        PG8_WAIT_V(2); PG8_BAR;
        PG8_STAGE(PG8_SB(1, 0), cB + kstep, voffB); PG8_STAGE(PG8_SA(1, 0), cA + kstep, voffA); PG8_STAGE(PG8_SB(1, 1), cB + hstep + kstep, voffB);
        PG8_WAIT_V(6); PG8_BAR;
    } else {
        PG8_STAGE(PG8_SB(0, 0), cB, voffB); PG8_STAGE(PG8_SA(0, 0), cA, voffA); PG8_STAGE(PG8_SB(0, 1), cB + hstep, voffB); PG8_STAGE(PG8_SA(0, 1), cA + hstep, voffA);
        if (wr == 1) PG8_BAR;
        PG8_WAIT_V(4); PG8_BAR;
        PG8_STAGE(PG8_SB(1, 0), cB + kstep, voffB); PG8_STAGE(PG8_SA(1, 0), cA + kstep, voffA); PG8_STAGE(PG8_SB(1, 1), cB + hstep + kstep, voffB);
        PG8_WAIT_V(6); PG8_BAR;
    }
    for (;;) {
        const bool has_next = S.next(ui + 1, nxt);
        const char* nA = has_next ? (const char*)g.A + (size_t)nxt.pm * tstep : cA; const char* nB = has_next ? (const char*)g.Bt + (size_t)(nxt.brow + nxt.pn) * tstep : cB;
        for (int t = 0; t < nt; t += 2) {
            const bool last = (t == nt - 2);
            const char* a1 = cA + (size_t)(t + 1) * kstep;
            const char* a2 = last ? nA : cA + (size_t)(t + 2) * kstep; const char* b2 = last ? nB : cB + (size_t)(t + 2) * kstep;
            const char* a3 = a2 + kstep; const char* b3 = b2 + kstep;
            if (last && has_next) S.a_ready(nxt);
            if constexpr (SP2) {
            PG8_LDB(B0, 0, 0); PG8_LDB(B1, 0, 1); PG8_SCHED; PG8_LDA(At, 0, 0); PG8_STAGE(PG8_SA(1, 1), a1 + hstep, voffA);
            PG8_WAIT_V(8); PG8_WAIT_L(0); PG8_BAR; PG8_MMA(0, 0, At, B0); PG8_MMA(0, 1, At, B1); PG8_BAR; PG8_SCHED;
            PG8_LDA(At, 0, 1); PG8_STAGE(PG8_SB(0, 0), b2, voffB); PG8_STAGE(PG8_SB(0, 1), b2 + hstep, voffB); PG8_STAGE(PG8_SA(0, 0), a2, voffA);
            PG8_WAIT_V(8); PG8_WAIT_L(0); PG8_BAR; PG8_MMA(1, 0, At, B0); PG8_MMA(1, 1, At, B1); PG8_BAR; PG8_SCHED;
            PG8_LDB(B0, 1, 0); PG8_LDB(B1, 1, 1); PG8_SCHED; PG8_LDA(At, 1, 0); PG8_STAGE(PG8_SA(0, 1), a2 + hstep, voffA);
            PG8_WAIT_V(8); PG8_WAIT_L(0); PG8_BAR; PG8_MMA(0, 0, At, B0); PG8_MMA(0, 1, At, B1); PG8_BAR; PG8_SCHED;
            PG8_LDA(At, 1, 1); PG8_STAGE(PG8_SB(1, 0), b3, voffB); PG8_STAGE(PG8_SB(1, 1), b3 + hstep, voffB); PG8_STAGE(PG8_SA(1, 0), a3, voffA);
            PG8_WAIT_V(8); PG8_WAIT_L(0); PG8_BAR; PG8_MMA(1, 0, At, B0); PG8_MMA(1, 1, At, B1); PG8_BAR; PG8_SCHED;
            } else {
            PG8_LDB(B0, 0, 0); PG8_SCHED; PG8_LDA(At, 0, 0); PG8_STAGE(PG8_SA(1, 1), a1 + hstep, voffA);
            PG8_WAIT_L(8); PG8_BAR; PG8_WAIT_L(0); PG8_MMA(0, 0, At, B0); PG8_BAR; PG8_SCHED;
            PG8_LDB(B1, 0, 1); PG8_STAGE(PG8_SB(0, 0), b2, voffB);
            PG8_BAR; PG8_WAIT_L(0); PG8_MMA(0, 1, At, B1); PG8_BAR;
            PG8_LDA(At, 0, 1); PG8_STAGE(PG8_SA(0, 0), a2, voffA);
            PG8_BAR; PG8_WAIT_L(0); PG8_MMA(1, 0, At, B0); PG8_BAR; PG8_SCHED;
            PG8_STAGE(PG8_SB(0, 1), b2 + hstep, voffB);
            PG8_WAIT_V(6); PG8_BAR; PG8_MMA(1, 1, At, B1); PG8_BAR;
            PG8_LDB(B0, 1, 0); PG8_SCHED; PG8_LDA(At, 1, 0); PG8_STAGE(PG8_SA(0, 1), a2 + hstep, voffA);
            PG8_WAIT_L(8); PG8_BAR; PG8_WAIT_L(0); PG8_MMA(0, 0, At, B0); PG8_BAR; PG8_SCHED;
            PG8_LDB(B1, 1, 1); PG8_STAGE(PG8_SB(1, 0), b3, voffB);
            PG8_BAR; PG8_WAIT_L(0); PG8_MMA(0, 1, At, B1); PG8_BAR;
            PG8_LDA(At, 1, 1); PG8_STAGE(PG8_SA(1, 0), a3, voffA);
            PG8_BAR; PG8_WAIT_L(0); PG8_MMA(1, 0, At, B0); PG8_BAR; PG8_SCHED;
            PG8_STAGE(PG8_SB(1, 1), b3 + hstep, voffB);
            PG8_WAIT_V(6); PG8_BAR; PG8_MMA(1, 1, At, B1); PG8_BAR;
            }
        }
        if constexpr (ALIGN_EPI) { if (wr == 0) PG8_BAR; }
        if constexpr (!Epi::AFTER_DRAIN) { E(acc, cur, wr, wc, fr, fq); S.done(cur); }
        if (!has_next) break;
#pragma unroll
        for (int a = 0; a < 2; ++a)
#pragma unroll
            for (int b = 0; b < 2; ++b)
#pragma unroll
                for (int m = 0; m < 4; ++m)
#pragma unroll
                    for (int n = 0; n < 2; ++n) acc[a][b][m][n] = (f32x4){0.f, 0.f, 0.f, 0.f};
        cur = nxt; cA = nA; cB = nB; ++ui;
        if constexpr (ALIGN_EPI) { if (wr == 1) PG8_BAR; }
    }
    PG8_WAIT_V(0);
    if constexpr (!ALIGN_EPI) { if (wr == 0) PG8_BAR; }
    PG8_BAR;
    if constexpr (Epi::AFTER_DRAIN) { E.fused(acc, cur, wr, wc, fr, fq, lds, wid, lane); S.done(cur); }
#undef PG8_SA
#undef PG8_SB
#undef PG8_STAGE
#undef PG8_LDA
#undef PG8_LDB
#undef PG8_MMA
#undef PG8_WAIT_V
#undef PG8_WAIT_L
#undef PG8_BAR
#undef PG8_SCHED
}
}

using pg8::bf16_t; using pg8::f32x4; using pg8::u32x4; using pg8::Unit;
constexpr int T_TOK = 32768, DM = 1024, SEQ = 2048, NBATCH = 16, MEML = 256, TMEM = 4096, SPAD = 81920;
constexpr float EPS = 1e-6f;
constexpr float LOG2E = 1.4426950408889634f;
constexpr size_t MiB = 1u << 20;
constexpr size_t WS_CTL = 0, CTL_ZERO_BYTES = 64 * 1024;
constexpr size_t WS_ROPEC = 1 * MiB, WS_ROPES = 1 * MiB + 64 * 1024, WS_WR = 1 * MiB + 128 * 1024  , WS_LAM = 1 * MiB + 512 * 1024;
constexpr size_t WS_SSQ = 2 * MiB, WS_SSQM = 4 * MiB;
constexpr size_t WS_TOKSLOT = 5 * MiB, WS_WSLOT = 5 * MiB + 512 * 1024, WS_RSSLOT = 6 * MiB;
constexpr size_t WS_ROUTE_E = 7 * MiB, WS_ROUTE_W = 7 * MiB + 512 * 1024, WS_RSTOK = 8 * MiB;
constexpr size_t WS_MEMB = 10 * MiB, WS_MKV = 18 * MiB;
constexpr size_t WS_WMEM = 26 * MiB, WS_WIN = 28 * MiB, WS_WOUT0 = 34 * MiB, WS_WQKV = 36 * MiB, WS_WOUT1 = 39 * MiB, WS_WQ = 41 * MiB, WS_WO = 43 * MiB,
                 WS_WGU = 45 * MiB, WS_WDN = 173 * MiB;
constexpr size_t WS_XA = 240 * MiB, WS_XBF = 368 * MiB, WS_Y = 432 * MiB, WS_QX = 496 * MiB, WS_OX = 528 * MiB, WS_U1 = 560 * MiB, WS_U2 = 752 * MiB, WS_END = 880 * MiB;
constexpr int CI_CNT = 0, CI_CUR = 64, CI_LBASE = 128, CI_NT = 192, CI_TEXP = 256, CI_STRIDE = 1024;

__device__ __forceinline__ unsigned f2bf(float f) { unsigned u = __builtin_bit_cast(unsigned, f); return (u + 0x7fffu + ((u >> 16) & 1u)) >> 16; }
__device__ __forceinline__ unsigned pk2(float lo, float hi) { return f2bf(lo) | (f2bf(hi) << 16); }
__device__ __forceinline__ float bflo(unsigned w) { return __builtin_bit_cast(float, w << 16); }
__device__ __forceinline__ float bfhi(unsigned w) { return __builtin_bit_cast(float, w & 0xffff0000u); }
__device__ __forceinline__ float bf2f(bf16_t h) { return __builtin_bit_cast(float, (unsigned)h << 16); }
__device__ __forceinline__ float wave_sum(float v) {
#pragma unroll
    for (int o = 1; o < 64; o <<= 1) v += __shfl_xor(v, o);
    return v;
}
__device__ __forceinline__ float row_rs(const float* ssq, int row) {
    const f32x4* p = (const f32x4*)(ssq + (size_t)row * 16);
    const f32x4 a = p[0], b = p[1], c = p[2], d = p[3];
    const float s = (((a.x + a.y) + (a.z + a.w)) + ((b.x + b.y) + (b.z + b.w))) + (((c.x + c.y) + (c.z + c.w)) + ((d.x + d.y) + (d.z + d.w)));
    return 1.0f / sqrtf(s * (1.0f / 1024.0f) + EPS);
}

struct EpiProj {
    static constexpr bool PERM = true, AFTER_DRAIN = false;
    bf16_t* O; const float* ssq; const float* bias; const float* ropeC; const float* ropeS; int ldc, rope_lo, rope_hi, pad;
    __device__ __forceinline__ void operator()(const f32x4 (&acc)[2][2][4][2], const Unit& u, int wr, int wc, int fr, int fq) const {
        const int row0 = u.pm * 256 + wr * 64 + fr;
#pragma unroll
        for (int ai = 0; ai < 2; ++ai)
#pragma unroll
            for (int m = 0; m < 4; ++m) {
                const int row = row0 + ai * 128 + m * 16;
                const float rs = row_rs(ssq, row);
                const int pos = row & (SEQ - 1);
#pragma unroll
                for (int bj = 0; bj < 2; ++bj) {
                    const int col = u.pn * 256 + bj * 128 + wc * 32 + 8 * fq;
                    float v[8], pv[8];
#pragma unroll
                    for (int i = 0; i < 8; ++i) v[i] = acc[ai][bj][m][i >> 2][i & 3] * rs;
                    if (bias) {
                        const f32x4 b0 = *(const f32x4*)(bias + col), b1 = *(const f32x4*)(bias + col + 4);
#pragma unroll
                        for (int i = 0; i < 4; ++i) { v[i] += b0[i]; v[4 + i] += b1[i]; }
                    }
#pragma unroll
                    for (int i = 0; i < 8; ++i) pv[i] = __shfl_xor(v[i], 16);
                    if (col >= rope_lo && col < rope_hi && (col & 63) < 16) {
                        const f32x4 c0 = *(const f32x4*)(ropeC + pos * 8), c1 = *(const f32x4*)(ropeC + pos * 8 + 4);
                        const f32x4 s0 = *(const f32x4*)(ropeS + pos * 8), s1 = *(const f32x4*)(ropeS + pos * 8 + 4);
                        const float sg = (col & 8) ? 1.0f : -1.0f;
#pragma unroll
                        for (int i = 0; i < 4; ++i) { v[i] = v[i] * c0[i] + sg * pv[i] * s0[i]; v[4 + i] = v[4 + i] * c1[i] + sg * pv[4 + i] * s1[i]; }
                    }
                    u32x4 w; w.x = pk2(v[0], v[1]); w.y = pk2(v[2], v[3]); w.z = pk2(v[4], v[5]); w.w = pk2(v[6], v[7]);
                    *(u32x4*)(O + (size_t)row * ldc + col) = w;
                }
            }
    }
};
struct EpiResid {
    static constexpr bool PERM = true, AFTER_DRAIN = false;
    const float* xin; float* xout; bf16_t* xb; float* ssq; const float* bias;
    __device__ __forceinline__ void operator()(const f32x4 (&acc)[2][2][4][2], const Unit& u, int wr, int wc, int fr, int fq) const {
        const int row0 = u.pm * 256 + wr * 64 + fr;
#pragma unroll
        for (int ai = 0; ai < 2; ++ai)
#pragma unroll
            for (int m = 0; m < 4; ++m) {
                const int row = row0 + ai * 128 + m * 16;
                float ss = 0.f;
#pragma unroll
                for (int bj = 0; bj < 2; ++bj) {
                    const int col = u.pn * 256 + bj * 128 + wc * 32 + 8 * fq;
                    const size_t off = (size_t)row * DM + col;
                    f32x4 x0 = *(const f32x4*)(xin + off), x1 = *(const f32x4*)(xin + off + 4);
                    x0 += acc[ai][bj][m][0]; x1 += acc[ai][bj][m][1];
                    if (bias) { x0 += *(const f32x4*)(bias + col); x1 += *(const f32x4*)(bias + col + 4); }
                    *(f32x4*)(xout + off) = x0; *(f32x4*)(xout + off + 4) = x1;
                    u32x4 w; w.x = pk2(x0[0], x0[1]); w.y = pk2(x0[2], x0[3]); w.z = pk2(x1[0], x1[1]); w.w = pk2(x1[2], x1[3]);
                    *(u32x4*)(xb + off) = w;
                    ss += (x0[0] * x0[0] + x0[1] * x0[1]) + (x0[2] * x0[2] + x0[3] * x0[3]) + (x1[0] * x1[0] + x1[1] * x1[1]) + (x1[2] * x1[2] + x1[3] * x1[3]);
                }
                ss += __shfl_xor(ss, 16); ss += __shfl_xor(ss, 32);
                if (fq == 0) ssq[(size_t)row * 16 + u.pn * 4 + wc] = ss;
            }
    }
};
struct EpiGateUp {
    static constexpr bool PERM = true, AFTER_DRAIN = false;
    bf16_t* hid; const float* rs_slot;
    __device__ __forceinline__ void operator()(const f32x4 (&acc)[2][2][4][2], const Unit& u, int wr, int wc, int fr, int fq) const {
        const int row0 = u.pm * 256 + wr * 64 + fr;
#pragma unroll
        for (int ai = 0; ai < 2; ++ai)
#pragma unroll
            for (int m = 0; m < 4; ++m) {
                const int row = row0 + ai * 128 + m * 16;
                const float rs = rs_slot[row];
                float h[8];
#pragma unroll
                for (int i = 0; i < 8; ++i) { const float g = acc[ai][0][m][i >> 2][i & 3] * rs, up = acc[ai][1][m][i >> 2][i & 3] * rs; h[i] = g / (1.0f + __expf(-g)) * up; }
                u32x4 w; w.x = pk2(h[0], h[1]); w.y = pk2(h[2], h[3]); w.z = pk2(h[4], h[5]); w.w = pk2(h[6], h[7]);
                *(u32x4*)(hid + (size_t)row * 512 + u.pn * 128 + wc * 32 + 8 * fq) = w;
            }
    }
};
struct EpiDown {
    static constexpr bool PERM = true, AFTER_DRAIN = false;
    float* x; bf16_t* xb; float* ssq; const int* tok_of_slot; const float* w_of_slot; int last, pad;
    __device__ __forceinline__ void operator()(const f32x4 (&acc)[2][2][4][2], const Unit& u, int wr, int wc, int fr, int fq) const {
        const int row0 = u.pm * 256 + wr * 64 + fr;
#pragma unroll
        for (int ai = 0; ai < 2; ++ai)
#pragma unroll
            for (int m = 0; m < 4; ++m) {
                const int slot = row0 + ai * 128 + m * 16;
                const int tok = tok_of_slot[slot];
                const float wt = w_of_slot[slot];
                float ss = 0.f;
                if (tok >= 0) {
#pragma unroll
                    for (int bj = 0; bj < 2; ++bj) {
                        const int col = u.pn * 256 + bj * 128 + wc * 32 + 8 * fq;
                        const size_t off = (size_t)tok * DM + col;
                        f32x4 x0 = *(const f32x4*)(x + off), x1 = *(const f32x4*)(x + off + 4);
                        x0 += acc[ai][bj][m][0] * wt; x1 += acc[ai][bj][m][1] * wt;
                        *(f32x4*)(x + off) = x0; *(f32x4*)(x + off + 4) = x1;
                        if (last) {
                            u32x4 w; w.x = pk2(x0[0], x0[1]); w.y = pk2(x0[2], x0[3]); w.z = pk2(x1[0], x1[1]); w.w = pk2(x1[2], x1[3]);
                            *(u32x4*)(xb + off) = w;
                            ss += (x0[0] * x0[0] + x0[1] * x0[1]) + (x0[2] * x0[2] + x0[3] * x0[3]) + (x1[0] * x1[0] + x1[1] * x1[1]) + (x1[2] * x1[2] + x1[3] * x1[3]);
                        }
                    }
                }
                ss += __shfl_xor(ss, 16); ss += __shfl_xor(ss, 32);
                if (last && tok >= 0 && fq == 0) ssq[(size_t)tok * 16 + u.pn * 4 + wc] = ss;
            }
    }
};

struct GroupedOrder {
    const int* tile_expert; int t_lo, t_hi, nN, G, c, tiles_per_expert;
    __device__ __forceinline__ bool next(int i, Unit& u) const {
        const long L = (long)i * G + c; const long n = (long)(t_hi - t_lo) * nN; if (L >= n) return false;
        u.pm = t_lo + (int)(L / nN); u.pn = (int)(L % nN); u.brow = tile_expert[u.pm] * tiles_per_expert; return true;
    }
    __device__ __forceinline__ void a_ready(const Unit&) const {}
    __device__ __forceinline__ void done(const Unit&) const {}
};

namespace att {
#define ATT_LAS __attribute__((address_space(3)))
#define ATT_DI __device__ __forceinline__
typedef short bf16x8 __attribute__((ext_vector_type(8)));
typedef short s16x4 __attribute__((ext_vector_type(4)));
typedef float f32x16 __attribute__((ext_vector_type(16)));
typedef short v4i16_t __attribute__((ext_vector_type(4)));
typedef float f32x2_t __attribute__((ext_vector_type(2)));
typedef __bf16 bf16x2_t __attribute__((ext_vector_type(2)));
ATT_DI int crow(int reg, int h) { return (reg & 3) + 8 * (reg >> 2) + 4 * h; }
ATT_DI unsigned cvtpk(float lo, float hi) { f32x2_t v = {lo, hi}; bf16x2_t b = __builtin_convertvector(v, bf16x2_t); return __builtin_bit_cast(unsigned, b); }
ATT_DI s16x4 vtr(const ATT_LAS char* p) { return __builtin_bit_cast(s16x4, __builtin_amdgcn_ds_read_tr16_b64_v4i16((ATT_LAS v4i16_t*)p)); }
ATT_DI bf16x8 pack8(const f32x16& x, int s) {
    u32x4 p; p.x = cvtpk(x[8 * s + 0], x[8 * s + 1]); p.y = cvtpk(x[8 * s + 2], x[8 * s + 3]); p.z = cvtpk(x[8 * s + 4], x[8 * s + 5]); p.w = cvtpk(x[8 * s + 6], x[8 * s + 7]);
    return __builtin_bit_cast(bf16x8, p);
}
struct L256 { static constexpr int PITCH = 256; static ATT_DI int addr(int row, int byte) { return row * 256 + ((((byte >> 4) ^ (row & 15)) << 4) | (byte & 15)); } };
struct LPAD { static constexpr int PITCH = 144; static ATT_DI int addr(int row, int byte) { return row * 144 + byte; } };

template <int NKS, int NDB, class KLay, class Lay, bool MASK>
ATT_DI void tile64(const ATT_LAS char* kt, const ATT_LAS char* vt, int kcb, int vcb, const bf16x8 (&qf)[NKS], float& m, float& l, f32x16 (&O)[NDB], float c,
                   int r, int h, int g1, int tq, int tp, int qpos, int kpos0, int win) {
    f32x16 p0, p1;
#pragma unroll
    for (int i = 0; i < 16; ++i) { p0[i] = 0.f; p1[i] = 0.f; }
#pragma unroll
    for (int s = 0; s < NKS; ++s) {
        const bf16x8 a0 = *(const ATT_LAS bf16x8*)(kt + KLay::addr(r, kcb + 32 * s + 16 * h));
        const bf16x8 a1 = *(const ATT_LAS bf16x8*)(kt + KLay::addr(32 + r, kcb + 32 * s + 16 * h));
        p0 = __builtin_amdgcn_mfma_f32_32x32x16_bf16(a0, qf[s], p0, 0, 0, 0);
        p1 = __builtin_amdgcn_mfma_f32_32x32x16_bf16(a1, qf[s], p1, 0, 0, 0);
    }
    if (MASK) {
#pragma unroll
        for (int i = 0; i < 16; ++i) {
            const int k0 = kpos0 + crow(i, h), k1 = k0 + 32;
            if (k0 > qpos || k0 <= qpos - win || k0 < 0) p0[i] = -INFINITY;
            if (k1 > qpos || k1 <= qpos - win || k1 < 0) p1[i] = -INFINITY;
        }
    }
    float mx = fmaxf(p0[0], p1[0]);
#pragma unroll
    for (int i = 1; i < 16; ++i) mx = fmaxf(mx, fmaxf(p0[i], p1[i]));
    mx = fmaxf(mx, __shfl_xor(mx, 32));
    const float mn = fmaxf(m, mx * c);
    const float ms = (mn == -INFINITY) ? 0.f : mn;
    const float corr = __builtin_amdgcn_exp2f(m - ms);
    m = mn;
    float ls = 0.f;
#pragma unroll
    for (int i = 0; i < 16; ++i) { p0[i] = __builtin_amdgcn_exp2f(fmaf(p0[i], c, -ms)); p1[i] = __builtin_amdgcn_exp2f(fmaf(p1[i], c, -ms)); ls += p0[i] + p1[i]; }
    l = l * corr + ls;
#pragma unroll
    for (int db = 0; db < NDB; ++db) O[db] = O[db] * corr;
    bf16x8 pf[4]; pf[0] = pack8(p0, 0); pf[1] = pack8(p0, 1); pf[2] = pack8(p1, 0); pf[3] = pack8(p1, 1);
#pragma unroll
    for (int db = 0; db < NDB; ++db)
#pragma unroll
        for (int ks = 0; ks < 4; ++ks) {
            const int rowl = (ks >> 1) * 32 + (ks & 1) * 16 + 4 * h + tq, colb = vcb + (db * 32 + 16 * g1 + 4 * tp) * 2;
            const s16x4 lo = vtr(vt + Lay::addr(rowl, colb)), hi = vtr(vt + Lay::addr(rowl + 8, colb));
            const bf16x8 a = __builtin_shufflevector(lo, hi, 0, 1, 2, 3, 4, 5, 6, 7);
            O[db] = __builtin_amdgcn_mfma_f32_32x32x16_bf16(a, pf[ks], O[db], 0, 0, 0);
        }
}
template <int NKS> ATT_DI void load_q(bf16x8 (&qf)[NKS], const bf16_t* qrow  , int h) {
#pragma unroll
    for (int s = 0; s < NKS; ++s) qf[s] = *(const bf16x8*)(qrow + 16 * s + 8 * h);
}
template <int NDB> ATT_DI void store_o(const f32x16 (&O)[NDB], float l, bf16_t* orow, int h) {
    const float il = 1.0f / (l + __shfl_xor(l, 32));
#pragma unroll
    for (int db = 0; db < NDB; ++db)
#pragma unroll
        for (int g = 0; g < 4; ++g) {
            const unsigned w0 = cvtpk(O[db][4 * g] * il, O[db][4 * g + 1] * il), w1 = cvtpk(O[db][4 * g + 2] * il, O[db][4 * g + 3] * il);
            *(unsigned long long*)(orow + db * 32 + 8 * g + 4 * h) = (unsigned long long)w0 | ((unsigned long long)w1 << 32);
        }
}

ATT_DI void xattn_unit(ATT_LAS char* lds, const bf16_t* QX, const bf16_t* MKV, bf16_t* OX, int unit) {
    int tid_l = threadIdx.x; asm volatile("" : "+v"(tid_l));
    const int tid = tid_l, lane = tid & 63, w = tid >> 6, r = lane & 31, h = lane >> 5, g1 = (lane >> 4) & 1, tq = (lane & 15) >> 2, tp = lane & 3;
    const int b = unit >> 4, hd = (unit >> 2) & 3, part = unit & 3;
    __syncthreads();
    for (int cidx = tid; cidx < 256 * 16; cidx += 512) { const int row = cidx >> 4, ch = cidx & 15;
        const bf16_t* src = MKV + (size_t)(b * MEML + row) * 1024 + hd * 128 + ch * 8;
        const u32x4 kv = *(const u32x4*)src, vv = *(const u32x4*)(src + 512);
        *(ATT_LAS u32x4*)(lds + L256::addr(row, ch * 16)) = kv; *(ATT_LAS u32x4*)(lds + 65536 + L256::addr(row, ch * 16)) = vv; }
    __syncthreads();
    const float c = LOG2E * 0.08838834764831845f;
#pragma unroll 1
    for (int qb = 0; qb < 2; ++qb) {
        const size_t tok = (size_t)b * SEQ + part * 512 + qb * 256 + w * 32 + r;
        bf16x8 qf[8]; load_q<8>(qf, QX + tok * 512 + hd * 128, h);
        float m = -INFINITY, l = 0.f; f32x16 O[4];
#pragma unroll
        for (int db = 0; db < 4; ++db)
#pragma unroll
            for (int i = 0; i < 16; ++i) O[db][i] = 0.f;
#pragma unroll 1
        for (int kt = 0; kt < 4; ++kt)
            tile64<8, 4, L256, L256, false>(lds + kt * 64 * 256, lds + 65536 + kt * 64 * 256, 0, 0, qf, m, l, O, c, r, h, g1, tq, tp, 0, 0, 0);
        store_o<4>(O, l, OX + tok * 512 + hd * 128, h);
    }
}
ATT_DI void swa_unit(ATT_LAS char* lds, const bf16_t* P  , const float* sinks, bf16_t* Y, int unit) {
    int tid_l = threadIdx.x; asm volatile("" : "+v"(tid_l));
    const int tid = tid_l, lane = tid & 63, w = tid >> 6, r = lane & 31, h = lane >> 5, g1 = (lane >> 4) & 1, tq = (lane & 15) >> 2, tp = lane & 3;
    const int b = unit >> 5, kvh = (unit >> 3) & 3, qb = unit & 7, q0 = qb * 256;
    constexpr int VOFF = 384 * 144;
    __syncthreads();
    for (int cidx = tid; cidx < 384 * 8; cidx += 512) { const int row = cidx >> 3, ch = cidx & 7; const int kpos = q0 - 128 + row;
        u32x4 kv = (u32x4){0u, 0u, 0u, 0u}, vv = kv;
        if (kpos >= 0) { const bf16_t* src = P + (size_t)(b * SEQ + kpos) * 1536 + 1024 + kvh * 64 + ch * 8; kv = *(const u32x4*)src; vv = *(const u32x4*)(src + 256); }
        *(ATT_LAS u32x4*)(lds + LPAD::addr(row, ch * 16)) = kv; *(ATT_LAS u32x4*)(lds + VOFF + LPAD::addr(row, ch * 16)) = vv; }
    __syncthreads();
    const float c = LOG2E * 0.125f;
    const int qpos = q0 + w * 32 + r; const size_t tok = (size_t)b * SEQ + qpos;
    const int t0 = (32 * w + 1) >> 6;
#pragma unroll 1
    for (int g = 0; g < 4; ++g) {
        const int hq = kvh * 4 + g;
        bf16x8 qf[4]; load_q<4>(qf, P + tok * 1536 + hq * 64, h);
        float m = sinks[hq] * LOG2E, l = (h == 0) ? 1.f : 0.f; f32x16 O[2];
#pragma unroll
        for (int db = 0; db < 2; ++db)
#pragma unroll
            for (int i = 0; i < 16; ++i) O[db][i] = 0.f;
#pragma unroll 1
        for (int t = t0; t < t0 + 3; ++t)
            tile64<4, 2, LPAD, LPAD, true>(lds + t * 64 * 144, lds + VOFF + t * 64 * 144, 0, 0, qf, m, l, O, c, r, h, g1, tq, tp, qpos, q0 - 128 + t * 64, 128);
        store_o<2>(O, l, Y + tok * 1024 + hq * 64, h);
    }
}
constexpr int DKB = 64 * 144, DBUF = DKB + 16384;
ATT_DI void diff_pass(ATT_LAS char* lds, const bf16_t* P, int b, int hd, int qb, int mp, f32x16 (&O)[4], float& lsum) {
    int tid_l = threadIdx.x; asm volatile("" : "+v"(tid_l));
    const int tid = tid_l, lane = tid & 63, w = tid >> 6, r = lane & 31, h = lane >> 5, g1 = (lane >> 4) & 1, tq = (lane & 15) >> 2, tp = lane & 3;
    const int q0 = qb * 256, NT = 4 * (qb + 1);
    const int qpos = q0 + w * 32 + r; const size_t tok = (size_t)b * SEQ + qpos;
    const int qmax_w = q0 + w * 32 + 31, qmin_w = q0 + w * 32;
    const float c = LOG2E * 0.125f;
    bf16x8 qf[4]; load_q<4>(qf, P + tok * 3072 + 1536 + hd * 128 + mp * 64, h);
    float m = -INFINITY, l = 0.f;
#pragma unroll
    for (int db = 0; db < 4; ++db)
#pragma unroll
        for (int i = 0; i < 16; ++i) O[db][i] = 0.f;
    const int srow = tid >> 3, sc1 = tid & 7;
    const bf16_t* sbase = P + (size_t)(b * SEQ + srow) * 3072 + hd * 128;
    u32x4 st[3];
    st[0] = *(const u32x4*)(sbase + 2048 + mp * 64 + sc1 * 8); st[1] = *(const u32x4*)(sbase + 2560 + sc1 * 16); st[2] = *(const u32x4*)(sbase + 2560 + sc1 * 16 + 8);
    __syncthreads();
    *(ATT_LAS u32x4*)(lds + LPAD::addr(srow, sc1 * 16)) = st[0];
    *(ATT_LAS u32x4*)(lds + DKB + L256::addr(srow, sc1 * 32)) = st[1]; *(ATT_LAS u32x4*)(lds + DKB + L256::addr(srow, sc1 * 32 + 16)) = st[2];
    __syncthreads();
#pragma unroll 1
    for (int kt = 0; kt < NT; ++kt) {
        const bool more = (kt + 1 < NT);
        if (more) { const bf16_t* s2 = sbase + (size_t)(kt + 1) * 64 * 3072;
            st[0] = *(const u32x4*)(s2 + 2048 + mp * 64 + sc1 * 8); st[1] = *(const u32x4*)(s2 + 2560 + sc1 * 16); st[2] = *(const u32x4*)(s2 + 2560 + sc1 * 16 + 8); }
        const ATT_LAS char* kb = lds + (kt & 1) * DBUF; const ATT_LAS char* vb = kb + DKB;
        if (kt * 64 <= qmax_w) {
            if (kt * 64 + 63 > qmin_w) tile64<4, 4, LPAD, L256, true>(kb, vb, 0, 0, qf, m, l, O, c, r, h, g1, tq, tp, qpos, kt * 64, 1 << 30);
            else                       tile64<4, 4, LPAD, L256, false>(kb, vb, 0, 0, qf, m, l, O, c, r, h, g1, tq, tp, qpos, kt * 64, 1 << 30);
        }
        if (more) { ATT_LAS char* d = lds + ((kt + 1) & 1) * DBUF;
            *(ATT_LAS u32x4*)(d + LPAD::addr(srow, sc1 * 16)) = st[0];
            *(ATT_LAS u32x4*)(d + DKB + L256::addr(srow, sc1 * 32)) = st[1]; *(ATT_LAS u32x4*)(d + DKB + L256::addr(srow, sc1 * 32 + 16)) = st[2]; }
        __syncthreads();
    }
    lsum = l + __shfl_xor(l, 32);
}
ATT_DI void diff_unit(ATT_LAS char* lds, const bf16_t* P  , const float* subln, float lam, bf16_t* Y, float* park  , int b, int hd, int qb) {
    int tid_l = threadIdx.x; asm volatile("" : "+v"(tid_l));
    const int tid = tid_l, lane = tid & 63, w = tid >> 6, r = lane & 31, h = lane >> 5;
    const size_t tok = (size_t)b * SEQ + qb * 256 + w * 32 + r;
    f32x4* pk = (f32x4*)(park + ((tok * 4 + hd) * 2 + h) * 64);
    f32x16 O0[4], O1[4]; float l0, l1;
    diff_pass(lds, P, b, hd, qb, 0, O0, l0);
    { const float i0 = 1.0f / l0;
#pragma unroll
      for (int db = 0; db < 4; ++db)
#pragma unroll
          for (int g = 0; g < 4; ++g) pk[db * 4 + g] = (f32x4){O0[db][4 * g] * i0, O0[db][4 * g + 1] * i0, O0[db][4 * g + 2] * i0, O0[db][4 * g + 3] * i0}; }
    diff_pass(lds, P, b, hd, qb, 1, O1, l1);
#pragma unroll
    for (int db = 0; db < 4; ++db)
#pragma unroll
        for (int g = 0; g < 4; ++g) { const f32x4 v = pk[db * 4 + g]; O0[db][4 * g] = v.x; O0[db][4 * g + 1] = v.y; O0[db][4 * g + 2] = v.z; O0[db][4 * g + 3] = v.w; }
    const float i1 = lam / l1;
    float ss = 0.f;
#pragma unroll
    for (int db = 0; db < 4; ++db)
#pragma unroll
        for (int i = 0; i < 16; ++i) { const float o = O0[db][i] - O1[db][i] * i1; O0[db][i] = o; ss += o * o; }
    ss += __shfl_xor(ss, 32);
    const float rs = 0.8f / sqrtf(ss * (1.0f / 128.0f) + EPS);
    bf16_t* orow = Y + tok * 1024 + 512 + hd * 128;
#pragma unroll
    for (int db = 0; db < 4; ++db)
#pragma unroll
        for (int g = 0; g < 4; ++g) { const int d = db * 32 + 8 * g + 4 * h; const f32x4 gg = *(const f32x4*)(subln + d);
            const unsigned w0 = cvtpk(O0[db][4 * g] * rs * gg.x, O0[db][4 * g + 1] * rs * gg.y), w1 = cvtpk(O0[db][4 * g + 2] * rs * gg.z, O0[db][4 * g + 3] * rs * gg.w);
            *(unsigned long long*)(orow + d) = (unsigned long long)w0 | ((unsigned long long)w1 << 32); }
}
ATT_DI void conv_tokens(const bf16_t* P, const float* convw, bf16_t* Y, int tok0  ) {
    int tid_l = threadIdx.x; asm volatile("" : "+v"(tid_l));
    const int tid = tid_l, cg = tid & 63, run = tid >> 6, c0 = cg * 8;
    float w[3][8];
#pragma unroll
    for (int j = 0; j < 3; ++j) { const f32x4 a = *(const f32x4*)(convw + j * 512 + c0), b2 = *(const f32x4*)(convw + j * 512 + c0 + 4);
        w[j][0] = a.x; w[j][1] = a.y; w[j][2] = a.z; w[j][3] = a.w; w[j][4] = b2.x; w[j][5] = b2.y; w[j][6] = b2.z; w[j][7] = b2.w; }
    const int tfirst = tok0 + run * 16;
    float z1[8], z2[8];
#pragma unroll
    for (int i = 0; i < 8; ++i) { z1[i] = 0.f; z2[i] = 0.f; }
#pragma unroll 1
    for (int tt = -2; tt < 16; ++tt) {
        const int tok = tfirst + tt;
        float z0[8];
        const bool inseq = ((tfirst & (SEQ - 1)) + tt) >= 0;
        if (inseq) { const bf16_t* pr = P + (size_t)tok * 3072; const u32x4 gc = *(const u32x4*)(pr + 512 + c0), uu = *(const u32x4*)(pr + 1024 + c0);
            z0[0] = bflo(gc.x) * bflo(uu.x); z0[1] = bfhi(gc.x) * bfhi(uu.x); z0[2] = bflo(gc.y) * bflo(uu.y); z0[3] = bfhi(gc.y) * bfhi(uu.y);
            z0[4] = bflo(gc.z) * bflo(uu.z); z0[5] = bfhi(gc.z) * bfhi(uu.z); z0[6] = bflo(gc.w) * bflo(uu.w); z0[7] = bfhi(gc.w) * bfhi(uu.w); }
        else {
#pragma unroll
            for (int i = 0; i < 8; ++i) z0[i] = 0.f; }
        if (tt >= 0) { const u32x4 gb = *(const u32x4*)(P + (size_t)tok * 3072 + c0); float y[8];
            const float gbf[8] = {bflo(gb.x), bfhi(gb.x), bflo(gb.y), bfhi(gb.y), bflo(gb.z), bfhi(gb.z), bflo(gb.w), bfhi(gb.w)};
#pragma unroll
            for (int i = 0; i < 8; ++i) y[i] = gbf[i] * (w[0][i] * z2[i] + w[1][i] * z1[i] + w[2][i] * z0[i]);
            u32x4 o; o.x = pk2(y[0], y[1]); o.y = pk2(y[2], y[3]); o.z = pk2(y[4], y[5]); o.w = pk2(y[6], y[7]);
            *(u32x4*)(Y + (size_t)tok * 1024 + c0) = o; }
#pragma unroll
        for (int i = 0; i < 8; ++i) { z2[i] = z1[i]; z1[i] = z0[i]; }
    }
}
}

#define LAS __attribute__((address_space(3)))
constexpr int LDS_BYTES = 147456, LDSCTL_OFF = 131072;
constexpr int LC_MISC = 0, LC_HIST = 64, LC_LBASE = 128, LC_RSV = 192, LC_SLOTS = 256, LC_JOBS_BYTE = 4096;
constexpr int CW_BAR = 4096;
constexpr size_t WS_WRT = 9 * MiB;

#define XB_TMO      128
#define XB_XCNT(j)  (256  + 64 * (j))
#define XB_XSUB(j)  (1280 + 64 * (j))
#define XB_XGEN(j)  (2304 + 64 * (j))
#define XB_TOP      3328
#define XB_TOPGEN   3392
#define XCD_BAR_WORDS 3456
#define XB_SPIN_CAP (1u << 18)
__device__ __forceinline__ unsigned xb_ld(unsigned* p)              { return __hip_atomic_load(p, __ATOMIC_RELAXED, __HIP_MEMORY_SCOPE_AGENT); }
__device__ __forceinline__ unsigned xb_add(unsigned* p, unsigned v) { return __hip_atomic_fetch_add(p, v, __ATOMIC_RELAXED, __HIP_MEMORY_SCOPE_AGENT); }
__device__ __forceinline__ unsigned xb_xcc_id() { return (unsigned)__builtin_amdgcn_s_getreg((3 << 11) | 20) & 0xFu; }
#define XB_SPIN(cond, bar) do { unsigned _sp = 0; while (cond) { __builtin_amdgcn_s_sleep(1); \
    if ((++_sp & 255u) == 0u) { if (xb_ld(&(bar)[XB_TMO])) break; if (_sp > XB_SPIN_CAP) { atomicAdd(&(bar)[XB_TMO], 1u); break; } } } } while (0)
struct XcdBarrier { unsigned* bar; unsigned x; volatile LAS unsigned* st; };
__device__ __forceinline__ XcdBarrier xcd_barrier_post(unsigned* bar, volatile LAS unsigned* st) {
    XcdBarrier b; b.bar = bar; b.x = xb_xcc_id(); b.st = st;
    if (threadIdx.x == 0) (void)xb_add(&bar[XB_XCNT(b.x)], 1u);
    return b;
}
__device__ __forceinline__ void xcd_barrier_complete(unsigned* bar, unsigned x, unsigned& nloc, unsigned& nx) {
    const unsigned G = gridDim.x * gridDim.y * gridDim.z;
    unsigned sum, cnt, mine, sp = 0u;
    for (;;) {
        sum = 0u; cnt = 0u; mine = 0u;
#pragma unroll
        for (unsigned j = 0; j < 16; ++j) { const unsigned c = xb_ld(&bar[XB_XCNT(j)]); sum += c; cnt += (c > 0u) ? 1u : 0u; mine = (j == x) ? c : mine; }
        if (sum == G) break;
        __builtin_amdgcn_s_sleep(1);
        if ((++sp & 255u) == 0u) { if (xb_ld(&bar[XB_TMO])) break; if (sp > XB_SPIN_CAP) { atomicAdd(&bar[XB_TMO], 1u); break; } }
    }
    nloc = mine > 0u ? mine : 1u; nx = cnt > 0u ? cnt : 1u;
}
__device__ __forceinline__ void xcd_barrier(const XcdBarrier& b) {
    asm volatile("s_waitcnt vmcnt(0)" ::: "memory");
    __syncthreads();
    if (threadIdx.x == 0) {
        unsigned* bar = b.bar;
        __builtin_amdgcn_s_waitcnt(0);
        unsigned nloc = b.st[0], nx = b.st[1];
        if (nloc == 0u) { xcd_barrier_complete(bar, b.x, nloc, nx); b.st[0] = nloc; b.st[1] = nx; }
        const unsigned old = xb_add(&bar[XB_XSUB(b.x)], 1u);
        const unsigned gen = old / nloc;
        if (old + 1u == (gen + 1u) * nloc) {
            __builtin_amdgcn_fence(__ATOMIC_RELEASE, "agent");
            asm volatile("s_waitcnt vmcnt(0)" ::: "memory");
            const unsigned og = xb_add(&bar[XB_TOP], 1u);
            const unsigned tg = og / nx;
            if (og + 1u == (tg + 1u) * nx) xb_add(&bar[XB_TOPGEN], 1u);
            else XB_SPIN(xb_ld(&bar[XB_TOPGEN]) == tg, bar);
            __builtin_amdgcn_fence(__ATOMIC_ACQUIRE, "agent");
            xb_add(&bar[XB_XGEN(b.x)], 1u);
            asm volatile("s_waitcnt vmcnt(0)" ::: "memory");
        } else {
            XB_SPIN(xb_ld(&bar[XB_XGEN(b.x)]) == gen, bar);
            __builtin_amdgcn_fence(__ATOMIC_ACQUIRE, "agent");
            asm volatile("s_waitcnt vmcnt(0)" ::: "memory");
        }
    }
    __syncthreads();
}

struct WJob { const float* src; bf16_t* dst; const float* gain; int K, N, ipm, first, nitems, perm; };
__device__ __forceinline__ void wt_item(const float* W, int K, int N, const float* gain, bf16_t* WT, int perm, LAS float* scr, int item, int lane) {
    const int nblk = N / 32, kb = item / nblk, nb = item % nblk, k0 = 64 * kb, n0 = 32 * nb;
#pragma unroll 8
    for (int i = 0; i < 32; ++i) { const int kk = 2 * i + (lane >> 5); const float g = gain ? gain[k0 + kk] : 1.0f; scr[kk * 33 + (lane & 31)] = W[(size_t)(k0 + kk) * N + n0 + (lane & 31)] * g; }
    asm volatile("s_waitcnt lgkmcnt(0)" ::: "memory");
    const int c = lane & 7;
#pragma unroll
    for (int j = 0; j < 4; ++j) { const int n = (lane >> 3) + 8 * j; const LAS float* s = scr + (8 * c) * 33 + n;
        u32x4 o; o.x = pk2(s[0 * 33], s[1 * 33]); o.y = pk2(s[2 * 33], s[3 * 33]); o.z = pk2(s[4 * 33], s[5 * 33]); o.w = pk2(s[6 * 33], s[7 * 33]);
        const int ns = n0 + n; int nd = ns;
        if (perm) { const int half = ns >> 9, jj = ns & 511; nd = (jj >> 7) * 256 + half * 128 + (jj & 127); }
        *(u32x4*)(WT + (size_t)nd * K + k0 + 8 * c) = o; }
    asm volatile("s_waitcnt lgkmcnt(0)" ::: "memory");
}
__device__ __forceinline__ void rowprep_rows(const float* x, bf16_t* xb, float* ssq, int rows, int gw, int ngw, int lane) {
    for (int row = gw; row < rows; row += ngw) {
        const f32x4* xr = (const f32x4*)(x + (size_t)row * DM) + lane; float s = 0.f;
        unsigned long long* o8 = (unsigned long long*)(xb + (size_t)row * DM) + lane;
#pragma unroll
        for (int jx = 0; jx < 4; ++jx) { const f32x4 v = xr[64 * jx]; s += (v.x * v.x + v.y * v.y) + (v.z * v.z + v.w * v.w);
            o8[64 * jx] = (unsigned long long)pk2(v.x, v.y) | ((unsigned long long)pk2(v.z, v.w) << 32); }
        s = wave_sum(s);
        if (lane < 16) ssq[(size_t)row * 16 + lane] = (lane == 0) ? s : 0.f;
    }
}
__device__ __forceinline__ void sincos_d(double a, float& c, float& s) {
    const double TWO_PI = 6.283185307179586476925286766559;
    const double n = __builtin_rint(a / TWO_PI); const double r = a - n * TWO_PI;
    const double r2 = r * r;
    double sp = 1.0, cp = 1.0;
#pragma unroll
    for (int k = 15; k >= 1; --k) { sp = 1.0 - r2 / (double)((2 * k) * (2 * k + 1)) * sp; cp = 1.0 - r2 / (double)((2 * k - 1) * (2 * k)) * cp; }
    s = (float)(r * sp); c = (float)cp;
}

typedef float f32x16r __attribute__((ext_vector_type(16)));
__device__ __forceinline__ void route_group(const float* x, const float* ssq, const float* WRt, const float* bg, const float* br, int tok0, LAS float* S  , LAS int* hist,
                                            int* route_e, float* route_w, float* rs_tok, int lane) {
    const int r = lane & 31, kk = lane >> 5;
    f32x16r a0, a1;
#pragma unroll
    for (int i = 0; i < 16; ++i) { a0[i] = 0.f; a1[i] = 0.f; }
    const f32x4* xa = (const f32x4*)(x + (size_t)(tok0 + r) * DM + 4 * kk);
    const f32x4* w0 = (const f32x4*)(WRt + (size_t)r * DM + 4 * kk);
    const f32x4* w1 = (const f32x4*)(WRt + (size_t)(32 + r) * DM + 4 * kk);
#pragma unroll 4
    for (int j = 0; j < 128; ++j) {
        const f32x4 av = xa[2 * j], b0 = w0[2 * j], b1 = w1[2 * j];
#pragma unroll
        for (int e = 0; e < 4; ++e) { a0 = __builtin_amdgcn_mfma_f32_32x32x2f32(av[e], b0[e], a0, 0, 0, 0); a1 = __builtin_amdgcn_mfma_f32_32x32x2f32(av[e], b1[e], a1, 0, 0, 0); }
    }
#pragma unroll
    for (int i = 0; i < 16; ++i) { const int trow = (i & 3) + 8 * (i >> 2) + 4 * kk; S[trow * 68 + r] = a0[i]; if (r < 4) S[trow * 68 + 32 + r] = a1[i]; }
    asm volatile("s_waitcnt lgkmcnt(0)" ::: "memory");
    if (lane < 32) {
        const int tok = tok0 + lane; const LAS float* sr = S + lane * 68;
        const float rs = row_rs(ssq, tok);
        float lg[4];
#pragma unroll
        for (int g = 0; g < 4; ++g) lg[g] = sr[g] * rs + bg[g];
        int gs = 0; float gm = lg[0];
#pragma unroll
        for (int g = 1; g < 4; ++g) if (lg[g] > gm) { gm = lg[g]; gs = g; }
        float gsum = 0.f;
#pragma unroll
        for (int g = 0; g < 4; ++g) gsum += expf(lg[g] - gm);
        const float p_g = 1.0f / gsum;
        float le[8];
#pragma unroll
        for (int e = 0; e < 8; ++e) le[e] = sr[4 + gs * 8 + e] * rs + br[gs * 8 + e];
        int i1 = 0; float m1 = le[0];
#pragma unroll
        for (int e = 1; e < 8; ++e) if (le[e] > m1) { m1 = le[e]; i1 = e; }
        int i2 = -1; float m2 = -INFINITY;
#pragma unroll
        for (int e = 0; e < 8; ++e) if (e != i1 && le[e] > m2) { m2 = le[e]; i2 = e; }
        const float e2 = expf(m2 - m1); const float w1v = p_g / (1.0f + e2), w2v = p_g * e2 / (1.0f + e2);
        const int ex1 = gs * 8 + i1, ex2 = gs * 8 + i2;
        route_e[tok * 2] = ex1; route_e[tok * 2 + 1] = ex2; route_w[tok * 2] = w1v; route_w[tok * 2 + 1] = w2v; rs_tok[tok] = rs;
        __hip_atomic_fetch_add(hist + ex1, 1, __ATOMIC_RELAXED, __HIP_MEMORY_SCOPE_WORKGROUP);
        __hip_atomic_fetch_add(hist + 32 + ex2, 1, __ATOMIC_RELAXED, __HIP_MEMORY_SCOPE_WORKGROUP);
    }
    asm volatile("s_waitcnt lgkmcnt(0)" ::: "memory");
}

#define PHASE_PTRS \
    unsigned char* ws = args.ws; int z_ = 0; int tid = threadIdx.x; asm volatile("" : "+s"(ws), "+s"(z_), "+v"(tid)); \
    const int lane = tid & 63, wave = __builtin_amdgcn_readfirstlane(tid >> 6), gw = bx * 8 + wave; (void)lane; (void)gw; \
    const float* x = args.in[0 + z_]; const float* mem = args.in[1 + z_]; const float* mem_norm = args.in[2 + z_]; const float* mem_w_kv = args.in[3 + z_]; \
    const float* norm_mix = args.in[4 + z_]; const float* norm_xattn = args.in[5 + z_]; const float* norm_ffn = args.in[6 + z_]; \
    const float* hyb_w_in = args.in[7 + z_]; const float* hyb_conv_w = args.in[8 + z_]; const float* diff_lambda = args.in[9 + z_]; const float* diff_subln = args.in[10 + z_]; \
    const float* hyb_w_out = args.in[11 + z_]; const float* swa_w_qkv = args.in[12 + z_]; const float* swa_b_qkv = args.in[13 + z_]; const float* swa_sinks = args.in[14 + z_]; \
    const float* swa_w_out = args.in[15 + z_]; const float* swa_b_out = args.in[16 + z_]; const float* xattn_w_q = args.in[17 + z_]; const float* xattn_w_o = args.in[18 + z_]; \
    const float* moe_w_group = args.in[19 + z_]; const float* moe_b_group = args.in[20 + z_]; const float* moe_w_router = args.in[21 + z_]; const float* moe_b_router = args.in[22 + z_]; \
    const float* moe_w_gate_up = args.in[23 + z_]; const float* moe_w_down = args.in[24 + z_]; const float* final_norm = args.in[25 + z_]; \
    float* ropeC = (float*)(ws + WS_ROPEC); float* ropeS = (float*)(ws + WS_ROPES); float* WRt = (float*)(ws + WS_WRT); float* lam = (float*)(ws + WS_LAM); \
    float* ssq = (float*)(ws + WS_SSQ); float* ssqm = (float*)(ws + WS_SSQM); \
    int* tok_of_slot = (int*)(ws + WS_TOKSLOT); float* w_of_slot = (float*)(ws + WS_WSLOT); float* rs_of_slot = (float*)(ws + WS_RSSLOT); \
    int* route_e = (int*)(ws + WS_ROUTE_E); float* route_w = (float*)(ws + WS_ROUTE_W); float* rs_tok = (float*)(ws + WS_RSTOK); \
    bf16_t* memb = (bf16_t*)(ws + WS_MEMB); bf16_t* mkv = (bf16_t*)(ws + WS_MKV); \
    bf16_t* Wmem = (bf16_t*)(ws + WS_WMEM); bf16_t* Win = (bf16_t*)(ws + WS_WIN); bf16_t* Wout0 = (bf16_t*)(ws + WS_WOUT0); bf16_t* Wqkv = (bf16_t*)(ws + WS_WQKV); bf16_t* Wout1 = (bf16_t*)(ws + WS_WOUT1); \
    bf16_t* Wq = (bf16_t*)(ws + WS_WQ); bf16_t* Wo = (bf16_t*)(ws + WS_WO); bf16_t* Wgu = (bf16_t*)(ws + WS_WGU); bf16_t* Wdn = (bf16_t*)(ws + WS_WDN); \
    float* XA = (float*)(ws + WS_XA); bf16_t* XBF = (bf16_t*)(ws + WS_XBF); bf16_t* Y = (bf16_t*)(ws + WS_Y); bf16_t* QX = (bf16_t*)(ws + WS_QX); bf16_t* OX = (bf16_t*)(ws + WS_OX); \
    bf16_t* P = (bf16_t*)(ws + WS_U1); bf16_t* XS = (bf16_t*)(ws + WS_U1); float* PARK = (float*)(ws + WS_U2); bf16_t* HID = (bf16_t*)(ws + WS_U2); \
    (void)0

struct MegaArgs { const float* in[26]; float* out; unsigned char* ws; double inv[8]; int ph_lo, ph_hi; };
constexpr int N_PHASES = 24;
__global__ void __launch_bounds__(512, 2) mega_fwd(MegaArgs args) {
    extern __shared__ __attribute__((aligned(16))) unsigned char lds_raw[];
    LAS unsigned char* lds = (LAS unsigned char*)lds_raw;
    LAS int* LC = (LAS int*)(lds + LDSCTL_OFF);
    const int G = (int)gridDim.x, bx = (int)blockIdx.x, ngw = G * 8;
    int* ctl = (int*)(args.ws + WS_CTL);
    for (int u = threadIdx.x; u < 1024; u += 512) LC[u] = 0;
    __syncthreads();
    const int lo = args.ph_lo, hi = args.ph_hi;
    const bool multi = (hi - lo) > 1;
    XcdBarrier bar; bar.bar = (unsigned*)(ctl + CW_BAR); bar.x = 0; bar.st = nullptr;
    if (multi) bar = xcd_barrier_post((unsigned*)(ctl + CW_BAR), (volatile LAS unsigned*)(LC + LC_MISC + 8));
#define IN(k) (lo <= (k) && (k) < hi)
#define BAR(k) do { if (IN(k) && IN((k) + 1)) xcd_barrier(bar); } while (0)

    if (IN(0)) { PHASE_PTRS;
        LAS unsigned long long* jp = (LAS unsigned long long*)(lds + LDSCTL_OFF + LC_JOBS_BYTE);
        LAS int* ji = (LAS int*)(lds + LDSCTL_OFF + LC_JOBS_BYTE + 1024);
        if (tid == 0) {
            int first = 0, nj = 0;
#define ADDJOB(SRC, DST, GAIN, KK, NN, NB, PERM) do { jp[3 * nj] = (unsigned long long)(uintptr_t)(SRC); jp[3 * nj + 1] = (unsigned long long)(uintptr_t)(DST); jp[3 * nj + 2] = (unsigned long long)(uintptr_t)(GAIN); \
            const int ipm_ = ((KK) / 64) * ((NN) / 32); ji[8 * nj] = (KK); ji[8 * nj + 1] = (NN); ji[8 * nj + 2] = ipm_; ji[8 * nj + 3] = first; ji[8 * nj + 4] = ipm_ * (NB); ji[8 * nj + 5] = (PERM); first += ipm_ * (NB); ++nj; } while (0)
            ADDJOB(moe_w_gate_up, Wgu, norm_ffn, 1024, 1024, 32, 1);
            ADDJOB(moe_w_gate_up + (size_t)32 * 1024 * 1024, Wgu + (size_t)32 * 1024 * 1024, norm_ffn + 1024, 1024, 1024, 32, 1);
            ADDJOB(moe_w_down, Wdn, (const float*)nullptr, 512, 1024, 32, 0);
            ADDJOB(moe_w_down + (size_t)32 * 512 * 1024, Wdn + (size_t)32 * 512 * 1024, (const float*)nullptr, 512, 1024, 32, 0);
            ADDJOB(mem_w_kv, Wmem, mem_norm, 1024, 1024, 1, 0);
            ADDJOB(hyb_w_in, Win, norm_mix, 1024, 3072, 1, 0);
            ADDJOB(hyb_w_out, Wout0, (const float*)nullptr, 1024, 1024, 1, 0);
            ADDJOB(swa_w_qkv, Wqkv, norm_mix + 1024, 1024, 1536, 1, 0);
            ADDJOB(swa_w_out, Wout1, (const float*)nullptr, 1024, 1024, 1, 0);
            ADDJOB(xattn_w_q, Wq, norm_xattn, 1024, 512, 1, 0);
            ADDJOB(xattn_w_q + (size_t)1024 * 512, Wq + (size_t)512 * 1024, norm_xattn + 1024, 1024, 512, 1, 0);
            ADDJOB(xattn_w_o, Wo, (const float*)nullptr, 512, 1024, 1, 0);
            ADDJOB(xattn_w_o + (size_t)512 * 1024, Wo + (size_t)1024 * 512, (const float*)nullptr, 512, 1024, 1, 0);
#undef ADDJOB
        }
        __syncthreads();
        LAS float* scr = (LAS float*)(lds + wave * 16384);
#pragma unroll 1
        for (int j = 0; j < 13; ++j) {
            const float* jsrc = (const float*)(uintptr_t)jp[3 * j]; bf16_t* jdst = (bf16_t*)(uintptr_t)jp[3 * j + 1]; const float* jgain = (const float*)(uintptr_t)jp[3 * j + 2];
            const int jK = ji[8 * j], jN = ji[8 * j + 1], jipm = ji[8 * j + 2], jfirst = ji[8 * j + 3], jn = ji[8 * j + 4], jperm = ji[8 * j + 5];
            int loc = (gw - jfirst) % ngw; if (loc < 0) loc += ngw;
            for (; loc < jn; loc += ngw) { const int bidx = loc / jipm, item = loc - bidx * jipm; const size_t mo = (size_t)bidx * jK * jN;
                wt_item(jsrc + mo, jK, jN, jgain, jdst + mo, jperm, scr, item, lane); }
        }
        { const int gid = bx * 512 + tid, nth = G * 512;
          for (int i = gid; i < SEQ * 8; i += nth) { const int pos = i >> 3, jx = i & 7; float c, s; sincos_d((double)pos * args.inv[jx], c, s); ropeC[i] = c; ropeS[i] = s; }
          for (int i = gid; i < 2 * 64 * 1024; i += nth) { const int l = i >> 16, c = (i >> 10) & 63, k = i & 1023; const float g = norm_ffn[l * 1024 + k];
              WRt[i] = (c < 4) ? g * moe_w_group[(size_t)(l * 1024 + k) * 4 + c] : (c < 36) ? g * moe_w_router[(size_t)(l * 1024 + k) * 32 + (c - 4)] : 0.f; }
          if (gid == 0) { float s01 = 0.f, s23 = 0.f; for (int d = 0; d < 64; ++d) { s01 += diff_lambda[d] * diff_lambda[64 + d]; s23 += diff_lambda[128 + d] * diff_lambda[192 + d]; }
              lam[0] = expf(s01) - expf(s23) + 0.2f; } }
        rowprep_rows(x, XBF, ssq, T_TOK, gw, ngw, lane);
        rowprep_rows(mem, memb, ssqm, TMEM, gw, ngw, lane);
    }
    BAR(0);
    if (IN(1)) { PHASE_PTRS;
        { pg8::Gemm g{memb, Wmem, TMEM, 1024, 1024, 0}; pg8::StaticOrder S; S.init(TMEM, 1024, G, (bx + 64) % G);
          EpiProj E; E.O = mkv; E.ssq = ssqm; E.bias = nullptr; E.ropeC = ropeC; E.ropeS = ropeS; E.ldc = 1024; E.rope_lo = 0; E.rope_hi = 0; E.pad = 0;
          pg8::gemm_phase<EpiProj, pg8::StaticOrder, true, true>(lds, g, S, E); }
        __syncthreads();
        { pg8::Gemm g{XBF, Win, T_TOK, 3072, 1024, 0}; pg8::StaticOrder S; S.init(T_TOK, 3072, G, bx);
          EpiProj E; E.O = P; E.ssq = ssq; E.bias = nullptr; E.ropeC = ropeC; E.ropeS = ropeS; E.ldc = 3072; E.rope_lo = 1536; E.rope_hi = 2560; E.pad = 0;
          pg8::gemm_phase<EpiProj, pg8::StaticOrder, true, true>(lds, g, S, E); }
    }
    BAR(1);
    if (IN(2)) { PHASE_PTRS;
        const float lamv = lam[0];
        for (int cu = bx; cu < 256; cu += G) {
            const int bh = cu >> 2, j = cu & 3;
            att::diff_unit((ATT_LAS char*)lds, P, diff_subln, lamv, Y, PARK, bh >> 2, bh & 3, 7 - j);
            att::diff_unit((ATT_LAS char*)lds, P, diff_subln, lamv, Y, PARK, bh >> 2, bh & 3, j);
            att::conv_tokens(P, hyb_conv_w, Y, cu * 128);
        }
    }
    BAR(2);
    if (IN(3)) { PHASE_PTRS;
        pg8::Gemm g{Y, Wout0, T_TOK, 1024, 1024, 0}; pg8::StaticOrder S; S.init(T_TOK, 1024, G, bx);
        EpiResid E; E.xin = x; E.xout = XA; E.xb = XBF; E.ssq = ssq; E.bias = nullptr;
        pg8::gemm_phase<EpiResid, pg8::StaticOrder, true, true>(lds, g, S, E);
    }
    BAR(3);
#pragma unroll 1
    for (int l = 0; l < 2; ++l) {
        int* lctl = ctl + l * CI_STRIDE;
        if (l == 1) {
            if (IN(12)) { PHASE_PTRS;
                pg8::Gemm g{XBF, Wqkv, T_TOK, 1536, 1024, 0}; pg8::StaticOrder S; S.init(T_TOK, 1536, G, bx);
                EpiProj E; E.O = P; E.ssq = ssq; E.bias = swa_b_qkv; E.ropeC = ropeC; E.ropeS = ropeS; E.ldc = 1536; E.rope_lo = 0; E.rope_hi = 1280; E.pad = 0;
                pg8::gemm_phase<EpiProj, pg8::StaticOrder, true, true>(lds, g, S, E);
            }
            BAR(12);
            if (IN(13)) { PHASE_PTRS; for (int u = bx; u < 512; u += G) att::swa_unit((ATT_LAS char*)lds, P, swa_sinks, Y, u); }
            BAR(13);
            if (IN(14)) { PHASE_PTRS;
                pg8::Gemm g{Y, Wout1, T_TOK, 1024, 1024, 0}; pg8::StaticOrder S; S.init(T_TOK, 1024, G, bx);
                EpiResid E; E.xin = XA; E.xout = XA; E.xb = XBF; E.ssq = ssq; E.bias = swa_b_out;
                pg8::gemm_phase<EpiResid, pg8::StaticOrder, true, true>(lds, g, S, E);
            }
            BAR(14);
        }
        const int cb = l ? 15 : 4;
        if (IN(cb)) { PHASE_PTRS;
            pg8::Gemm g{XBF, Wq + (size_t)l * 512 * 1024, T_TOK, 512, 1024, 0}; pg8::StaticOrder S; S.init(T_TOK, 512, G, bx);
            EpiProj E; E.O = QX; E.ssq = ssq; E.bias = nullptr; E.ropeC = ropeC; E.ropeS = ropeS; E.ldc = 512; E.rope_lo = 0; E.rope_hi = 0; E.pad = 0;
            pg8::gemm_phase<EpiProj, pg8::StaticOrder, true, true>(lds, g, S, E);
        }
        BAR(cb);
        if (IN(cb + 1)) { PHASE_PTRS; for (int u = bx; u < 256; u += G) att::xattn_unit((ATT_LAS char*)lds, QX, mkv, OX, u); }
        BAR(cb + 1);
        if (IN(cb + 2)) { PHASE_PTRS;
            pg8::Gemm g{OX, Wo + (size_t)l * 1024 * 512, T_TOK, 1024, 512, 0}; pg8::StaticOrder S; S.init(T_TOK, 1024, G, bx);
            EpiResid E; E.xin = XA; E.xout = XA; E.xb = XBF; E.ssq = ssq; E.bias = nullptr;
            pg8::gemm_phase<EpiResid, pg8::StaticOrder, true, true>(lds, g, S, E);
        }
        BAR(cb + 2);
        if (IN(cb + 3)) { PHASE_PTRS;
            __syncthreads();
            if (tid < 64) LC[LC_HIST + tid] = 0;
            for (int i = bx * 512 + tid; i < SPAD; i += G * 512) tok_of_slot[i] = -1;
            __syncthreads();
            for (int grp = wave * G + bx; grp < T_TOK / 32; grp += 8 * G)
                route_group(XA, ssq, WRt + (size_t)l * 64 * 1024, moe_b_group + l * 4, moe_b_router + l * 32, grp * 32, (LAS float*)(lds + wave * 16384), LC + LC_HIST, route_e, route_w, rs_tok, lane);
            __syncthreads();
            if (tid < 64) { const int c = LC[LC_HIST + tid]; if (c > 0) atomicAdd(lctl + CI_CNT + tid, c); }
        }
        BAR(cb + 3);
        if (IN(cb + 4)) { PHASE_PTRS;
            __syncthreads();
            if (wave == 0) {
                const int cnt = lctl[CI_CNT + lane]; const int tiles = (cnt + 255) >> 8;
                int incl = tiles;
#pragma unroll
                for (int o = 1; o < 64; o <<= 1) { const int t = __shfl_up(incl, o); if (lane >= o) incl += t; }
                const int base = incl - tiles;
                LC[LC_LBASE + lane] = base * 256;
                if (bx == 0) {
                    for (int i = 0; i < tiles; ++i) lctl[CI_TEXP + base + i] = lane & 31;
                    if (lane == 31) lctl[CI_NT] = incl;
                    if (lane == 63) lctl[CI_NT + 1] = incl;
                }
            }
            for (int chunk = bx; chunk < T_TOK / 128; chunk += G) {
                __syncthreads();
                if (tid < 64) LC[LC_HIST + tid] = 0;
                __syncthreads();
                int L = 0, rank = 0; const int tokp = chunk * 128 + (tid >> 1), kq = tid & 1;
                if (tid < 256) { L = kq * 32 + route_e[tokp * 2 + kq]; rank = __hip_atomic_fetch_add(LC + LC_HIST + L, 1, __ATOMIC_RELAXED, __HIP_MEMORY_SCOPE_WORKGROUP); }
                __syncthreads();
                if (tid < 64) { const int c = LC[LC_HIST + tid]; LC[LC_RSV + tid] = (c > 0) ? atomicAdd(lctl + CI_CUR + tid, c) : 0; }
                __syncthreads();
                if (tid < 256) { const int slot = LC[LC_LBASE + L] + LC[LC_RSV + L] + rank; LC[LC_SLOTS + tid] = slot;
                    tok_of_slot[slot] = tokp; w_of_slot[slot] = route_w[tokp * 2 + kq]; rs_of_slot[slot] = rs_tok[tokp]; }
                __syncthreads();
                for (int pr = wave * 32; pr < wave * 32 + 32; ++pr) { const int slot = LC[LC_SLOTS + pr]; const int tk = chunk * 128 + (pr >> 1);
                    const u32x4* src = (const u32x4*)(XBF + (size_t)tk * DM); u32x4* dst = (u32x4*)(XS + (size_t)slot * DM);
                    dst[lane] = src[lane]; dst[lane + 64] = src[lane + 64]; }
            }
        }
        BAR(cb + 4);
        if (IN(cb + 5)) { PHASE_PTRS;
            pg8::Gemm g{XS, Wgu + (size_t)l * 32 * 1024 * 1024, SPAD, 1024, 1024, 0};
            GroupedOrder S; S.tile_expert = lctl + CI_TEXP; S.nN = 4; S.G = G; S.c = bx; S.tiles_per_expert = 4; S.t_lo = 0; S.t_hi = lctl[CI_NT + 1];
            EpiGateUp E; E.hid = HID; E.rs_slot = rs_of_slot;
            pg8::gemm_phase<EpiGateUp, GroupedOrder, true, true>(lds, g, S, E);
        }
        BAR(cb + 5);
#pragma unroll 1
        for (int pass = 0; pass < 2; ++pass) {
            if (IN(cb + 6 + pass)) { PHASE_PTRS;
                pg8::Gemm g{HID, Wdn + (size_t)l * 32 * 1024 * 512, SPAD, 1024, 512, 0};
                const int nt0 = lctl[CI_NT], nt1 = lctl[CI_NT + 1];
                GroupedOrder S; S.tile_expert = lctl + CI_TEXP; S.nN = 4; S.G = G; S.c = bx; S.tiles_per_expert = 4; S.t_lo = pass ? nt0 : 0; S.t_hi = pass ? nt1 : nt0;
                EpiDown E; E.x = XA; E.xb = XBF; E.ssq = ssq; E.tok_of_slot = tok_of_slot; E.w_of_slot = w_of_slot; E.last = pass; E.pad = 0;
                pg8::gemm_phase<EpiDown, GroupedOrder, true, true>(lds, g, S, E);
            }
            BAR(cb + 6 + pass);
        }
    }
    if (IN(23)) { PHASE_PTRS;
        for (int row = gw; row < T_TOK; row += ngw) {
            const f32x4* xr = (const f32x4*)(XA + (size_t)row * DM) + lane; f32x4 v[4]; float s = 0.f;
#pragma unroll
            for (int jx = 0; jx < 4; ++jx) { v[jx] = xr[64 * jx]; s += (v[jx].x * v[jx].x + v[jx].y * v[jx].y) + (v[jx].z * v[jx].z + v[jx].w * v[jx].w); }
            const float rs = 1.0f / sqrtf(wave_sum(s) * (1.0f / 1024.0f) + EPS);
            f32x4* orow = (f32x4*)(args.out + (size_t)row * DM) + lane; const f32x4* gr = (const f32x4*)final_norm + lane;
#pragma unroll
            for (int jx = 0; jx < 4; ++jx) orow[64 * jx] = v[jx] * rs * gr[64 * jx];
        }
    }
#undef IN
#undef BAR
}

#ifndef MK_PER_PHASE
#define MK_PER_PHASE 0
#endif
extern "C" void kernel_launch(void* const* d_in, const int* in_sizes, int n_in, void* d_out, int out_size, void* d_ws, size_t ws_size, hipStream_t stream) {
    static int grid = 0;
    if (grid == 0) {
        if (n_in != 26 || ws_size < WS_END || out_size != T_TOK * DM) { fprintf(stderr, "kernel_launch: unexpected n_in %d / out %d / ws %zu\n", n_in, out_size, ws_size); grid = -1; return; }
        int dev = 0, cus = 0, per_cu = 0;
        if (hipGetDevice(&dev) != hipSuccess || hipDeviceGetAttribute(&cus, hipDeviceAttributeMultiprocessorCount, dev) != hipSuccess) { grid = -1; return; }
        if (hipFuncSetAttribute((const void*)mega_fwd, hipFuncAttributeMaxDynamicSharedMemorySize, LDS_BYTES) != hipSuccess) { fprintf(stderr, "kernel_launch: hipFuncSetAttribute failed\n"); grid = -1; return; }
        if (hipOccupancyMaxActiveBlocksPerMultiprocessor(&per_cu, (const void*)mega_fwd, 512, LDS_BYTES) != hipSuccess || per_cu < 1) { fprintf(stderr, "kernel_launch: occupancy query says %d\n", per_cu); per_cu = 1; }
        (void)hipGetLastError();
        grid = cus;
    }
    if (grid < 0) return;
    (void)hipMemsetAsync((char*)d_ws + WS_CTL, 0, CTL_ZERO_BYTES, stream);
    MegaArgs a{};
    for (int i = 0; i < 26; ++i) a.in[i] = (const float*)d_in[i];
    a.out = (float*)d_out; a.ws = (unsigned char*)d_ws;
    for (int jx = 0; jx < 8; ++jx) a.inv[jx] = pow(500000.0, -(double)(2 * jx) / 16.0);
#if MK_PER_PHASE
    for (int ph = 0; ph < N_PHASES; ++ph) { a.ph_lo = ph; a.ph_hi = ph + 1; hipLaunchKernelGGL(mega_fwd, dim3(grid), dim3(512), LDS_BYTES, stream, a); }
#else
    a.ph_lo = 0; a.ph_hi = N_PHASES;
    hipLaunchKernelGGL(mega_fwd, dim3(grid), dim3(512), LDS_BYTES, stream, a);
#endif
}
```

```cpp
#include <hip/hip_runtime.h>
#include <cstdio>
#include <cstdint>
#include <cmath>
namespace pg8 {
#define PG8_LAS __attribute__((address_space(3)))
typedef unsigned short bf16_t;
typedef short bf16x8 __attribute__((ext_vector_type(8)));
typedef float f32x4 __attribute__((ext_vector_type(4)));
typedef unsigned u32x4 __attribute__((ext_vector_type(4)));
constexpr int BM = 256, BK = 64, HALF = 128, HTB = HALF * BK * 2  , STAGE_BYTES = 8 * HTB, NXCD = 8, WGM = 8;

__host__ __device__ __forceinline__ int lds_byte(int r, int c) { const int st = (r >> 4) * 2 + (c >> 5), rr = r & 15, cc = c & 31, ob = rr * 64 + cc * 2; return st * 1024 + (ob ^ (((ob >> 9) & 1) << 5)); }
__host__ __device__ __forceinline__ void stage_rc(int b, int& R, int& C) { const int st = b / 1024, sb = b % 1024, swz = sb ^ (((sb >> 9) & 1) << 5); R = (st >> 1) * 16 + swz / 64; C = (st & 1) * 32 + (swz % 64) / 2; }
__host__ __device__ __forceinline__ int perm32(int rho) { const int n = rho >> 4, i = rho & 15; return 8 * (i >> 2) + 4 * n + (i & 3); }

struct Unit { int pm, pn, brow; };
struct Gemm { const bf16_t* A; const bf16_t* Bt; int M, N, K, pad; };

struct StaticOrder {
    int nM, nN, nwg, G, c;
    __host__ __device__ void init(int M, int N, int G_, int c_) { nM = M / BM; nN = N / BM; nwg = nM * nN; G = G_; c = c_; }
    __host__ __device__ bool next(int i, Unit& u) const {
        const long L = (long)i * G + c; if (L >= nwg) return false;
        int wgid = (int)L; { const int q = nwg / NXCD, r = nwg % NXCD, xcd = wgid % NXCD, off = wgid / NXCD; wgid = (xcd < r ? xcd * (q + 1) : r * (q + 1) + (xcd - r) * q) + off; }
        const int nig = WGM * nN, gid = wgid / nig, fm = gid * WGM, gsz = (nM - fm) < WGM ? (nM - fm) : WGM;
        u.pm = fm + ((wgid % nig) % gsz); u.pn = (wgid % nig) / gsz; u.brow = 0; return true;
    }
    __device__ __forceinline__ void a_ready(const Unit&) const {}
    __device__ __forceinline__ void done(const Unit&) const {}
};

__device__ __forceinline__ unsigned cvt_pk_bf16(float lo, float hi) { unsigned r; asm volatile("v_cvt_pk_bf16_f32 %0, %1, %2" : "=v"(r) : "v"(lo), "v"(hi)); return r; }
template <class Epi, class Sched, bool ALIGN_EPI = false, bool SP2 = false>
__device__ __forceinline__ void gemm_phase(PG8_LAS unsigned char* lds, const Gemm g, const Sched& S, const Epi& E) {
    int tid_l = threadIdx.x; asm volatile("" : "+v"(tid_l));
    const int tid = tid_l, wid = __builtin_amdgcn_readfirstlane(tid >> 6), lane = tid & 63, wr = wid >> 2, wc = wid & 3, fr = lane & 15, fq = lane >> 4;
    const int K = g.K, nt = K / BK;
    unsigned voffA[2], voffB[2];
#pragma unroll
    for (int i = 0; i < 2; ++i) { int R, C; stage_rc(tid * 16 + i * 8192, R, C); const int Rb = Epi::PERM ? ((R & ~31) + perm32(R & 31)) : R;
        voffA[i] = (unsigned)(R * K + C) * 2u; voffB[i] = (unsigned)(Rb * K + C) * 2u; }
    const size_t kstep = (size_t)(BK * 2);
    const size_t hstep = (size_t)HALF * K * 2;
    const size_t tstep = 2 * hstep;
    const unsigned ldsw = (unsigned)wid * 1024u;
    const int aoff = lds_byte(wr * 64 + fr, fq * 8), boff = lds_byte(wc * 32 + fr, fq * 8);
#define PG8_SA(b, h) (((b) * 2 + (h)) * HTB)
#define PG8_SB(b, h) ((4 + (b) * 2 + (h)) * HTB)
#define PG8_STAGE(bufoff, gbase, voff) do { _Pragma("unroll") for (int _i = 0; _i < 2; ++_i) \
        __builtin_amdgcn_global_load_lds((const unsigned*)((const char*)(gbase) + (voff)[_i]), (PG8_LAS unsigned*)(lds + (bufoff) + ldsw + _i * 8192), 16, 0, 0); } while (0)
#define PG8_LDA(dst, b, h) do { _Pragma("unroll") for (int m = 0; m < 4; ++m) _Pragma("unroll") for (int k = 0; k < 2; ++k) dst[m][k] = *(const PG8_LAS bf16x8*)(lds + PG8_SA(b, h) + aoff + m * 2048 + k * 1024); } while (0)
#define PG8_LDB(dst, b, h) do { _Pragma("unroll") for (int n = 0; n < 2; ++n) _Pragma("unroll") for (int k = 0; k < 2; ++k) dst[n][k] = *(const PG8_LAS bf16x8*)(lds + PG8_SB(b, h) + boff + n * 2048 + k * 1024); } while (0)
#define PG8_MMA(ai, bj, At, Bt) do { __builtin_amdgcn_s_setprio(1); _Pragma("unroll") for (int m = 0; m < 4; ++m) _Pragma("unroll") for (int n = 0; n < 2; ++n) _Pragma("unroll") for (int k = 0; k < 2; ++k) \
        acc[ai][bj][m][n] = __builtin_amdgcn_mfma_f32_16x16x32_bf16(Bt[n][k], At[m][k], acc[ai][bj][m][n], 0, 0, 0); __builtin_amdgcn_s_setprio(0); } while (0)
#define PG8_WAIT_V(n) asm volatile("s_waitcnt vmcnt(" #n ")" ::: "memory")
#define PG8_WAIT_L(n) asm volatile("s_waitcnt lgkmcnt(" #n ")" ::: "memory")
#define PG8_BAR __builtin_amdgcn_s_barrier()
#define PG8_SCHED __builtin_amdgcn_sched_barrier(0)
    Unit cur, nxt; int ui = 0;
    if (!S.next(0, cur)) return;
    f32x4 acc[2][2][4][2];
#pragma unroll
    for (int a = 0; a < 2; ++a)
#pragma unroll
        for (int b = 0; b < 2; ++b)
#pragma unroll
            for (int m = 0; m < 4; ++m)
#pragma unroll
                for (int n = 0; n < 2; ++n) acc[a][b][m][n] = (f32x4){0.f, 0.f, 0.f, 0.f};
    bf16x8 At[4][2], B0[2][2], B1[2][2];
    const char* cA = (const char*)g.A + (size_t)cur.pm * tstep; const char* cB = (const char*)g.Bt + (size_t)(cur.brow + cur.pn) * tstep;
    S.a_ready(cur);
    if constexpr (SP2) {
        PG8_STAGE(PG8_SB(0, 0), cB, voffB); PG8_STAGE(PG8_SB(0, 1), cB + hstep, voffB); PG8_STAGE(PG8_SA(0, 0), cA, voffA); PG8_STAGE(PG8_SA(0, 1), cA + hstep, voffA);
        if (wr == 1) PG8_BAR;
        PG8_WAIT_V(2); PG8_BAR;
        PG8_STAGE(PG8_SB(1, 0), cB + kstep, voffB); PG8_STAGE(PG8_SA(1, 0), cA + kstep, voffA); PG8_STAGE(PG8_SB(1, 1), cB + hstep + kstep, voffB);
        PG8_WAIT_V(6); PG8_BAR;
    } else {
        PG8_STAGE(PG8_SB(0, 0), cB, voffB); PG8_STAGE(PG8_SA(0, 0), cA, voffA); PG8_STAGE(PG8_SB(0, 1), cB + hstep, voffB); PG8_STAGE(PG8_SA(0, 1), cA + hstep, voffA);
        if (wr == 1) PG8_BAR;
        PG8_WAIT_V(4); PG8_BAR;
        PG8_STAGE(PG8_SB(1, 0), cB + kstep, voffB); PG8_STAGE(PG8_SA(1, 0), cA + kstep, voffA); PG8_STAGE(PG8_SB(1, 1), cB + hstep + kstep, voffB);
        PG8_WAIT_V(6); PG8_BAR;
    }
    for (;;) {
        const bool has_next = S.next(ui + 1, nxt);
        const char* nA = has_next ? (const char*)g.A + (size_t)nxt.pm * tstep : cA; const char* nB = has_next ? (const char*)g.Bt + (size_t)(nxt.brow + nxt.pn) * tstep : cB;
        for (int t = 0; t < nt; t += 2) {
            const bool last = (t == nt - 2);
            const char* a1 = cA + (size_t)(t + 1) * kstep;
            const char* a2 = last ? nA : cA + (size_t)(t + 2) * kstep; const char* b2 = last ? nB : cB + (size_t)(t + 2) * kstep;
            const char* a3 = a2 + kstep; const char* b3 = b2 + kstep;
            if (last && has_next) S.a_ready(nxt);
            if constexpr (SP2) {
            PG8_LDB(B0, 0, 0); PG8_LDB(B1, 0, 1); PG8_SCHED; PG8_LDA(At, 0, 0); PG8_STAGE(PG8_SA(1, 1), a1 + hstep, voffA);
            PG8_WAIT_V(8); PG8_WAIT_L(0); PG8_BAR; PG8_MMA(0, 0, At, B0); PG8_MMA(0, 1, At, B1); PG8_BAR; PG8_SCHED;
            PG8_LDA(At, 0, 1); PG8_STAGE(PG8_SB(0, 0), b2, voffB); PG8_STAGE(PG8_SB(0, 1), b2 + hstep, voffB); PG8_STAGE(PG8_SA(0, 0), a2, voffA);
            PG8_WAIT_V(8); PG8_WAIT_L(0); PG8_BAR; PG8_MMA(1, 0, At, B0); PG8_MMA(1, 1, At, B1); PG8_BAR; PG8_SCHED;
            PG8_LDB(B0, 1, 0); PG8_LDB(B1, 1, 1); PG8_SCHED; PG8_LDA(At, 1, 0); PG8_STAGE(PG8_SA(0, 1), a2 + hstep, voffA);
            PG8_WAIT_V(8); PG8_WAIT_L(0); PG8_BAR; PG8_MMA(0, 0, At, B0); PG8_MMA(0, 1, At, B1); PG8_BAR; PG8_SCHED;
            PG8_LDA(At, 1, 1); PG8_STAGE(PG8_SB(1, 0), b3, voffB); PG8_STAGE(PG8_SB(1, 1), b3 + hstep, voffB); PG8_STAGE(PG8_SA(1, 0), a3, voffA);
            PG8_WAIT_V(8); PG8_WAIT_L(0); PG8_BAR; PG8_MMA(1, 0, At, B0); PG8_MMA(1, 1, At, B1); PG8_BAR; PG8_SCHED;
            } else {
            PG8_LDB(B0, 0, 0); PG8_SCHED; PG8_LDA(At, 0, 0); PG8_STAGE(PG8_SA(1, 1), a1 + hstep, voffA);
            PG8_WAIT_L(8); PG8_BAR; PG8_WAIT_L(0); PG8_MMA(0, 0, At, B0); PG8_BAR; PG8_SCHED;
            PG8_LDB(B1, 0, 1); PG8_STAGE(PG8_SB(0, 0), b2, voffB);
            PG8_BAR; PG8_WAIT_L(0); PG8_MMA(0, 1, At, B1); PG8_BAR;
            PG8_LDA(At, 0, 1); PG8_STAGE(PG8_SA(0, 0), a2, voffA);
            PG8_BAR; PG8_WAIT_L(0); PG8_MMA(1, 0, At, B0); PG8_BAR; PG8_SCHED;
            PG8_STAGE(PG8_SB(0, 1), b2 + hstep, voffB);
            PG8_WAIT_V(6); PG8_BAR; PG8_MMA(1, 1, At, B1); PG8_BAR;
            PG8_LDB(B0, 1, 0); PG8_SCHED; PG8_LDA(At, 1, 0); PG8_STAGE(PG8_SA(0, 1), a2 + hstep, voffA);
            PG8_WAIT_L(8); PG8_BAR; PG8_WAIT_L(0); PG8_MMA(0, 0, At, B0); PG8_BAR; PG8_SCHED;
            PG8_LDB(B1, 1, 1); PG8_STAGE(PG8_SB(1, 0), b3, voffB);
            PG8_BAR; PG8_WAIT_L(0); PG8_MMA(0, 1, At, B1); PG8_BAR;
            PG8_LDA(At, 1, 1); PG8_STAGE(PG8_SA(1, 0), a3, voffA);
            PG8_BAR; PG8_WAIT_L(0); PG8_MMA(1, 0, At, B0); PG8_BAR; PG8_SCHED;
            PG8_STAGE(PG8_SB(1, 1), b3 + hstep, voffB);
            PG8_WAIT_V(6); PG8_BAR; PG8_MMA(1, 1, At, B1); PG8_BAR;
            }
        }
        if constexpr (ALIGN_EPI) { if (wr == 0) PG8_BAR; }
        if constexpr (!Epi::AFTER_DRAIN) { E(acc, cur, wr, wc, fr, fq); S.done(cur); }
        if (!has_next) break;
#pragma unroll
        for (int a = 0; a < 2; ++a)
#pragma unroll
            for (int b = 0; b < 2; ++b)
#pragma unroll
                for (int m = 0; m < 4; ++m)
#pragma unroll
                    for (int n = 0; n < 2; ++n) acc[a][b][m][n] = (f32x4){0.f, 0.f, 0.f, 0.f};
        cur = nxt; cA = nA; cB = nB; ++ui;
        if constexpr (ALIGN_EPI) { if (wr == 1) PG8_BAR; }
    }
    PG8_WAIT_V(0);
    if constexpr (!ALIGN_EPI) { if (wr == 0) PG8_BAR; }
    PG8_BAR;
    if constexpr (Epi::AFTER_DRAIN) { E.fused(acc, cur, wr, wc, fr, fq, lds, wid, lane); S.done(cur); }
#undef PG8_SA
#undef PG8_SB
#undef PG8_STAGE
#undef PG8_LDA
#undef PG8_LDB
#undef PG8_MMA
#undef PG8_WAIT_V
#undef PG8_WAIT_L
#undef PG8_BAR
#undef PG8_SCHED
}
}

using pg8::bf16_t; using pg8::f32x4; using pg8::u32x4; using pg8::Unit;
constexpr int T_TOK = 32768, DM = 1024, SEQ = 2048, NBATCH = 16, MEML = 256, TMEM = 4096, SPAD = 81920;
constexpr float EPS = 1e-6f;
constexpr float LOG2E = 1.4426950408889634f;
constexpr size_t MiB = 1u << 20;
constexpr size_t WS_CTL = 0, CTL_ZERO_BYTES = 64 * 1024;
constexpr size_t WS_ROPEC = 1 * MiB, WS_ROPES = 1 * MiB + 64 * 1024, WS_WR = 1 * MiB + 128 * 1024  , WS_LAM = 1 * MiB + 512 * 1024;
constexpr size_t WS_SSQ = 2 * MiB, WS_SSQM = 4 * MiB;
constexpr size_t WS_TOKSLOT = 5 * MiB, WS_WSLOT = 5 * MiB + 512 * 1024, WS_RSSLOT = 6 * MiB;
constexpr size_t WS_ROUTE_E = 7 * MiB, WS_ROUTE_W = 7 * MiB + 512 * 1024, WS_RSTOK = 8 * MiB;
constexpr size_t WS_MEMB = 10 * MiB, WS_MKV = 18 * MiB;
constexpr size_t WS_WMEM = 26 * MiB, WS_WIN = 28 * MiB, WS_WOUT0 = 34 * MiB, WS_WQKV = 36 * MiB, WS_WOUT1 = 39 * MiB, WS_WQ = 41 * MiB, WS_WO = 43 * MiB,
                 WS_WGU = 45 * MiB, WS_WDN = 173 * MiB;
constexpr size_t WS_XA = 240 * MiB, WS_XBF = 368 * MiB, WS_Y = 432 * MiB, WS_QX = 496 * MiB, WS_OX = 528 * MiB, WS_U1 = 560 * MiB, WS_U2 = 752 * MiB, WS_END = 880 * MiB;
constexpr int CI_CNT = 0, CI_CUR = 64, CI_LBASE = 128, CI_NT = 192, CI_TEXP = 256, CI_STRIDE = 1024;

__device__ __forceinline__ unsigned f2bf(float f) { unsigned u = __builtin_bit_cast(unsigned, f); return (u + 0x7fffu + ((u >> 16) & 1u)) >> 16; }
__device__ __forceinline__ unsigned pk2(float lo, float hi) { return f2bf(lo) | (f2bf(hi) << 16); }
__device__ __forceinline__ float bflo(unsigned w) { return __builtin_bit_cast(float, w << 16); }
__device__ __forceinline__ float bfhi(unsigned w) { return __builtin_bit_cast(float, w & 0xffff0000u); }
__device__ __forceinline__ float bf2f(bf16_t h) { return __builtin_bit_cast(float, (unsigned)h << 16); }
__device__ __forceinline__ float wave_sum(float v) {
#pragma unroll
    for (int o = 1; o < 64; o <<= 1) v += __shfl_xor(v, o);
    return v;
}
__device__ __forceinline__ float row_rs(const float* ssq, int row) {
    const f32x4* p = (const f32x4*)(ssq + (size_t)row * 16);
    const f32x4 a = p[0], b = p[1], c = p[2], d = p[3];
    const float s = (((a.x + a.y) + (a.z + a.w)) + ((b.x + b.y) + (b.z + b.w))) + (((c.x + c.y) + (c.z + c.w)) + ((d.x + d.y) + (d.z + d.w)));
    return 1.0f / sqrtf(s * (1.0f / 1024.0f) + EPS);
}

struct EpiProj {
    static constexpr bool PERM = true, AFTER_DRAIN = false;
    bf16_t* O; const float* ssq; const float* bias; const float* ropeC; const float* ropeS; int ldc, rope_lo, rope_hi, pad;
    __device__ __forceinline__ void operator()(const f32x4 (&acc)[2][2][4][2], const Unit& u, int wr, int wc, int fr, int fq) const {
        const int row0 = u.pm * 256 + wr * 64 + fr;
#pragma unroll
        for (int ai = 0; ai < 2; ++ai)
#pragma unroll
            for (int m = 0; m < 4; ++m) {
                const int row = row0 + ai * 128 + m * 16;
                const float rs = row_rs(ssq, row);
                const int pos = row & (SEQ - 1);
#pragma unroll
                for (int bj = 0; bj < 2; ++bj) {
                    const int col = u.pn * 256 + bj * 128 + wc * 32 + 8 * fq;
                    float v[8], pv[8];
#pragma unroll
                    for (int i = 0; i < 8; ++i) v[i] = acc[ai][bj][m][i >> 2][i & 3] * rs;
                    if (bias) {
                        const f32x4 b0 = *(const f32x4*)(bias + col), b1 = *(const f32x4*)(bias + col + 4);
#pragma unroll
                        for (int i = 0; i < 4; ++i) { v[i] += b0[i]; v[4 + i] += b1[i]; }
                    }
#pragma unroll
                    for (int i = 0; i < 8; ++i) pv[i] = __shfl_xor(v[i], 16);
                    if (col >= rope_lo && col < rope_hi && (col & 63) < 16) {
                        const f32x4 c0 = *(const f32x4*)(ropeC + pos * 8), c1 = *(const f32x4*)(ropeC + pos * 8 + 4);
                        const f32x4 s0 = *(const f32x4*)(ropeS + pos * 8), s1 = *(const f32x4*)(ropeS + pos * 8 + 4);
                        const float sg = (col & 8) ? 1.0f : -1.0f;
#pragma unroll
                        for (int i = 0; i < 4; ++i) { v[i] = v[i] * c0[i] + sg * pv[i] * s0[i]; v[4 + i] = v[4 + i] * c1[i] + sg * pv[4 + i] * s1[i]; }
                    }
                    u32x4 w; w.x = pk2(v[0], v[1]); w.y = pk2(v[2], v[3]); w.z = pk2(v[4], v[5]); w.w = pk2(v[6], v[7]);
                    *(u32x4*)(O + (size_t)row * ldc + col) = w;
                }
            }
    }
};
struct EpiResid {
    static constexpr bool PERM = true, AFTER_DRAIN = false;
    const float* xin; float* xout; bf16_t* xb; float* ssq; const float* bias;
    __device__ __forceinline__ void operator()(const f32x4 (&acc)[2][2][4][2], const Unit& u, int wr, int wc, int fr, int fq) const {
        const int row0 = u.pm * 256 + wr * 64 + fr;
#pragma unroll
        for (int ai = 0; ai < 2; ++ai)
#pragma unroll
            for (int m = 0; m < 4; ++m) {
                const int row = row0 + ai * 128 + m * 16;
                float ss = 0.f;
#pragma unroll
                for (int bj = 0; bj < 2; ++bj) {
                    const int col = u.pn * 256 + bj * 128 + wc * 32 + 8 * fq;
                    const size_t off = (size_t)row * DM + col;
                    f32x4 x0 = *(const f32x4*)(xin + off), x1 = *(const f32x4*)(xin + off + 4);
                    x0 += acc[ai][bj][m][0]; x1 += acc[ai][bj][m][1];
                    if (bias) { x0 += *(const f32x4*)(bias + col); x1 += *(const f32x4*)(bias + col + 4); }
                    *(f32x4*)(xout + off) = x0; *(f32x4*)(xout + off + 4) = x1;
                    u32x4 w; w.x = pk2(x0[0], x0[1]); w.y = pk2(x0[2], x0[3]); w.z = pk2(x1[0], x1[1]); w.w = pk2(x1[2], x1[3]);
                    *(u32x4*)(xb + off) = w;
                    ss += (x0[0] * x0[0] + x0[1] * x0[1]) + (x0[2] * x0[2] + x0[3] * x0[3]) + (x1[0] * x1[0] + x1[1] * x1[1]) + (x1[2] * x1[2] + x1[3] * x1[3]);
                }
                ss += __shfl_xor(ss, 16); ss += __shfl_xor(ss, 32);
                if (fq == 0) ssq[(size_t)row * 16 + u.pn * 4 + wc] = ss;
            }
    }
};
struct EpiGateUp {
    static constexpr bool PERM = true, AFTER_DRAIN = false;
    bf16_t* hid; const float* rs_slot;
    __device__ __forceinline__ void operator()(const f32x4 (&acc)[2][2][4][2], const Unit& u, int wr, int wc, int fr, int fq) const {
        const int row0 = u.pm * 256 + wr * 64 + fr;
#pragma unroll
        for (int ai = 0; ai < 2; ++ai)
#pragma unroll
            for (int m = 0; m < 4; ++m) {
                const int row = row0 + ai * 128 + m * 16;
                const float rs = rs_slot[row];
                float h[8];
#pragma unroll
                for (int i = 0; i < 8; ++i) { const float g = acc[ai][0][m][i >> 2][i & 3] * rs, up = acc[ai][1][m][i >> 2][i & 3] * rs; h[i] = g / (1.0f + __expf(-g)) * up; }
                u32x4 w; w.x = pk2(h[0], h[1]); w.y = pk2(h[2], h[3]); w.z = pk2(h[4], h[5]); w.w = pk2(h[6], h[7]);
                *(u32x4*)(hid + (size_t)row * 512 + u.pn * 128 + wc * 32 + 8 * fq) = w;
            }
    }
};
struct EpiDown {
    static constexpr bool PERM = true, AFTER_DRAIN = false;
    float* x; bf16_t* xb; float* ssq; const int* tok_of_slot; const float* w_of_slot; int last, pad;
    __device__ __forceinline__ void operator()(const f32x4 (&acc)[2][2][4][2], const Unit& u, int wr, int wc, int fr, int fq) const {
        const int row0 = u.pm * 256 + wr * 64 + fr;
#pragma unroll
        for (int ai = 0; ai < 2; ++ai)
#pragma unroll
            for (int m = 0; m < 4; ++m) {
                const int slot = row0 + ai * 128 + m * 16;
                const int tok = tok_of_slot[slot];
                const float wt = w_of_slot[slot];
                float ss = 0.f;
                if (tok >= 0) {
#pragma unroll
                    for (int bj = 0; bj < 2; ++bj) {
                        const int col = u.pn * 256 + bj * 128 + wc * 32 + 8 * fq;
                        const size_t off = (size_t)tok * DM + col;
                        f32x4 x0 = *(const f32x4*)(x + off), x1 = *(const f32x4*)(x + off + 4);
                        x0 += acc[ai][bj][m][0] * wt; x1 += acc[ai][bj][m][1] * wt;
                        *(f32x4*)(x + off) = x0; *(f32x4*)(x + off + 4) = x1;
                        if (last) {
                            u32x4 w; w.x = pk2(x0[0], x0[1]); w.y = pk2(x0[2], x0[3]); w.z = pk2(x1[0], x1[1]); w.w = pk2(x1[2], x1[3]);
                            *(u32x4*)(xb + off) = w;
                            ss += (x0[0] * x0[0] + x0[1] * x0[1]) + (x0[2] * x0[2] + x0[3] * x0[3]) + (x1[0] * x1[0] + x1[1] * x1[1]) + (x1[2] * x1[2] + x1[3] * x1[3]);
                        }
                    }
                }
                ss += __shfl_xor(ss, 16); ss += __shfl_xor(ss, 32);
                if (last && tok >= 0 && fq == 0) ssq[(size_t)tok * 16 + u.pn * 4 + wc] = ss;
            }
    }
};

struct GroupedOrder {
    const int* tile_expert; int t_lo, t_hi, nN, G, c, tiles_per_expert;
    __device__ __forceinline__ bool next(int i, Unit& u) const {
        const long L = (long)i * G + c; const long n = (long)(t_hi - t_lo) * nN; if (L >= n) return false;
        u.pm = t_lo + (int)(L / nN); u.pn = (int)(L % nN); u.brow = tile_expert[u.pm] * tiles_per_expert; return true;
    }
    __device__ __forceinline__ void a_ready(const Unit&) const {}
    __device__ __forceinline__ void done(const Unit&) const {}
};

namespace att {
#define ATT_LAS __attribute__((address_space(3)))
#define ATT_DI __device__ __forceinline__
typedef short bf16x8 __attribute__((ext_vector_type(8)));
typedef short s16x4 __attribute__((ext_vector_type(4)));
typedef float f32x16 __attribute__((ext_vector_type(16)));
typedef short v4i16_t __attribute__((ext_vector_type(4)));
typedef float f32x2_t __attribute__((ext_vector_type(2)));
typedef __bf16 bf16x2_t __attribute__((ext_vector_type(2)));
ATT_DI int crow(int reg, int h) { return (reg & 3) + 8 * (reg >> 2) + 4 * h; }
ATT_DI unsigned cvtpk(float lo, float hi) { f32x2_t v = {lo, hi}; bf16x2_t b = __builtin_convertvector(v, bf16x2_t); return __builtin_bit_cast(unsigned, b); }
ATT_DI s16x4 vtr(const ATT_LAS char* p) { return __builtin_bit_cast(s16x4, __builtin_amdgcn_ds_read_tr16_b64_v4i16((ATT_LAS v4i16_t*)p)); }
ATT_DI bf16x8 pack8(const f32x16& x, int s) {
    u32x4 p; p.x = cvtpk(x[8 * s + 0], x[8 * s + 1]); p.y = cvtpk(x[8 * s + 2], x[8 * s + 3]); p.z = cvtpk(x[8 * s + 4], x[8 * s + 5]); p.w = cvtpk(x[8 * s + 6], x[8 * s + 7]);
    return __builtin_bit_cast(bf16x8, p);
}
struct L256 { static constexpr int PITCH = 256; static ATT_DI int addr(int row, int byte) { return row * 256 + ((((byte >> 4) ^ (row & 15)) << 4) | (byte & 15)); } };
struct LPAD { static constexpr int PITCH = 144; static ATT_DI int addr(int row, int byte) { return row * 144 + byte; } };

template <int NKS, int NDB, class KLay, class Lay, bool MASK>
ATT_DI void tile64(const ATT_LAS char* kt, const ATT_LAS char* vt, int kcb, int vcb, const bf16x8 (&qf)[NKS], float& m, float& l, f32x16 (&O)[NDB], float c,
                   int r, int h, int g1, int tq, int tp, int qpos, int kpos0, int win) {
    f32x16 p0, p1;
#pragma unroll
    for (int i = 0; i < 16; ++i) { p0[i] = 0.f; p1[i] = 0.f; }
#pragma unroll
    for (int s = 0; s < NKS; ++s) {
        const bf16x8 a0 = *(const ATT_LAS bf16x8*)(kt + KLay::addr(r, kcb + 32 * s + 16 * h));
        const bf16x8 a1 = *(const ATT_LAS bf16x8*)(kt + KLay::addr(32 + r, kcb + 32 * s + 16 * h));
        p0 = __builtin_amdgcn_mfma_f32_32x32x16_bf16(a0, qf[s], p0, 0, 0, 0);
        p1 = __builtin_amdgcn_mfma_f32_32x32x16_bf16(a1, qf[s], p1, 0, 0, 0);
    }
    if (MASK) {
#pragma unroll
        for (int i = 0; i < 16; ++i) {
            const int k0 = kpos0 + crow(i, h), k1 = k0 + 32;
            if (k0 > qpos || k0 <= qpos - win || k0 < 0) p0[i] = -INFINITY;
            if (k1 > qpos || k1 <= qpos - win || k1 < 0) p1[i] = -INFINITY;
        }
    }
    float mx = fmaxf(p0[0], p1[0]);
#pragma unroll
    for (int i = 1; i < 16; ++i) mx = fmaxf(mx, fmaxf(p0[i], p1[i]));
    mx = fmaxf(mx, __shfl_xor(mx, 32));
    const float mn = fmaxf(m, mx * c);
    const float ms = (mn == -INFINITY) ? 0.f : mn;
    const float corr = __builtin_amdgcn_exp2f(m - ms);
    m = mn;
    float ls = 0.f;
#pragma unroll
    for (int i = 0; i < 16; ++i) { p0[i] = __builtin_amdgcn_exp2f(fmaf(p0[i], c, -ms)); p1[i] = __builtin_amdgcn_exp2f(fmaf(p1[i], c, -ms)); ls += p0[i] + p1[i]; }
    l = l * corr + ls;
#pragma unroll
    for (int db = 0; db < NDB; ++db) O[db] = O[db] * corr;
    bf16x8 pf[4]; pf[0] = pack8(p0, 0); pf[1] = pack8(p0, 1); pf[2] = pack8(p1, 0); pf[3] = pack8(p1, 1);
#pragma unroll
    for (int db = 0; db < NDB; ++db)
#pragma unroll
        for (int ks = 0; ks < 4; ++ks) {
            const int rowl = (ks >> 1) * 32 + (ks & 1) * 16 + 4 * h + tq, colb = vcb + (db * 32 + 16 * g1 + 4 * tp) * 2;
            const s16x4 lo = vtr(vt + Lay::addr(rowl, colb)), hi = vtr(vt + Lay::addr(rowl + 8, colb));
            const bf16x8 a = __builtin_shufflevector(lo, hi, 0, 1, 2, 3, 4, 5, 6, 7);
            O[db] = __builtin_amdgcn_mfma_f32_32x32x16_bf16(a, pf[ks], O[db], 0, 0, 0);
        }
}
template <int NKS> ATT_DI void load_q(bf16x8 (&qf)[NKS], const bf16_t* qrow  , int h) {
#pragma unroll
    for (int s = 0; s < NKS; ++s) qf[s] = *(const bf16x8*)(qrow + 16 * s + 8 * h);
}
template <int NDB> ATT_DI void store_o(const f32x16 (&O)[NDB], float l, bf16_t* orow, int h) {
    const float il = 1.0f / (l + __shfl_xor(l, 32));
#pragma unroll
    for (int db = 0; db < NDB; ++db)
#pragma unroll
        for (int g = 0; g < 4; ++g) {
            const unsigned w0 = cvtpk(O[db][4 * g] * il, O[db][4 * g + 1] * il), w1 = cvtpk(O[db][4 * g + 2] * il, O[db][4 * g + 3] * il);
            *(unsigned long long*)(orow + db * 32 + 8 * g + 4 * h) = (unsigned long long)w0 | ((unsigned long long)w1 << 32);
        }
}

ATT_DI void xattn_unit(ATT_LAS char* lds, const bf16_t* QX, const bf16_t* MKV, bf16_t* OX, int unit) {
    int tid_l = threadIdx.x; asm volatile("" : "+v"(tid_l));
    const int tid = tid_l, lane = tid & 63, w = tid >> 6, r = lane & 31, h = lane >> 5, g1 = (lane >> 4) & 1, tq = (lane & 15) >> 2, tp = lane & 3;
    const int b = unit >> 4, hd = (unit >> 2) & 3, part = unit & 3;
    __syncthreads();
    for (int cidx = tid; cidx < 256 * 16; cidx += 512) { const int row = cidx >> 4, ch = cidx & 15;
        const bf16_t* src = MKV + (size_t)(b * MEML + row) * 1024 + hd * 128 + ch * 8;
        const u32x4 kv = *(const u32x4*)src, vv = *(const u32x4*)(src + 512);
        *(ATT_LAS u32x4*)(lds + L256::addr(row, ch * 16)) = kv; *(ATT_LAS u32x4*)(lds + 65536 + L256::addr(row, ch * 16)) = vv; }
    __syncthreads();
    const float c = LOG2E * 0.08838834764831845f;
#pragma unroll 1
    for (int qb = 0; qb < 2; ++qb) {
        const size_t tok = (size_t)b * SEQ + part * 512 + qb * 256 + w * 32 + r;
        bf16x8 qf[8]; load_q<8>(qf, QX + tok * 512 + hd * 128, h);
        float m = -INFINITY, l = 0.f; f32x16 O[4];
#pragma unroll
        for (int db = 0; db < 4; ++db)
#pragma unroll
            for (int i = 0; i < 16; ++i) O[db][i] = 0.f;
#pragma unroll 1
        for (int kt = 0; kt < 4; ++kt)
            tile64<8, 4, L256, L256, false>(lds + kt * 64 * 256, lds + 65536 + kt * 64 * 256, 0, 0, qf, m, l, O, c, r, h, g1, tq, tp, 0, 0, 0);
        store_o<4>(O, l, OX + tok * 512 + hd * 128, h);
    }
}
ATT_DI void swa_unit(ATT_LAS char* lds, const bf16_t* P  , const float* sinks, bf16_t* Y, int unit) {
    int tid_l = threadIdx.x; asm volatile("" : "+v"(tid_l));
    const int tid = tid_l, lane = tid & 63, w = tid >> 6, r = lane & 31, h = lane >> 5, g1 = (lane >> 4) & 1, tq = (lane & 15) >> 2, tp = lane & 3;
    const int b = unit >> 5, kvh = (unit >> 3) & 3, qb = unit & 7, q0 = qb * 256;
    constexpr int VOFF = 384 * 144;
    __syncthreads();
    for (int cidx = tid; cidx < 384 * 8; cidx += 512) { const int row = cidx >> 3, ch = cidx & 7; const int kpos = q0 - 128 + row;
        u32x4 kv = (u32x4){0u, 0u, 0u, 0u}, vv = kv;
        if (kpos >= 0) { const bf16_t* src = P + (size_t)(b * SEQ + kpos) * 1536 + 1024 + kvh * 64 + ch * 8; kv = *(const u32x4*)src; vv = *(const u32x4*)(src + 256); }
        *(ATT_LAS u32x4*)(lds + LPAD::addr(row, ch * 16)) = kv; *(ATT_LAS u32x4*)(lds + VOFF + LPAD::addr(row, ch * 16)) = vv; }
    __syncthreads();
    const float c = LOG2E * 0.125f;
    const int qpos = q0 + w * 32 + r; const size_t tok = (size_t)b * SEQ + qpos;
    const int t0 = (32 * w + 1) >> 6;
#pragma unroll 1
    for (int g = 0; g < 4; ++g) {
        const int hq = kvh * 4 + g;
        bf16x8 qf[4]; load_q<4>(qf, P + tok * 1536 + hq * 64, h);
        float m = sinks[hq] * LOG2E, l = (h == 0) ? 1.f : 0.f; f32x16 O[2];
#pragma unroll
        for (int db = 0; db < 2; ++db)
#pragma unroll
            for (int i = 0; i < 16; ++i) O[db][i] = 0.f;
#pragma unroll 1
        for (int t = t0; t < t0 + 3; ++t)
            tile64<4, 2, LPAD, LPAD, true>(lds + t * 64 * 144, lds + VOFF + t * 64 * 144, 0, 0, qf, m, l, O, c, r, h, g1, tq, tp, qpos, q0 - 128 + t * 64, 128);
        store_o<2>(O, l, Y + tok * 1024 + hq * 64, h);
    }
}
constexpr int DKB = 64 * 144, DBUF = DKB + 16384;
ATT_DI void diff_pass(ATT_LAS char* lds, const bf16_t* P, int b, int hd, int qb, int mp, f32x16 (&O)[4], float& lsum) {
    int tid_l = threadIdx.x; asm volatile("" : "+v"(tid_l));
    const int tid = tid_l, lane = tid & 63, w = tid >> 6, r = lane & 31, h = lane >> 5, g1 = (lane >> 4) & 1, tq = (lane & 15) >> 2, tp = lane & 3;
    const int q0 = qb * 256, NT = 4 * (qb + 1);
    const int qpos = q0 + w * 32 + r; const size_t tok = (size_t)b * SEQ + qpos;
    const int qmax_w = q0 + w * 32 + 31, qmin_w = q0 + w * 32;
    const float c = LOG2E * 0.125f;
    bf16x8 qf[4]; load_q<4>(qf, P + tok * 3072 + 1536 + hd * 128 + mp * 64, h);
    float m = -INFINITY, l = 0.f;
#pragma unroll
    for (int db = 0; db < 4; ++db)
#pragma unroll
        for (int i = 0; i < 16; ++i) O[db][i] = 0.f;
    const int srow = tid >> 3, sc1 = tid & 7;
    const bf16_t* sbase = P + (size_t)(b * SEQ + srow) * 3072 + hd * 128;
    u32x4 st[3];
    st[0] = *(const u32x4*)(sbase + 2048 + mp * 64 + sc1 * 8); st[1] = *(const u32x4*)(sbase + 2560 + sc1 * 16); st[2] = *(const u32x4*)(sbase + 2560 + sc1 * 16 + 8);
    __syncthreads();
    *(ATT_LAS u32x4*)(lds + LPAD::addr(srow, sc1 * 16)) = st[0];
    *(ATT_LAS u32x4*)(lds + DKB + L256::addr(srow, sc1 * 32)) = st[1]; *(ATT_LAS u32x4*)(lds + DKB + L256::addr(srow, sc1 * 32 + 16)) = st[2];
    __syncthreads();
#pragma unroll 1
    for (int kt = 0; kt < NT; ++kt) {
        const bool more = (kt + 1 < NT);
        if (more) { const bf16_t* s2 = sbase + (size_t)(kt + 1) * 64 * 3072;
            st[0] = *(const u32x4*)(s2 + 2048 + mp * 64 + sc1 * 8); st[1] = *(const u32x4*)(s2 + 2560 + sc1 * 16); st[2] = *(const u32x4*)(s2 + 2560 + sc1 * 16 + 8); }
        const ATT_LAS char* kb = lds + (kt & 1) * DBUF; const ATT_LAS char* vb = kb + DKB;
        if (kt * 64 <= qmax_w) {
            if (kt * 64 + 63 > qmin_w) tile64<4, 4, LPAD, L256, true>(kb, vb, 0, 0, qf, m, l, O, c, r, h, g1, tq, tp, qpos, kt * 64, 1 << 30);
            else                       tile64<4, 4, LPAD, L256, false>(kb, vb, 0, 0, qf, m, l, O, c, r, h, g1, tq, tp, qpos, kt * 64, 1 << 30);
        }
        if (more) { ATT_LAS char* d = lds + ((kt + 1) & 1) * DBUF;
            *(ATT_LAS u32x4*)(d + LPAD::addr(srow, sc1 * 16)) = st[0];
            *(ATT_LAS u32x4*)(d + DKB + L256::addr(srow, sc1 * 32)) = st[1]; *(ATT_LAS u32x4*)(d + DKB + L256::addr(srow, sc1 * 32 + 16)) = st[2]; }
        __syncthreads();
    }
    lsum = l + __shfl_xor(l, 32);
}
ATT_DI void diff_unit(ATT_LAS char* lds, const bf16_t* P  , const float* subln, float lam, bf16_t* Y, float* park  , int b, int hd, int qb) {
    int tid_l = threadIdx.x; asm volatile("" : "+v"(tid_l));
    const int tid = tid_l, lane = tid & 63, w = tid >> 6, r = lane & 31, h = lane >> 5;
    const size_t tok = (size_t)b * SEQ + qb * 256 + w * 32 + r;
    f32x4* pk = (f32x4*)(park + ((tok * 4 + hd) * 2 + h) * 64);
    f32x16 O0[4], O1[4]; float l0, l1;
    diff_pass(lds, P, b, hd, qb, 0, O0, l0);
    { const float i0 = 1.0f / l0;
#pragma unroll
      for (int db = 0; db < 4; ++db)
#pragma unroll
          for (int g = 0; g < 4; ++g) pk[db * 4 + g] = (f32x4){O0[db][4 * g] * i0, O0[db][4 * g + 1] * i0, O0[db][4 * g + 2] * i0, O0[db][4 * g + 3] * i0}; }
    diff_pass(lds, P, b, hd, qb, 1, O1, l1);
#pragma unroll
    for (int db = 0; db < 4; ++db)
#pragma unroll
        for (int g = 0; g < 4; ++g) { const f32x4 v = pk[db * 4 + g]; O0[db][4 * g] = v.x; O0[db][4 * g + 1] = v.y; O0[db][4 * g + 2] = v.z; O0[db][4 * g + 3] = v.w; }
    const float i1 = lam / l1;
    float ss = 0.f;
#pragma unroll
    for (int db = 0; db < 4; ++db)
#pragma unroll
        for (int i = 0; i < 16; ++i) { const float o = O0[db][i] - O1[db][i] * i1; O0[db][i] = o; ss += o * o; }
    ss += __shfl_xor(ss, 32);
    const float rs = 0.8f / sqrtf(ss * (1.0f / 128.0f) + EPS);
    bf16_t* orow = Y + tok * 1024 + 512 + hd * 128;
#pragma unroll
    for (int db = 0; db < 4; ++db)
#pragma unroll
        for (int g = 0; g < 4; ++g) { const int d = db * 32 + 8 * g + 4 * h; const f32x4 gg = *(const f32x4*)(subln + d);
            const unsigned w0 = cvtpk(O0[db][4 * g] * rs * gg.x, O0[db][4 * g + 1] * rs * gg.y), w1 = cvtpk(O0[db][4 * g + 2] * rs * gg.z, O0[db][4 * g + 3] * rs * gg.w);
            *(unsigned long long*)(orow + d) = (unsigned long long)w0 | ((unsigned long long)w1 << 32); }
}
ATT_DI void conv_tokens(const bf16_t* P, const float* convw, bf16_t* Y, int tok0  ) {
    int tid_l = threadIdx.x; asm volatile("" : "+v"(tid_l));
    const int tid = tid_l, cg = tid & 63, run = tid >> 6, c0 = cg * 8;
    float w[3][8];
#pragma unroll
    for (int j = 0; j < 3; ++j) { const f32x4 a = *(const f32x4*)(convw + j * 512 + c0), b2 = *(const f32x4*)(convw + j * 512 + c0 + 4);
        w[j][0] = a.x; w[j][1] = a.y; w[j][2] = a.z; w[j][3] = a.w; w[j][4] = b2.x; w[j][5] = b2.y; w[j][6] = b2.z; w[j][7] = b2.w; }
    const int tfirst = tok0 + run * 16;
    float z1[8], z2[8];
#pragma unroll
    for (int i = 0; i < 8; ++i) { z1[i] = 0.f; z2[i] = 0.f; }
#pragma unroll 1
    for (int tt = -2; tt < 16; ++tt) {
        const int tok = tfirst + tt;
        float z0[8];
        const bool inseq = ((tfirst & (SEQ - 1)) + tt) >= 0;
        if (inseq) { const bf16_t* pr = P + (size_t)tok * 3072; const u32x4 gc = *(const u32x4*)(pr + 512 + c0), uu = *(const u32x4*)(pr + 1024 + c0);
            z0[0] = bflo(gc.x) * bflo(uu.x); z0[1] = bfhi(gc.x) * bfhi(uu.x); z0[2] = bflo(gc.y) * bflo(uu.y); z0[3] = bfhi(gc.y) * bfhi(uu.y);
            z0[4] = bflo(gc.z) * bflo(uu.z); z0[5] = bfhi(gc.z) * bfhi(uu.z); z0[6] = bflo(gc.w) * bflo(uu.w); z0[7] = bfhi(gc.w) * bfhi(uu.w); }
        else {
#pragma unroll
            for (int i = 0; i < 8; ++i) z0[i] = 0.f; }
        if (tt >= 0) { const u32x4 gb = *(const u32x4*)(P + (size_t)tok * 3072 + c0); float y[8];
            const float gbf[8] = {bflo(gb.x), bfhi(gb.x), bflo(gb.y), bfhi(gb.y), bflo(gb.z), bfhi(gb.z), bflo(gb.w), bfhi(gb.w)};
#pragma unroll
            for (int i = 0; i < 8; ++i) y[i] = gbf[i] * (w[0][i] * z2[i] + w[1][i] * z1[i] + w[2][i] * z0[i]);
            u32x4 o; o.x = pk2(y[0], y[1]); o.y = pk2(y[2], y[3]); o.z = pk2(y[4], y[5]); o.w = pk2(y[6], y[7]);
            *(u32x4*)(Y + (size_t)tok * 1024 + c0) = o; }
#pragma unroll
        for (int i = 0; i < 8; ++i) { z2[i] = z1[i]; z1[i] = z0[i]; }
    }
}
}

#define LAS __attribute__((address_space(3)))
constexpr int LDS_BYTES = 147456, LDSCTL_OFF = 131072;
constexpr int LC_MISC = 0, LC_HIST = 64, LC_LBASE = 128, LC_RSV = 192, LC_SLOTS = 256, LC_JOBS_BYTE = 4096;
constexpr int CW_BAR = 4096;
constexpr size_t WS_WRT = 9 * MiB;

#define XB_TMO      128
#define XB_XCNT(j)  (256  + 64 * (j))
#define XB_XSUB(j)  (1280 + 64 * (j))
#define XB_XGEN(j)  (2304 + 64 * (j))
#define XB_TOP      3328
#define XB_TOPGEN   3392
#define XCD_BAR_WORDS 3456
#define XB_SPIN_CAP (1u << 18)
__device__ __forceinline__ unsigned xb_ld(unsigned* p)              { return __hip_atomic_load(p, __ATOMIC_RELAXED, __HIP_MEMORY_SCOPE_AGENT); }
__device__ __forceinline__ unsigned xb_add(unsigned* p, unsigned v) { return __hip_atomic_fetch_add(p, v, __ATOMIC_RELAXED, __HIP_MEMORY_SCOPE_AGENT); }
__device__ __forceinline__ unsigned xb_xcc_id() { return (unsigned)__builtin_amdgcn_s_getreg((3 << 11) | 20) & 0xFu; }
#define XB_SPIN(cond, bar) do { unsigned _sp = 0; while (cond) { __builtin_amdgcn_s_sleep(1); \
    if ((++_sp & 255u) == 0u) { if (xb_ld(&(bar)[XB_TMO])) break; if (_sp > XB_SPIN_CAP) { atomicAdd(&(bar)[XB_TMO], 1u); break; } } } } while (0)
struct XcdBarrier { unsigned* bar; unsigned x; volatile LAS unsigned* st; };
__device__ __forceinline__ XcdBarrier xcd_barrier_post(unsigned* bar, volatile LAS unsigned* st) {
    XcdBarrier b; b.bar = bar; b.x = xb_xcc_id(); b.st = st;
    if (threadIdx.x == 0) (void)xb_add(&bar[XB_XCNT(b.x)], 1u);
    return b;
}
__device__ __forceinline__ void xcd_barrier_complete(unsigned* bar, unsigned x, unsigned& nloc, unsigned& nx) {
    const unsigned G = gridDim.x * gridDim.y * gridDim.z;
    unsigned sum, cnt, mine, sp = 0u;
    for (;;) {
        sum = 0u; cnt = 0u; mine = 0u;
#pragma unroll
        for (unsigned j = 0; j < 16; ++j) { const unsigned c = xb_ld(&bar[XB_XCNT(j)]); sum += c; cnt += (c > 0u) ? 1u : 0u; mine = (j == x) ? c : mine; }
        if (sum == G) break;
        __builtin_amdgcn_s_sleep(1);
        if ((++sp & 255u) == 0u) { if (xb_ld(&bar[XB_TMO])) break; if (sp > XB_SPIN_CAP) { atomicAdd(&bar[XB_TMO], 1u); break; } }
    }
    nloc = mine > 0u ? mine : 1u; nx = cnt > 0u ? cnt : 1u;
}
__device__ __forceinline__ void xcd_barrier(const XcdBarrier& b) {
    asm volatile("s_waitcnt vmcnt(0)" ::: "memory");
    __syncthreads();
    if (threadIdx.x == 0) {
        unsigned* bar = b.bar;
        __builtin_amdgcn_s_waitcnt(0);
        unsigned nloc = b.st[0], nx = b.st[1];
        if (nloc == 0u) { xcd_barrier_complete(bar, b.x, nloc, nx); b.st[0] = nloc; b.st[1] = nx; }
        const unsigned old = xb_add(&bar[XB_XSUB(b.x)], 1u);
        const unsigned gen = old / nloc;
        if (old + 1u == (gen + 1u) * nloc) {
            __builtin_amdgcn_fence(__ATOMIC_RELEASE, "agent");
            asm volatile("s_waitcnt vmcnt(0)" ::: "memory");
            const unsigned og = xb_add(&bar[XB_TOP], 1u);
            const unsigned tg = og / nx;
            if (og + 1u == (tg + 1u) * nx) xb_add(&bar[XB_TOPGEN], 1u);
            else XB_SPIN(xb_ld(&bar[XB_TOPGEN]) == tg, bar);
            __builtin_amdgcn_fence(__ATOMIC_ACQUIRE, "agent");
            xb_add(&bar[XB_XGEN(b.x)], 1u);
            asm volatile("s_waitcnt vmcnt(0)" ::: "memory");
        } else {
            XB_SPIN(xb_ld(&bar[XB_XGEN(b.x)]) == gen, bar);
            __builtin_amdgcn_fence(__ATOMIC_ACQUIRE, "agent");
            asm volatile("s_waitcnt vmcnt(0)" ::: "memory");
        }
    }
    __syncthreads();
}

struct WJob { const float* src; bf16_t* dst; const float* gain; int K, N, ipm, first, nitems, perm; };
__device__ __forceinline__ void wt_item(const float* W, int K, int N, const float* gain, bf16_t* WT, int perm, LAS float* scr, int item, int lane) {
    const int nblk = N / 32, kb = item / nblk, nb = item % nblk, k0 = 64 * kb, n0 = 32 * nb;
    const int lr = lane >> 3, lc = (lane & 7) * 4;
    f32x4 v[8];
#pragma unroll
    for (int i = 0; i < 8; ++i) v[i] = *(const f32x4*)(W + (size_t)(k0 + 8 * i + lr) * N + n0 + lc);
    const int c = lane & 7;
    f32x4 g0 = (f32x4){1.f, 1.f, 1.f, 1.f}, g1 = g0;
    if (gain) { g0 = *(const f32x4*)(gain + k0 + 8 * c); g1 = *(const f32x4*)(gain + k0 + 8 * c + 4); }
#pragma unroll
    for (int i = 0; i < 8; ++i) { LAS float* d = scr + (8 * i + lr) * 33 + lc; d[0] = v[i].x; d[1] = v[i].y; d[2] = v[i].z; d[3] = v[i].w; }
    asm volatile("s_waitcnt lgkmcnt(0)" ::: "memory");
#pragma unroll
    for (int j = 0; j < 4; ++j) { const int n = (lane >> 3) + 8 * j; const LAS float* s = scr + (8 * c) * 33 + n;
        u32x4 o; o.x = pk2(s[0 * 33] * g0.x, s[1 * 33] * g0.y); o.y = pk2(s[2 * 33] * g0.z, s[3 * 33] * g0.w); o.z = pk2(s[4 * 33] * g1.x, s[5 * 33] * g1.y); o.w = pk2(s[6 * 33] * g1.z, s[7 * 33] * g1.w);
        const int ns = n0 + n; int nd = ns;
        if (perm) { const int half = ns >> 9, jj = ns & 511; nd = (jj >> 7) * 256 + half * 128 + (jj & 127); }
        *(u32x4*)(WT + (size_t)nd * K + k0 + 8 * c) = o; }
    asm volatile("s_waitcnt lgkmcnt(0)" ::: "memory");
}
__device__ __forceinline__ void rowprep_rows(const float* x, bf16_t* xb, float* ssq, int rows, int gw, int ngw, int lane) {
    for (int row = gw; row < rows; row += ngw) {
        const f32x4* xr = (const f32x4*)(x + (size_t)row * DM) + lane; float s = 0.f;
        unsigned long long* o8 = (unsigned long long*)(xb + (size_t)row * DM) + lane;
#pragma unroll
        for (int jx = 0; jx < 4; ++jx) { const f32x4 v = xr[64 * jx]; s += (v.x * v.x + v.y * v.y) + (v.z * v.z + v.w * v.w);
            o8[64 * jx] = (unsigned long long)pk2(v.x, v.y) | ((unsigned long long)pk2(v.z, v.w) << 32); }
        s = wave_sum(s);
        if (lane < 16) ssq[(size_t)row * 16 + lane] = (lane == 0) ? s : 0.f;
    }
}
__device__ __forceinline__ void sincos_d(double a, float& c, float& s) {
    const double TWO_PI = 6.283185307179586476925286766559;
    const double n = __builtin_rint(a / TWO_PI); const double r = a - n * TWO_PI;
    const double r2 = r * r;
    double sp = 1.0, cp = 1.0;
#pragma unroll
    for (int k = 15; k >= 1; --k) { sp = 1.0 - r2 / (double)((2 * k) * (2 * k + 1)) * sp; cp = 1.0 - r2 / (double)((2 * k - 1) * (2 * k)) * cp; }
    s = (float)(r * sp); c = (float)cp;
}

typedef float f32x16r __attribute__((ext_vector_type(16)));
__device__ __forceinline__ void route_group(const float* x, const float* ssq, const float* WRt, const float* bg, const float* br, int tok0, LAS float* S  , LAS int* hist,
                                            int* route_e, float* route_w, float* rs_tok, int lane) {
    const int r = lane & 31, kk = lane >> 5;
    f32x16r a0, a1;
#pragma unroll
    for (int i = 0; i < 16; ++i) { a0[i] = 0.f; a1[i] = 0.f; }
    const f32x4* xa = (const f32x4*)(x + (size_t)(tok0 + r) * DM + 4 * kk);
    const f32x4* w0 = (const f32x4*)(WRt + (size_t)r * DM + 4 * kk);
    const f32x4* w1 = (const f32x4*)(WRt + (size_t)(32 + r) * DM + 4 * kk);
#pragma unroll 4
    for (int j = 0; j < 128; ++j) {
        const f32x4 av = xa[2 * j], b0 = w0[2 * j], b1 = w1[2 * j];
#pragma unroll
        for (int e = 0; e < 4; ++e) { a0 = __builtin_amdgcn_mfma_f32_32x32x2f32(av[e], b0[e], a0, 0, 0, 0); a1 = __builtin_amdgcn_mfma_f32_32x32x2f32(av[e], b1[e], a1, 0, 0, 0); }
    }
#pragma unroll
    for (int i = 0; i < 16; ++i) { const int trow = (i & 3) + 8 * (i >> 2) + 4 * kk; S[trow * 68 + r] = a0[i]; if (r < 4) S[trow * 68 + 32 + r] = a1[i]; }
    asm volatile("s_waitcnt lgkmcnt(0)" ::: "memory");
    if (lane < 32) {
        const int tok = tok0 + lane; const LAS float* sr = S + lane * 68;
        const float rs = row_rs(ssq, tok);
        float lg[4];
#pragma unroll
        for (int g = 0; g < 4; ++g) lg[g] = sr[g] * rs + bg[g];
        int gs = 0; float gm = lg[0];
#pragma unroll
        for (int g = 1; g < 4; ++g) if (lg[g] > gm) { gm = lg[g]; gs = g; }
        float gsum = 0.f;
#pragma unroll
        for (int g = 0; g < 4; ++g) gsum += expf(lg[g] - gm);
        const float p_g = 1.0f / gsum;
        float le[8];
#pragma unroll
        for (int e = 0; e < 8; ++e) le[e] = sr[4 + gs * 8 + e] * rs + br[gs * 8 + e];
        int i1 = 0; float m1 = le[0];
#pragma unroll
        for (int e = 1; e < 8; ++e) if (le[e] > m1) { m1 = le[e]; i1 = e; }
        int i2 = -1; float m2 = -INFINITY;
#pragma unroll
        for (int e = 0; e < 8; ++e) if (e != i1 && le[e] > m2) { m2 = le[e]; i2 = e; }
        const float e2 = expf(m2 - m1); const float w1v = p_g / (1.0f + e2), w2v = p_g * e2 / (1.0f + e2);
        const int ex1 = gs * 8 + i1, ex2 = gs * 8 + i2;
        route_e[tok * 2] = ex1; route_e[tok * 2 + 1] = ex2; route_w[tok * 2] = w1v; route_w[tok * 2 + 1] = w2v; rs_tok[tok] = rs;
        __hip_atomic_fetch_add(hist + ex1, 1, __ATOMIC_RELAXED, __HIP_MEMORY_SCOPE_WORKGROUP);
        __hip_atomic_fetch_add(hist + 32 + ex2, 1, __ATOMIC_RELAXED, __HIP_MEMORY_SCOPE_WORKGROUP);
    }
    asm volatile("s_waitcnt lgkmcnt(0)" ::: "memory");
}

#define PHASE_PTRS \
    unsigned char* ws = args.ws; int z_ = 0; int tid = threadIdx.x; asm volatile("" : "+s"(ws), "+s"(z_), "+v"(tid)); \
    const int lane = tid & 63, wave = __builtin_amdgcn_readfirstlane(tid >> 6), gw = bx * 8 + wave; (void)lane; (void)gw; \
    const float* x = args.in[0 + z_]; const float* mem = args.in[1 + z_]; const float* mem_norm = args.in[2 + z_]; const float* mem_w_kv = args.in[3 + z_]; \
    const float* norm_mix = args.in[4 + z_]; const float* norm_xattn = args.in[5 + z_]; const float* norm_ffn = args.in[6 + z_]; \
    const float* hyb_w_in = args.in[7 + z_]; const float* hyb_conv_w = args.in[8 + z_]; const float* diff_lambda = args.in[9 + z_]; const float* diff_subln = args.in[10 + z_]; \
    const float* hyb_w_out = args.in[11 + z_]; const float* swa_w_qkv = args.in[12 + z_]; const float* swa_b_qkv = args.in[13 + z_]; const float* swa_sinks = args.in[14 + z_]; \
    const float* swa_w_out = args.in[15 + z_]; const float* swa_b_out = args.in[16 + z_]; const float* xattn_w_q = args.in[17 + z_]; const float* xattn_w_o = args.in[18 + z_]; \
    const float* moe_w_group = args.in[19 + z_]; const float* moe_b_group = args.in[20 + z_]; const float* moe_w_router = args.in[21 + z_]; const float* moe_b_router = args.in[22 + z_]; \
    const float* moe_w_gate_up = args.in[23 + z_]; const float* moe_w_down = args.in[24 + z_]; const float* final_norm = args.in[25 + z_]; \
    float* ropeC = (float*)(ws + WS_ROPEC); float* ropeS = (float*)(ws + WS_ROPES); float* WRt = (float*)(ws + WS_WRT); float* lam = (float*)(ws + WS_LAM); \
    float* ssq = (float*)(ws + WS_SSQ); float* ssqm = (float*)(ws + WS_SSQM); \
    int* tok_of_slot = (int*)(ws + WS_TOKSLOT); float* w_of_slot = (float*)(ws + WS_WSLOT); float* rs_of_slot = (float*)(ws + WS_RSSLOT); \
    int* route_e = (int*)(ws + WS_ROUTE_E); float* route_w = (float*)(ws + WS_ROUTE_W); float* rs_tok = (float*)(ws + WS_RSTOK); \
    bf16_t* memb = (bf16_t*)(ws + WS_MEMB); bf16_t* mkv = (bf16_t*)(ws + WS_MKV); \
    bf16_t* Wmem = (bf16_t*)(ws + WS_WMEM); bf16_t* Win = (bf16_t*)(ws + WS_WIN); bf16_t* Wout0 = (bf16_t*)(ws + WS_WOUT0); bf16_t* Wqkv = (bf16_t*)(ws + WS_WQKV); bf16_t* Wout1 = (bf16_t*)(ws + WS_WOUT1); \
    bf16_t* Wq = (bf16_t*)(ws + WS_WQ); bf16_t* Wo = (bf16_t*)(ws + WS_WO); bf16_t* Wgu = (bf16_t*)(ws + WS_WGU); bf16_t* Wdn = (bf16_t*)(ws + WS_WDN); \
    float* XA = (float*)(ws + WS_XA); bf16_t* XBF = (bf16_t*)(ws + WS_XBF); bf16_t* Y = (bf16_t*)(ws + WS_Y); bf16_t* QX = (bf16_t*)(ws + WS_QX); bf16_t* OX = (bf16_t*)(ws + WS_OX); \
    bf16_t* P = (bf16_t*)(ws + WS_U1); bf16_t* XS = (bf16_t*)(ws + WS_U1); float* PARK = (float*)(ws + WS_U2); bf16_t* HID = (bf16_t*)(ws + WS_U2); \
    (void)0

struct MegaArgs { const float* in[26]; float* out; unsigned char* ws; double inv[8]; int ph_lo, ph_hi, probe_phase, probe_reps; };
constexpr int N_PHASES = 24;
__global__ void __launch_bounds__(512, 2) mega_fwd(MegaArgs args) {
    extern __shared__ __attribute__((aligned(16))) unsigned char lds_raw[];
    LAS unsigned char* lds = (LAS unsigned char*)lds_raw;
    LAS int* LC = (LAS int*)(lds + LDSCTL_OFF);
    const int G = (int)gridDim.x, bx = (int)blockIdx.x, ngw = G * 8;
    int* ctl = (int*)(args.ws + WS_CTL);
    for (int u = threadIdx.x; u < 1024; u += 512) LC[u] = 0;
    __syncthreads();
    const int lo = args.ph_lo, hi = args.ph_hi;
    const bool multi = (hi - lo) > 1;
    XcdBarrier bar; bar.bar = (unsigned*)(ctl + CW_BAR); bar.x = 0; bar.st = nullptr;
    if (multi) bar = xcd_barrier_post((unsigned*)(ctl + CW_BAR), (volatile LAS unsigned*)(LC + LC_MISC + 8));
#define IN(k) (lo <= (k) && (k) < hi)
#define REPS(k) (((k) == args.probe_phase) ? 1 + args.probe_reps : 1)
#define BAR(k) do { if (IN(k) && IN((k) + 1)) xcd_barrier(bar); } while (0)

    if (IN(0)) for (int rep_ = 0; rep_ < REPS(0); ++rep_) { PHASE_PTRS; const bool dry = rep_ > 0; (void)dry;
        LAS unsigned long long* jp = (LAS unsigned long long*)(lds + LDSCTL_OFF + LC_JOBS_BYTE);
        LAS int* ji = (LAS int*)(lds + LDSCTL_OFF + LC_JOBS_BYTE + 1024);
        if (tid == 0) {
            int first = 0, nj = 0;
#define ADDJOB(SRC, DST, GAIN, KK, NN, NB, PERM) do { jp[3 * nj] = (unsigned long long)(uintptr_t)(SRC); jp[3 * nj + 1] = (unsigned long long)(uintptr_t)(DST); jp[3 * nj + 2] = (unsigned long long)(uintptr_t)(GAIN); \
            const int ipm_ = ((KK) / 64) * ((NN) / 32); ji[8 * nj] = (KK); ji[8 * nj + 1] = (NN); ji[8 * nj + 2] = ipm_; ji[8 * nj + 3] = first; ji[8 * nj + 4] = ipm_ * (NB); ji[8 * nj + 5] = (PERM); first += ipm_ * (NB); ++nj; } while (0)
            ADDJOB(moe_w_gate_up, Wgu, norm_ffn, 1024, 1024, 32, 1);
            ADDJOB(moe_w_gate_up + (size_t)32 * 1024 * 1024, Wgu + (size_t)32 * 1024 * 1024, norm_ffn + 1024, 1024, 1024, 32, 1);
            ADDJOB(moe_w_down, Wdn, (const float*)nullptr, 512, 1024, 32, 0);
            ADDJOB(moe_w_down + (size_t)32 * 512 * 1024, Wdn + (size_t)32 * 512 * 1024, (const float*)nullptr, 512, 1024, 32, 0);
            ADDJOB(mem_w_kv, Wmem, mem_norm, 1024, 1024, 1, 0);
            ADDJOB(hyb_w_in, Win, norm_mix, 1024, 3072, 1, 0);
            ADDJOB(hyb_w_out, Wout0, (const float*)nullptr, 1024, 1024, 1, 0);
            ADDJOB(swa_w_qkv, Wqkv, norm_mix + 1024, 1024, 1536, 1, 0);
            ADDJOB(swa_w_out, Wout1, (const float*)nullptr, 1024, 1024, 1, 0);
            ADDJOB(xattn_w_q, Wq, norm_xattn, 1024, 512, 1, 0);
            ADDJOB(xattn_w_q + (size_t)1024 * 512, Wq + (size_t)512 * 1024, norm_xattn + 1024, 1024, 512, 1, 0);
            ADDJOB(xattn_w_o, Wo, (const float*)nullptr, 512, 1024, 1, 0);
            ADDJOB(xattn_w_o + (size_t)512 * 1024, Wo + (size_t)1024 * 512, (const float*)nullptr, 512, 1024, 1, 0);
#undef ADDJOB
        }
        __syncthreads();
        LAS float* scr = (LAS float*)(lds + wave * 16384);
#pragma unroll 1
        for (int j = 0; j < 13; ++j) {
            const float* jsrc = (const float*)(uintptr_t)jp[3 * j]; bf16_t* jdst = (bf16_t*)(uintptr_t)jp[3 * j + 1]; const float* jgain = (const float*)(uintptr_t)jp[3 * j + 2];
            const int jK = ji[8 * j], jN = ji[8 * j + 1], jipm = ji[8 * j + 2], jfirst = ji[8 * j + 3], jn = ji[8 * j + 4], jperm = ji[8 * j + 5];
            int loc = (gw - jfirst) % ngw; if (loc < 0) loc += ngw;
            for (; loc < jn; loc += ngw) { const int bidx = loc / jipm, item = loc - bidx * jipm; const size_t mo = (size_t)bidx * jK * jN;
                wt_item(jsrc + mo, jK, jN, jgain, jdst + mo, jperm, scr, item, lane); }
        }
        { const int gid = bx * 512 + tid, nth = G * 512;
          for (int i = gid; i < SEQ * 8; i += nth) { const int pos = i >> 3, jx = i & 7; float c, s; sincos_d((double)pos * args.inv[jx], c, s); ropeC[i] = c; ropeS[i] = s; }
          for (int i = gid; i < 2 * 64 * 1024; i += nth) { const int l = i >> 16, c = (i >> 10) & 63, k = i & 1023; const float g = norm_ffn[l * 1024 + k];
              WRt[i] = (c < 4) ? g * moe_w_group[(size_t)(l * 1024 + k) * 4 + c] : (c < 36) ? g * moe_w_router[(size_t)(l * 1024 + k) * 32 + (c - 4)] : 0.f; }
          if (gid == 0) { float s01 = 0.f, s23 = 0.f; for (int d = 0; d < 64; ++d) { s01 += diff_lambda[d] * diff_lambda[64 + d]; s23 += diff_lambda[128 + d] * diff_lambda[192 + d]; }
              lam[0] = expf(s01) - expf(s23) + 0.2f; } }
        rowprep_rows(x, XBF, ssq, T_TOK, gw, ngw, lane);
        rowprep_rows(mem, memb, ssqm, TMEM, gw, ngw, lane);
    }
    BAR(0);
    if (IN(1)) for (int rep_ = 0; rep_ < REPS(1); ++rep_) { PHASE_PTRS; const bool dry = rep_ > 0; (void)dry;
        { pg8::Gemm g{memb, Wmem, TMEM, 1024, 1024, 0}; pg8::StaticOrder S; S.init(TMEM, 1024, G, (bx + 64) % G);
          EpiProj E; E.O = mkv; E.ssq = ssqm; E.bias = nullptr; E.ropeC = ropeC; E.ropeS = ropeS; E.ldc = 1024; E.rope_lo = 0; E.rope_hi = 0; E.pad = 0;
          pg8::gemm_phase<EpiProj, pg8::StaticOrder, true, true>(lds, g, S, E); }
        __syncthreads();
        { pg8::Gemm g{XBF, Win, T_TOK, 3072, 1024, 0}; pg8::StaticOrder S; S.init(T_TOK, 3072, G, bx);
          EpiProj E; E.O = P; E.ssq = ssq; E.bias = nullptr; E.ropeC = ropeC; E.ropeS = ropeS; E.ldc = 3072; E.rope_lo = 1536; E.rope_hi = 2560; E.pad = 0;
          pg8::gemm_phase<EpiProj, pg8::StaticOrder, true, true>(lds, g, S, E); }
    }
    BAR(1);
    if (IN(2)) for (int rep_ = 0; rep_ < REPS(2); ++rep_) { PHASE_PTRS; const bool dry = rep_ > 0; (void)dry;
        const float lamv = lam[0];
        for (int cu = bx; cu < 256; cu += G) {
            const int bh = cu >> 2, j = cu & 3;
            att::diff_unit((ATT_LAS char*)lds, P, diff_subln, lamv, Y, PARK, bh >> 2, bh & 3, 7 - j);
            att::diff_unit((ATT_LAS char*)lds, P, diff_subln, lamv, Y, PARK, bh >> 2, bh & 3, j);
            att::conv_tokens(P, hyb_conv_w, Y, cu * 128);
        }
    }
    BAR(2);
    if (IN(3)) for (int rep_ = 0; rep_ < REPS(3); ++rep_) { PHASE_PTRS; const bool dry = rep_ > 0; (void)dry;
        pg8::Gemm g{Y, Wout0, T_TOK, 1024, 1024, 0}; pg8::StaticOrder S; S.init(T_TOK, 1024, G, bx);
        EpiResid E; E.xin = x; E.xout = XA; E.xb = XBF; E.ssq = ssq; E.bias = nullptr;
        pg8::gemm_phase<EpiResid, pg8::StaticOrder, true, true>(lds, g, S, E);
    }
    BAR(3);
#pragma unroll 1
    for (int l = 0; l < 2; ++l) {
        int* lctl = ctl + l * CI_STRIDE;
        if (l == 1) {
            if (IN(12)) for (int rep_ = 0; rep_ < REPS(12); ++rep_) { PHASE_PTRS; const bool dry = rep_ > 0; (void)dry;
                pg8::Gemm g{XBF, Wqkv, T_TOK, 1536, 1024, 0}; pg8::StaticOrder S; S.init(T_TOK, 1536, G, bx);
                EpiProj E; E.O = P; E.ssq = ssq; E.bias = swa_b_qkv; E.ropeC = ropeC; E.ropeS = ropeS; E.ldc = 1536; E.rope_lo = 0; E.rope_hi = 1280; E.pad = 0;
                pg8::gemm_phase<EpiProj, pg8::StaticOrder, true, true>(lds, g, S, E);
            }
            BAR(12);
            if (IN(13)) for (int rep_ = 0; rep_ < REPS(13); ++rep_) { PHASE_PTRS; const bool dry = rep_ > 0; (void)dry; for (int u = bx; u < 512; u += G) att::swa_unit((ATT_LAS char*)lds, P, swa_sinks, Y, u); }
            BAR(13);
            if (IN(14)) for (int rep_ = 0; rep_ < REPS(14); ++rep_) { PHASE_PTRS; const bool dry = rep_ > 0; (void)dry;
                pg8::Gemm g{Y, Wout1, T_TOK, 1024, 1024, 0}; pg8::StaticOrder S; S.init(T_TOK, 1024, G, bx);
                EpiResid E; E.xin = XA; E.xout = dry ? args.out : XA; E.xb = dry ? QX : XBF; E.ssq = dry ? (float*)(ws + WS_U1 + 160 * MiB) : ssq; E.bias = swa_b_out;
                pg8::gemm_phase<EpiResid, pg8::StaticOrder, true, true>(lds, g, S, E);
            }
            BAR(14);
        }
        const int cb = l ? 15 : 4;
        if (IN(cb)) for (int rep_ = 0; rep_ < REPS(cb); ++rep_) { PHASE_PTRS; const bool dry = rep_ > 0; (void)dry;
            pg8::Gemm g{XBF, Wq + (size_t)l * 512 * 1024, T_TOK, 512, 1024, 0}; pg8::StaticOrder S; S.init(T_TOK, 512, G, bx);
            EpiProj E; E.O = QX; E.ssq = ssq; E.bias = nullptr; E.ropeC = ropeC; E.ropeS = ropeS; E.ldc = 512; E.rope_lo = 0; E.rope_hi = 0; E.pad = 0;
            pg8::gemm_phase<EpiProj, pg8::StaticOrder, true, true>(lds, g, S, E);
        }
        BAR(cb);
        if (IN(cb + 1)) for (int rep_ = 0; rep_ < REPS(cb + 1); ++rep_) { PHASE_PTRS; const bool dry = rep_ > 0; (void)dry; for (int u = bx; u < 256; u += G) att::xattn_unit((ATT_LAS char*)lds, QX, mkv, OX, u); }
        BAR(cb + 1);
        if (IN(cb + 2)) for (int rep_ = 0; rep_ < REPS(cb + 2); ++rep_) { PHASE_PTRS; const bool dry = rep_ > 0; (void)dry;
            pg8::Gemm g{OX, Wo + (size_t)l * 1024 * 512, T_TOK, 1024, 512, 0}; pg8::StaticOrder S; S.init(T_TOK, 1024, G, bx);
            EpiResid E; E.xin = XA; E.xout = dry ? args.out : XA; E.xb = dry ? Y : XBF; E.ssq = dry ? (float*)(ws + WS_U1 + 160 * MiB) : ssq; E.bias = nullptr;
            pg8::gemm_phase<EpiResid, pg8::StaticOrder, true, true>(lds, g, S, E);
        }
        BAR(cb + 2);
        if (IN(cb + 3)) for (int rep_ = 0; rep_ < REPS(cb + 3); ++rep_) { PHASE_PTRS; const bool dry = rep_ > 0; (void)dry;
            __syncthreads();
            if (tid < 64) LC[LC_HIST + tid] = 0;
            for (int i = bx * 512 + tid; i < SPAD; i += G * 512) tok_of_slot[i] = -1;
            __syncthreads();
            for (int grp = wave * G + bx; grp < T_TOK / 32; grp += 8 * G)
                route_group(XA, ssq, WRt + (size_t)l * 64 * 1024, moe_b_group + l * 4, moe_b_router + l * 32, grp * 32, (LAS float*)(lds + wave * 16384), LC + LC_HIST, route_e, route_w, rs_tok, lane);
            __syncthreads();
            if (tid < 64) { const int c = LC[LC_HIST + tid]; if (c > 0) atomicAdd((dry ? ctl + 2 * CI_STRIDE : lctl) + CI_CNT + tid, c); }
        }
        BAR(cb + 3);
        if (IN(cb + 4)) { PHASE_PTRS;
            __syncthreads();
            if (wave == 0) {
                const int cnt = lctl[CI_CNT + lane]; const int tiles = (cnt + 255) >> 8;
                int incl = tiles;
#pragma unroll
                for (int o = 1; o < 64; o <<= 1) { const int t = __shfl_up(incl, o); if (lane >= o) incl += t; }
                const int base = incl - tiles;
                LC[LC_LBASE + lane] = base * 256;
                if (bx == 0) {
                    for (int i = 0; i < tiles; ++i) lctl[CI_TEXP + base + i] = lane & 31;
                    if (lane == 31) lctl[CI_NT] = incl;
                    if (lane == 63) lctl[CI_NT + 1] = incl;
                }
            }
            for (int chunk = bx; chunk < T_TOK / 128; chunk += G) {
                __syncthreads();
                if (tid < 64) LC[LC_HIST + tid] = 0;
                __syncthreads();
                int L = 0, rank = 0; const int tokp = chunk * 128 + (tid >> 1), kq = tid & 1;
                if (tid < 256) { L = kq * 32 + route_e[tokp * 2 + kq]; rank = __hip_atomic_fetch_add(LC + LC_HIST + L, 1, __ATOMIC_RELAXED, __HIP_MEMORY_SCOPE_WORKGROUP); }
                __syncthreads();
                if (tid < 64) { const int c = LC[LC_HIST + tid]; LC[LC_RSV + tid] = (c > 0) ? atomicAdd(lctl + CI_CUR + tid, c) : 0; }
                __syncthreads();
                if (tid < 256) { const int slot = LC[LC_LBASE + L] + LC[LC_RSV + L] + rank; LC[LC_SLOTS + tid] = slot;
                    tok_of_slot[slot] = tokp; w_of_slot[slot] = route_w[tokp * 2 + kq]; rs_of_slot[slot] = rs_tok[tokp]; }
                __syncthreads();
                for (int pr = wave * 32; pr < wave * 32 + 32; ++pr) { const int slot = LC[LC_SLOTS + pr]; const int tk = chunk * 128 + (pr >> 1);
                    const u32x4* src = (const u32x4*)(XBF + (size_t)tk * DM); u32x4* dst = (u32x4*)(XS + (size_t)slot * DM);
                    dst[lane] = src[lane]; dst[lane + 64] = src[lane + 64]; }
            }
        }
        BAR(cb + 4);
        if (IN(cb + 5)) for (int rep_ = 0; rep_ < REPS(cb + 5); ++rep_) { PHASE_PTRS; const bool dry = rep_ > 0; (void)dry;
            pg8::Gemm g{XS, Wgu + (size_t)l * 32 * 1024 * 1024, SPAD, 1024, 1024, 0};
            GroupedOrder S; S.tile_expert = lctl + CI_TEXP; S.nN = 4; S.G = G; S.c = bx; S.tiles_per_expert = 4; S.t_lo = 0; S.t_hi = lctl[CI_NT + 1];
            EpiGateUp E; E.hid = HID; E.rs_slot = rs_of_slot;
            pg8::gemm_phase<EpiGateUp, GroupedOrder, true, true>(lds, g, S, E);
        }
        BAR(cb + 5);
#pragma unroll 1
        for (int pass = 0; pass < 2; ++pass) {
            if (IN(cb + 6 + pass)) for (int rep_ = 0; rep_ < REPS(cb + 6 + pass); ++rep_) { PHASE_PTRS; const bool dry = rep_ > 0; (void)dry;
                pg8::Gemm g{HID, Wdn + (size_t)l * 32 * 1024 * 512, SPAD, 1024, 512, 0};
                const int nt0 = lctl[CI_NT], nt1 = lctl[CI_NT + 1];
                GroupedOrder S; S.tile_expert = lctl + CI_TEXP; S.nN = 4; S.G = G; S.c = bx; S.tiles_per_expert = 4; S.t_lo = pass ? nt0 : 0; S.t_hi = pass ? nt1 : nt0;
                EpiDown E; E.x = dry ? args.out : XA; E.xb = dry ? Y : XBF; E.ssq = dry ? (float*)(ws + WS_U1 + 160 * MiB) : ssq; E.tok_of_slot = tok_of_slot; E.w_of_slot = w_of_slot; E.last = pass; E.pad = 0;
                pg8::gemm_phase<EpiDown, GroupedOrder, true, true>(lds, g, S, E);
            }
            BAR(cb + 6 + pass);
        }
    }
    if (IN(23)) for (int rep_ = 0; rep_ < REPS(23); ++rep_) { PHASE_PTRS; const bool dry = rep_ > 0; (void)dry;
        for (int row = gw; row < T_TOK; row += ngw) {
            const f32x4* xr = (const f32x4*)(XA + (size_t)row * DM) + lane; f32x4 v[4]; float s = 0.f;
#pragma unroll
            for (int jx = 0; jx < 4; ++jx) { v[jx] = xr[64 * jx]; s += (v[jx].x * v[jx].x + v[jx].y * v[jx].y) + (v[jx].z * v[jx].z + v[jx].w * v[jx].w); }
            const float rs = 1.0f / sqrtf(wave_sum(s) * (1.0f / 1024.0f) + EPS);
            f32x4* orow = (f32x4*)(args.out + (size_t)row * DM) + lane; const f32x4* gr = (const f32x4*)final_norm + lane;
#pragma unroll
            for (int jx = 0; jx < 4; ++jx) orow[64 * jx] = v[jx] * rs * gr[64 * jx];
        }
    }
#undef IN
#undef BAR
}

#ifndef MK_PROBE_PHASE
#define MK_PROBE_PHASE (-1)
#define MK_PROBE_REPS 0
#endif
#ifndef MK_PER_PHASE
#define MK_PER_PHASE 0
#endif
extern "C" void kernel_launch(void* const* d_in, const int* in_sizes, int n_in, void* d_out, int out_size, void* d_ws, size_t ws_size, hipStream_t stream) {
    static int grid = 0;
    if (grid == 0) {
        if (n_in != 26 || ws_size < WS_END || out_size != T_TOK * DM) { fprintf(stderr, "kernel_launch: unexpected n_in %d / out %d / ws %zu\n", n_in, out_size, ws_size); grid = -1; return; }
        int dev = 0, cus = 0, per_cu = 0;
        if (hipGetDevice(&dev) != hipSuccess || hipDeviceGetAttribute(&cus, hipDeviceAttributeMultiprocessorCount, dev) != hipSuccess) { grid = -1; return; }
        if (hipFuncSetAttribute((const void*)mega_fwd, hipFuncAttributeMaxDynamicSharedMemorySize, LDS_BYTES) != hipSuccess) { fprintf(stderr, "kernel_launch: hipFuncSetAttribute failed\n"); grid = -1; return; }
        if (hipOccupancyMaxActiveBlocksPerMultiprocessor(&per_cu, (const void*)mega_fwd, 512, LDS_BYTES) != hipSuccess || per_cu < 1) { fprintf(stderr, "kernel_launch: occupancy query says %d\n", per_cu); per_cu = 1; }
        (void)hipGetLastError();
        grid = cus;
    }
    if (grid < 0) return;
    (void)hipMemsetAsync((char*)d_ws + WS_CTL, 0, CTL_ZERO_BYTES, stream);
    MegaArgs a{};
    for (int i = 0; i < 26; ++i) a.in[i] = (const float*)d_in[i];
    a.out = (float*)d_out; a.ws = (unsigned char*)d_ws;
    for (int jx = 0; jx < 8; ++jx) a.inv[jx] = pow(500000.0, -(double)(2 * jx) / 16.0);
#if MK_PER_PHASE
    a.probe_phase = MK_PROBE_PHASE; a.probe_reps = MK_PROBE_REPS;
    for (int ph = 0; ph < N_PHASES; ++ph) { a.ph_lo = ph; a.ph_hi = ph + 1; hipLaunchKernelGGL(mega_fwd, dim3(grid), dim3(512), LDS_BYTES, stream, a); }
#else
    a.ph_lo = 0; a.ph_hi = N_PHASES; a.probe_phase = MK_PROBE_PHASE; a.probe_reps = MK_PROBE_REPS;
    hipLaunchKernelGGL(mega_fwd, dim3(grid), dim3(512), LDS_BYTES, stream, a);
#endif
}
```

```cpp
#include <hip/hip_runtime.h>
#include <cstdio>
#include <cstdint>
#include <cmath>
namespace pg8 {
#define PG8_LAS __attribute__((address_space(3)))
typedef unsigned short bf16_t;
typedef short bf16x8 __attribute__((ext_vector_type(8)));
typedef float f32x4 __attribute__((ext_vector_type(4)));
typedef unsigned u32x4 __attribute__((ext_vector_type(4)));
constexpr int BM = 256, BK = 64, HALF = 128, HTB = HALF * BK * 2  , STAGE_BYTES = 8 * HTB, NXCD = 8, WGM = 8;

__host__ __device__ __forceinline__ int lds_byte(int r, int c) { const int st = (r >> 4) * 2 + (c >> 5), rr = r & 15, cc = c & 31, ob = rr * 64 + cc * 2; return st * 1024 + (ob ^ (((ob >> 9) & 1) << 5)); }
__host__ __device__ __forceinline__ void stage_rc(int b, int& R, int& C) { const int st = b / 1024, sb = b % 1024, swz = sb ^ (((sb >> 9) & 1) << 5); R = (st >> 1) * 16 + swz / 64; C = (st & 1) * 32 + (swz % 64) / 2; }
__host__ __device__ __forceinline__ int perm32(int rho) { const int n = rho >> 4, i = rho & 15; return 8 * (i >> 2) + 4 * n + (i & 3); }

struct Unit { int pm, pn, brow; };
struct Gemm { const bf16_t* A; const bf16_t* Bt; int M, N, K, pad; };

struct StaticOrder {
    int nM, nN, nwg, G, c;
    __host__ __device__ void init(int M, int N, int G_, int c_) { nM = M / BM; nN = N / BM; nwg = nM * nN; G = G_; c = c_; }
    __host__ __device__ bool next(int i, Unit& u) const {
        const long L = (long)i * G + c; if (L >= nwg) return false;
        int wgid = (int)L; { const int q = nwg / NXCD, r = nwg % NXCD, xcd = wgid % NXCD, off = wgid / NXCD; wgid = (xcd < r ? xcd * (q + 1) : r * (q + 1) + (xcd - r) * q) + off; }
        const int nig = WGM * nN, gid = wgid / nig, fm = gid * WGM, gsz = (nM - fm) < WGM ? (nM - fm) : WGM;
        u.pm = fm + ((wgid % nig) % gsz); u.pn = (wgid % nig) / gsz; u.brow = 0; return true;
    }
    __device__ __forceinline__ void a_ready(const Unit&) const {}
    __device__ __forceinline__ void done(const Unit&) const {}
};

__device__ __forceinline__ unsigned cvt_pk_bf16(float lo, float hi) { unsigned r; asm volatile("v_cvt_pk_bf16_f32 %0, %1, %2" : "=v"(r) : "v"(lo), "v"(hi)); return r; }
template <class Epi, class Sched, bool ALIGN_EPI = false, bool SP2 = false>
__device__ __forceinline__ void gemm_phase(PG8_LAS unsigned char* lds, const Gemm g, const Sched& S, const Epi& E) {
    int tid_l = threadIdx.x; asm volatile("" : "+v"(tid_l));
    const int tid = tid_l, wid = __builtin_amdgcn_readfirstlane(tid >> 6), lane = tid & 63, wr = wid >> 2, wc = wid & 3, fr = lane & 15, fq = lane >> 4;
    const int K = g.K, nt = K / BK;
    unsigned voffA[2], voffB[2];
#pragma unroll
    for (int i = 0; i < 2; ++i) { int R, C; stage_rc(tid * 16 + i * 8192, R, C); const int Rb = Epi::PERM ? ((R & ~31) + perm32(R & 31)) : R;
        voffA[i] = (unsigned)(R * K + C) * 2u; voffB[i] = (unsigned)(Rb * K + C) * 2u; }
    const size_t kstep = (size_t)(BK * 2);
    const size_t hstep = (size_t)HALF * K * 2;
    const size_t tstep = 2 * hstep;
    const unsigned ldsw = (unsigned)wid * 1024u;
    const int aoff = lds_byte(wr * 64 + fr, fq * 8), boff = lds_byte(wc * 32 + fr, fq * 8);
#define PG8_SA(b, h) (((b) * 2 + (h)) * HTB)
#define PG8_SB(b, h) ((4 + (b) * 2 + (h)) * HTB)
#define PG8_STAGE(bufoff, gbase, voff) do { _Pragma("unroll") for (int _i = 0; _i < 2; ++_i) \
        __builtin_amdgcn_global_load_lds((const unsigned*)((const char*)(gbase) + (voff)[_i]), (PG8_LAS unsigned*)(lds + (bufoff) + ldsw + _i * 8192), 16, 0, 0); } while (0)
#define PG8_LDA(dst, b, h) do { _Pragma("unroll") for (int m = 0; m < 4; ++m) _Pragma("unroll") for (int k = 0; k < 2; ++k) dst[m][k] = *(const PG8_LAS bf16x8*)(lds + PG8_SA(b, h) + aoff + m * 2048 + k * 1024); } while (0)
#define PG8_LDB(dst, b, h) do { _Pragma("unroll") for (int n = 0; n < 2; ++n) _Pragma("unroll") for (int k = 0; k < 2; ++k) dst[n][k] = *(const PG8_LAS bf16x8*)(lds + PG8_SB(b, h) + boff + n * 2048 + k * 1024); } while (0)
#define PG8_MMA(ai, bj, At, Bt) do { __builtin_amdgcn_s_setprio(1); _Pragma("unroll") for (int m = 0; m < 4; ++m) _Pragma("unroll") for (int n = 0; n < 2; ++n) _Pragma("unroll") for (int k = 0; k < 2; ++k) \
        acc[ai][bj][m][n] = __builtin_amdgcn_mfma_f32_16x16x32_bf16(Bt[n][k], At[m][k], acc[ai][bj][m][n], 0, 0, 0); __builtin_amdgcn_s_setprio(0); } while (0)
#define PG8_WAIT_V(n) asm volatile("s_waitcnt vmcnt(" #n ")" ::: "memory")
#define PG8_WAIT_L(n) asm volatile("s_waitcnt lgkmcnt(" #n ")" ::: "memory")
#define PG8_BAR __builtin_amdgcn_s_barrier()
#define PG8_SCHED __builtin_amdgcn_sched_barrier(0)
    Unit cur, nxt; int ui = 0;
    if (!S.next(0, cur)) return;
    f32x4 acc[2][2][4][2];
#pragma unroll
    for (int a = 0; a < 2; ++a)
#pragma unroll
        for (int b = 0; b < 2; ++b)
#pragma unroll
            for (int m = 0; m < 4; ++m)
#pragma unroll
                for (int n = 0; n < 2; ++n) acc[a][b][m][n] = (f32x4){0.f, 0.f, 0.f, 0.f};
    bf16x8 At[4][2], B0[2][2], B1[2][2];
    const char* cA = (const char*)g.A + (size_t)cur.pm * tstep; const char* cB = (const char*)g.Bt + (size_t)(cur.brow + cur.pn) * tstep;
    S.a_ready(cur);
    if constexpr (SP2) {
        PG8_STAGE(PG8_SB(0, 0), cB, voffB); PG8_STAGE(PG8_SB(0, 1), cB + hstep, voffB); PG8_STAGE(PG8_SA(0, 0), cA, voffA); PG8_STAGE(PG8_SA(0, 1), cA + hstep, voffA);
        if (wr == 1) PG8_BAR;
        PG8_WAIT_V(2); PG8_BAR;
        PG8_STAGE(PG8_SB(1, 0), cB + kstep, voffB); PG8_STAGE(PG8_SA(1, 0), cA + kstep, voffA); PG8_STAGE(PG8_SB(1, 1), cB + hstep + kstep, voffB);
        PG8_WAIT_V(6); PG8_BAR;
    } else {
        PG8_STAGE(PG8_SB(0, 0), cB, voffB); PG8_STAGE(PG8_SA(0, 0), cA, voffA); PG8_STAGE(PG8_SB(0, 1), cB + hstep, voffB); PG8_STAGE(PG8_SA(0, 1), cA + hstep, voffA);
        if (wr == 1) PG8_BAR;
        PG8_WAIT_V(4); PG8_BAR;
        PG8_STAGE(PG8_SB(1, 0), cB + kstep, voffB); PG8_STAGE(PG8_SA(1, 0), cA + kstep, voffA); PG8_STAGE(PG8_SB(1, 1), cB + hstep + kstep, voffB);
        PG8_WAIT_V(6); PG8_BAR;
    }
    for (;;) {
        const bool has_next = S.next(ui + 1, nxt);
        const char* nA = has_next ? (const char*)g.A + (size_t)nxt.pm * tstep : cA; const char* nB = has_next ? (const char*)g.Bt + (size_t)(nxt.brow + nxt.pn) * tstep : cB;
        for (int t = 0; t < nt; t += 2) {
            const bool last = (t == nt - 2);
            const char* a1 = cA + (size_t)(t + 1) * kstep;
            const char* a2 = last ? nA : cA + (size_t)(t + 2) * kstep; const char* b2 = last ? nB : cB + (size_t)(t + 2) * kstep;
            const char* a3 = a2 + kstep; const char* b3 = b2 + kstep;
            if (last && has_next) S.a_ready(nxt);
            if constexpr (SP2) {
            PG8_LDB(B0, 0, 0); PG8_LDB(B1, 0, 1); PG8_SCHED; PG8_LDA(At, 0, 0); PG8_STAGE(PG8_SA(1, 1), a1 + hstep, voffA);
            PG8_WAIT_V(8); PG8_WAIT_L(0); PG8_BAR; PG8_MMA(0, 0, At, B0); PG8_MMA(0, 1, At, B1); PG8_BAR; PG8_SCHED;
            PG8_LDA(At, 0, 1); PG8_STAGE(PG8_SB(0, 0), b2, voffB); PG8_STAGE(PG8_SB(0, 1), b2 + hstep, voffB); PG8_STAGE(PG8_SA(0, 0), a2, voffA);
            PG8_WAIT_V(8); PG8_WAIT_L(0); PG8_BAR; PG8_MMA(1, 0, At, B0); PG8_MMA(1, 1, At, B1); PG8_BAR; PG8_SCHED;
            PG8_LDB(B0, 1, 0); PG8_LDB(B1, 1, 1); PG8_SCHED; PG8_LDA(At, 1, 0); PG8_STAGE(PG8_SA(0, 1), a2 + hstep, voffA);
            PG8_WAIT_V(8); PG8_WAIT_L(0); PG8_BAR; PG8_MMA(0, 0, At, B0); PG8_MMA(0, 1, At, B1); PG8_BAR; PG8_SCHED;
            PG8_LDA(At, 1, 1); PG8_STAGE(PG8_SB(1, 0), b3, voffB); PG8_STAGE(PG8_SB(1, 1), b3 + hstep, voffB); PG8_STAGE(PG8_SA(1, 0), a3, voffA);
            PG8_WAIT_V(8); PG8_WAIT_L(0); PG8_BAR; PG8_MMA(1, 0, At, B0); PG8_MMA(1, 1, At, B1); PG8_BAR; PG8_SCHED;
            } else {
            PG8_LDB(B0, 0, 0); PG8_SCHED; PG8_LDA(At, 0, 0); PG8_STAGE(PG8_SA(1, 1), a1 + hstep, voffA);
            PG8_WAIT_L(8); PG8_BAR; PG8_WAIT_L(0); PG8_MMA(0, 0, At, B0); PG8_BAR; PG8_SCHED;
            PG8_LDB(B1, 0, 1); PG8_STAGE(PG8_SB(0, 0), b2, voffB);
            PG8_BAR; PG8_WAIT_L(0); PG8_MMA(0, 1, At, B1); PG8_BAR;
            PG8_LDA(At, 0, 1); PG8_STAGE(PG8_SA(0, 0), a2, voffA);
            PG8_BAR; PG8_WAIT_L(0); PG8_MMA(1, 0, At, B0); PG8_BAR; PG8_SCHED;
            PG8_STAGE(PG8_SB(0, 1), b2 + hstep, voffB);
            PG8_WAIT_V(6); PG8_BAR; PG8_MMA(1, 1, At, B1); PG8_BAR;
            PG8_LDB(B0, 1, 0); PG8_SCHED; PG8_LDA(At, 1, 0); PG8_STAGE(PG8_SA(0, 1), a2 + hstep, voffA);
            PG8_WAIT_L(8); PG8_BAR; PG8_WAIT_L(0); PG8_MMA(0, 0, At, B0); PG8_BAR; PG8_SCHED;
            PG8_LDB(B1, 1, 1); PG8_STAGE(PG8_SB(1, 0), b3, voffB);
            PG8_BAR; PG8_WAIT_L(0); PG8_MMA(0, 1, At, B1); PG8_BAR;
            PG8_LDA(At, 1, 1); PG8_STAGE(PG8_SA(1, 0), a3, voffA);
            PG8_BAR; PG8_WAIT_L(0); PG8_MMA(1, 0, At, B0); PG8_BAR; PG8_SCHED;
            PG8_STAGE(PG8_SB(1, 1), b3 + hstep, voffB);
            PG8_WAIT_V(6); PG8_BAR; PG8_MMA(1, 1, At, B1); PG8_BAR;
            }
        }
        if constexpr (ALIGN_EPI) { if (wr == 0) PG8_BAR; }
        if constexpr (!Epi::AFTER_DRAIN) { E(acc, cur, wr, wc, fr, fq); S.done(cur); }
        if (!has_next) break;
#pragma unroll
        for (int a = 0; a < 2; ++a)
#pragma unroll
            for (int b = 0; b < 2; ++b)
#pragma unroll
                for (int m = 0; m < 4; ++m)
#pragma unroll
                    for (int n = 0; n < 2; ++n) acc[a][b][m][n] = (f32x4){0.f, 0.f, 0.f, 0.f};
        cur = nxt; cA = nA; cB = nB; ++ui;
        if constexpr (ALIGN_EPI) { if (wr == 1) PG8_BAR; }
    }
    PG8_WAIT_V(0);
    if constexpr (!ALIGN_EPI) { if (wr == 0) PG8_BAR; }
    PG8_BAR;
    if constexpr (Epi::AFTER_DRAIN) { E.fused(acc, cur, wr, wc, fr, fq, lds, wid, lane); S.done(cur); }
#undef PG8_SA
#undef PG8_SB
#undef PG8_STAGE
#undef PG8_LDA
#undef PG8_LDB
#undef PG8_MMA
#undef PG8_WAIT_V
#undef PG8_WAIT_L
#undef PG8_BAR
#undef PG8_SCHED
}
}

using pg8::bf16_t; using pg8::f32x4; using pg8::u32x4; using pg8::Unit;
constexpr int T_TOK = 32768, DM = 1024, SEQ = 2048, NBATCH = 16, MEML = 256, TMEM = 4096, SPAD = 81920;
constexpr float EPS = 1e-6f;
constexpr float LOG2E = 1.4426950408889634f;
constexpr size_t MiB = 1u << 20;
constexpr size_t WS_CTL = 0, CTL_ZERO_BYTES = 64 * 1024;
constexpr size_t WS_ROPEC = 1 * MiB, WS_ROPES = 1 * MiB + 64 * 1024, WS_WR = 1 * MiB + 128 * 1024  , WS_LAM = 1 * MiB + 512 * 1024;
constexpr size_t WS_SSQ = 2 * MiB, WS_SSQM = 4 * MiB;
constexpr size_t WS_TOKSLOT = 5 * MiB, WS_WSLOT = 5 * MiB + 512 * 1024, WS_RSSLOT = 6 * MiB;
constexpr size_t WS_ROUTE_E = 7 * MiB, WS_ROUTE_W = 7 * MiB + 512 * 1024, WS_RSTOK = 8 * MiB;
constexpr size_t WS_MEMB = 10 * MiB, WS_MKV = 18 * MiB;
constexpr size_t WS_WMEM = 26 * MiB, WS_WIN = 28 * MiB, WS_WOUT0 = 34 * MiB, WS_WQKV = 36 * MiB, WS_WOUT1 = 39 * MiB, WS_WQ = 41 * MiB, WS_WO = 43 * MiB,
                 WS_WGU = 45 * MiB, WS_WDN = 173 * MiB;
constexpr size_t WS_XA = 240 * MiB, WS_XBF = 368 * MiB, WS_Y = 432 * MiB, WS_QX = 496 * MiB, WS_OX = 528 * MiB, WS_U1 = 560 * MiB, WS_U2 = 752 * MiB, WS_END = 880 * MiB;
constexpr int CI_CNT = 0, CI_CUR = 64, CI_LBASE = 128, CI_NT = 192, CI_TEXP = 256, CI_STRIDE = 1024;

__device__ __forceinline__ unsigned f2bf(float f) { unsigned u = __builtin_bit_cast(unsigned, f); return (u + 0x7fffu + ((u >> 16) & 1u)) >> 16; }
typedef float f32x2_hw __attribute__((ext_vector_type(2))); typedef __bf16 bf16x2_hw __attribute__((ext_vector_type(2)));
__device__ __forceinline__ unsigned pk2(float lo, float hi) { f32x2_hw v = {lo, hi}; bf16x2_hw b = __builtin_convertvector(v, bf16x2_hw); return __builtin_bit_cast(unsigned, b); }
__device__ __forceinline__ float bflo(unsigned w) { return __builtin_bit_cast(float, w << 16); }
__device__ __forceinline__ float bfhi(unsigned w) { return __builtin_bit_cast(float, w & 0xffff0000u); }
__device__ __forceinline__ float bf2f(bf16_t h) { return __builtin_bit_cast(float, (unsigned)h << 16); }
__device__ __forceinline__ float wave_sum(float v) {
#pragma unroll
    for (int o = 1; o < 64; o <<= 1) v += __shfl_xor(v, o);
    return v;
}
__device__ __forceinline__ float row_rs(const float* ssq, int row) {
    const f32x4* p = (const f32x4*)(ssq + (size_t)row * 16);
    const f32x4 a = p[0], b = p[1], c = p[2], d = p[3];
    const float s = (((a.x + a.y) + (a.z + a.w)) + ((b.x + b.y) + (b.z + b.w))) + (((c.x + c.y) + (c.z + c.w)) + ((d.x + d.y) + (d.z + d.w)));
    return 1.0f / sqrtf(s * (1.0f / 1024.0f) + EPS);
}

struct EpiProj {
    static constexpr bool PERM = true, AFTER_DRAIN = false;
    bf16_t* O; const float* ssq; const float* bias; const float* ropeC; const float* ropeS; int ldc, rope_lo, rope_hi, pad;
    __device__ __forceinline__ void operator()(f32x4 (&acc)[2][2][4][2], const Unit& u, int wr, int wc, int fr, int fq) const {
        const int colw = u.pn * 256 + wc * 32 + 8 * fq;
        const bool rope_tile = (u.pn * 256 < rope_hi) && (u.pn * 256 + 256 > rope_lo);
#pragma unroll
        for (int ai = 0; ai < 2; ++ai) {
            const int row0 = u.pm * 256 + ai * 128 + wr * 64 + fr;
            float rsv[4];
#pragma unroll
            for (int m = 0; m < 4; ++m) rsv[m] = row_rs(ssq, row0 + m * 16);
#pragma unroll
            for (int bj = 0; bj < 2; ++bj) {
                f32x4 b0 = (f32x4){0.f, 0.f, 0.f, 0.f}, b1 = b0;
                if (bias) { b0 = *(const f32x4*)(bias + colw + bj * 128); b1 = *(const f32x4*)(bias + colw + bj * 128 + 4); }
#pragma unroll
                for (int m = 0; m < 4; ++m) { acc[ai][bj][m][0] = acc[ai][bj][m][0] * rsv[m] + b0; acc[ai][bj][m][1] = acc[ai][bj][m][1] * rsv[m] + b1; }
            }
            if (rope_tile) {
#pragma unroll
                for (int m = 0; m < 4; ++m) {
                    const int pos = (row0 + m * 16) & (SEQ - 1);
                    const f32x4 c0 = *(const f32x4*)(ropeC + pos * 8), c1 = *(const f32x4*)(ropeC + pos * 8 + 4);
                    const f32x4 s0 = *(const f32x4*)(ropeS + pos * 8), s1 = *(const f32x4*)(ropeS + pos * 8 + 4);
#pragma unroll
                    for (int bj = 0; bj < 2; ++bj) {
                        const int col = colw + bj * 128;
                        f32x4 p0, p1;
#pragma unroll
                        for (int i = 0; i < 4; ++i) { p0[i] = __shfl_xor(acc[ai][bj][m][0][i], 16); p1[i] = __shfl_xor(acc[ai][bj][m][1][i], 16); }
                        if (col >= rope_lo && col < rope_hi && (col & 63) < 16) {
                            const float sg = (col & 8) ? 1.0f : -1.0f;
                            acc[ai][bj][m][0] = acc[ai][bj][m][0] * c0 + p0 * s0 * sg; acc[ai][bj][m][1] = acc[ai][bj][m][1] * c1 + p1 * s1 * sg;
                        }
                    }
                }
            }
#pragma unroll
            for (int m = 0; m < 4; ++m)
#pragma unroll
                for (int bj = 0; bj < 2; ++bj) { const f32x4 v0 = acc[ai][bj][m][0], v1 = acc[ai][bj][m][1];
                    u32x4 w; w.x = pk2(v0[0], v0[1]); w.y = pk2(v0[2], v0[3]); w.z = pk2(v1[0], v1[1]); w.w = pk2(v1[2], v1[3]);
                    *(u32x4*)(O + (size_t)(row0 + m * 16) * ldc + colw + bj * 128) = w; }
        }
    }
};
struct EpiResid {
    static constexpr bool PERM = true, AFTER_DRAIN = false;
    const bf16_t* xin; bf16_t* xout; float* ssq; const float* bias;
    __device__ __forceinline__ void operator()(f32x4 (&acc)[2][2][4][2], const Unit& u, int wr, int wc, int fr, int fq) const {
        const int colw = u.pn * 256 + wc * 32 + 8 * fq;
#pragma unroll
        for (int ai = 0; ai < 2; ++ai) {
            const int row0 = u.pm * 256 + ai * 128 + wr * 64 + fr;
            float ssv[4]; u32x4 wv[4][2];
#pragma unroll
            for (int m = 0; m < 4; ++m)
#pragma unroll
                for (int bj = 0; bj < 2; ++bj) wv[m][bj] = *(const u32x4*)(xin + (size_t)(row0 + m * 16) * DM + colw + bj * 128);
#pragma unroll
            for (int m = 0; m < 4; ++m) {
                float ss = 0.f;
#pragma unroll
                for (int bj = 0; bj < 2; ++bj) {
                    const u32x4 xi = wv[m][bj];
                    f32x4 x0 = (f32x4){bflo(xi.x), bfhi(xi.x), bflo(xi.y), bfhi(xi.y)} + acc[ai][bj][m][0], x1 = (f32x4){bflo(xi.z), bfhi(xi.z), bflo(xi.w), bfhi(xi.w)} + acc[ai][bj][m][1];
                    if (bias) { x0 += *(const f32x4*)(bias + colw + bj * 128); x1 += *(const f32x4*)(bias + colw + bj * 128 + 4); }
                    u32x4 w; w.x = pk2(x0[0], x0[1]); w.y = pk2(x0[2], x0[3]); w.z = pk2(x1[0], x1[1]); w.w = pk2(x1[2], x1[3]);
                    wv[m][bj] = w;
                    const float r0 = bflo(w.x), r1 = bfhi(w.x), r2 = bflo(w.y), r3 = bfhi(w.y), r4 = bflo(w.z), r5 = bfhi(w.z), r6 = bflo(w.w), r7 = bfhi(w.w);
                    ss += (r0 * r0 + r1 * r1) + (r2 * r2 + r3 * r3) + (r4 * r4 + r5 * r5) + (r6 * r6 + r7 * r7);
                }
                ss += __shfl_xor(ss, 16); ss += __shfl_xor(ss, 32); ssv[m] = ss;
            }
#pragma unroll
            for (int m = 0; m < 4; ++m) {
                const int row = row0 + m * 16;
#pragma unroll
                for (int bj = 0; bj < 2; ++bj) *(u32x4*)(xout + (size_t)row * DM + colw + bj * 128) = wv[m][bj];
                if (fq == 0) ssq[(size_t)row * 16 + u.pn * 4 + wc] = ssv[m];
            }
        }
    }
};
struct EpiGateUp {
    static constexpr bool PERM = true, AFTER_DRAIN = false;
    bf16_t* hid; const float* rs_slot;
    __device__ __forceinline__ void operator()(f32x4 (&acc)[2][2][4][2], const Unit& u, int wr, int wc, int fr, int fq) const {
        const int row0 = u.pm * 256 + wr * 64 + fr;
        float rsv[2][4];
#pragma unroll
        for (int ai = 0; ai < 2; ++ai)
#pragma unroll
            for (int m = 0; m < 4; ++m) rsv[ai][m] = rs_slot[row0 + ai * 128 + m * 16];
#pragma unroll
        for (int ai = 0; ai < 2; ++ai)
#pragma unroll
            for (int m = 0; m < 4; ++m) {
                const int row = row0 + ai * 128 + m * 16;
                const float rs = rsv[ai][m];
                float h[8];
#pragma unroll
                for (int i = 0; i < 8; ++i) { const float g = acc[ai][0][m][i >> 2][i & 3] * rs, up = acc[ai][1][m][i >> 2][i & 3] * rs; h[i] = g / (1.0f + __expf(-g)) * up; }
                u32x4 w; w.x = pk2(h[0], h[1]); w.y = pk2(h[2], h[3]); w.z = pk2(h[4], h[5]); w.w = pk2(h[6], h[7]);
                *(u32x4*)(hid + (size_t)row * 512 + u.pn * 128 + wc * 32 + 8 * fq) = w;
            }
    }
};
struct EpiDown {
    static constexpr bool PERM = true, AFTER_DRAIN = false;
    const bf16_t* xin; bf16_t* xout; float* ssq; const int* tok_of_slot; const float* w_of_slot; int last, pad;
    __device__ __forceinline__ void operator()(f32x4 (&acc)[2][2][4][2], const Unit& u, int wr, int wc, int fr, int fq) const {
        const int colw = u.pn * 256 + wc * 32 + 8 * fq;
        int tokv[2][4]; float wtv[2][4];
#pragma unroll
        for (int ai = 0; ai < 2; ++ai)
#pragma unroll
            for (int m = 0; m < 4; ++m) { const int slot = u.pm * 256 + ai * 128 + wr * 64 + fr + m * 16; tokv[ai][m] = tok_of_slot[slot]; wtv[ai][m] = w_of_slot[slot]; }
#pragma unroll
        for (int ai = 0; ai < 2; ++ai) {
            float ssv[4]; u32x4 wv[4][2];
#pragma unroll
            for (int m = 0; m < 4; ++m)
#pragma unroll
                for (int bj = 0; bj < 2; ++bj) wv[m][bj] = *(const u32x4*)(xin + (size_t)(tokv[ai][m] < 0 ? 0 : tokv[ai][m]) * DM + colw + bj * 128);
#pragma unroll
            for (int m = 0; m < 4; ++m) {
                const float wt = wtv[ai][m];
                float ss = 0.f;
#pragma unroll
                for (int bj = 0; bj < 2; ++bj) {
                    const u32x4 xi = wv[m][bj];
                    const f32x4 x0 = (f32x4){bflo(xi.x), bfhi(xi.x), bflo(xi.y), bfhi(xi.y)} + acc[ai][bj][m][0] * wt, x1 = (f32x4){bflo(xi.z), bfhi(xi.z), bflo(xi.w), bfhi(xi.w)} + acc[ai][bj][m][1] * wt;
                    u32x4 w; w.x = pk2(x0[0], x0[1]); w.y = pk2(x0[2], x0[3]); w.z = pk2(x1[0], x1[1]); w.w = pk2(x1[2], x1[3]);
                    wv[m][bj] = w;
                    const float r0 = bflo(w.x), r1 = bfhi(w.x), r2 = bflo(w.y), r3 = bfhi(w.y), r4 = bflo(w.z), r5 = bfhi(w.z), r6 = bflo(w.w), r7 = bfhi(w.w);
                    ss += (r0 * r0 + r1 * r1) + (r2 * r2 + r3 * r3) + (r4 * r4 + r5 * r5) + (r6 * r6 + r7 * r7);
                }
                ss += __shfl_xor(ss, 16); ss += __shfl_xor(ss, 32); ssv[m] = ss;
            }
#pragma unroll
            for (int m = 0; m < 4; ++m) {
                const int tok = tokv[ai][m];
                if (tok >= 0) {
#pragma unroll
                    for (int bj = 0; bj < 2; ++bj) *(u32x4*)(xout + (size_t)tok * DM + colw + bj * 128) = wv[m][bj];
                    if (last && fq == 0) ssq[(size_t)tok * 16 + u.pn * 4 + wc] = ssv[m];
                }
            }
        }
    }
};

struct GroupedOrder {
    const int* tile_expert; int t_lo, t_hi, nN, G, c, tiles_per_expert;
    __device__ __forceinline__ bool next(int i, Unit& u) const {
        const long L = (long)i * G + c; const long n = (long)(t_hi - t_lo) * nN; if (L >= n) return false;
        u.pm = t_lo + (int)(L / nN); u.pn = (int)(L % nN); u.brow = tile_expert[u.pm] * tiles_per_expert; return true;
    }
    __device__ __forceinline__ void a_ready(const Unit&) const {}
    __device__ __forceinline__ void done(const Unit&) const {}
};

namespace att {
#define ATT_LAS __attribute__((address_space(3)))
#define ATT_DI __device__ __forceinline__
typedef short bf16x8 __attribute__((ext_vector_type(8)));
typedef short s16x4 __attribute__((ext_vector_type(4)));
typedef float f32x16 __attribute__((ext_vector_type(16)));
typedef short v4i16_t __attribute__((ext_vector_type(4)));
typedef float f32x2_t __attribute__((ext_vector_type(2)));
typedef __bf16 bf16x2_t __attribute__((ext_vector_type(2)));
ATT_DI int crow(int reg, int h) { return (reg & 3) + 8 * (reg >> 2) + 4 * h; }
ATT_DI unsigned cvtpk(float lo, float hi) { f32x2_t v = {lo, hi}; bf16x2_t b = __builtin_convertvector(v, bf16x2_t); return __builtin_bit_cast(unsigned, b); }
ATT_DI s16x4 vtr(const ATT_LAS char* p) { return __builtin_bit_cast(s16x4, __builtin_amdgcn_ds_read_tr16_b64_v4i16((ATT_LAS v4i16_t*)p)); }
ATT_DI bf16x8 pack8(const f32x16& x, int s) {
    u32x4 p; p.x = cvtpk(x[8 * s + 0], x[8 * s + 1]); p.y = cvtpk(x[8 * s + 2], x[8 * s + 3]); p.z = cvtpk(x[8 * s + 4], x[8 * s + 5]); p.w = cvtpk(x[8 * s + 6], x[8 * s + 7]);
    return __builtin_bit_cast(bf16x8, p);
}
struct L256 { static constexpr int PITCH = 256; static ATT_DI int addr(int row, int byte) { return row * 256 + ((((byte >> 4) ^ (row & 15)) << 4) | (byte & 15)); } };
struct LPAD { static constexpr int PITCH = 144; static ATT_DI int addr(int row, int byte) { return row * 144 + byte; } };

template <int NKS, int NDB, class KLay, class Lay, bool MASK>
ATT_DI void tile64(const ATT_LAS char* kt, const ATT_LAS char* vt, int kcb, int vcb, const bf16x8 (&qf)[NKS], float& m, float& l, f32x16 (&O)[NDB], float c,
                   int r, int h, int g1, int tq, int tp, int qpos, int kpos0, int win) {
    f32x16 p0, p1;
#pragma unroll
    for (int i = 0; i < 16; ++i) { p0[i] = 0.f; p1[i] = 0.f; }
#pragma unroll
    for (int s = 0; s < NKS; ++s) {
        const bf16x8 a0 = *(const ATT_LAS bf16x8*)(kt + KLay::addr(r, kcb + 32 * s + 16 * h));
        const bf16x8 a1 = *(const ATT_LAS bf16x8*)(kt + KLay::addr(32 + r, kcb + 32 * s + 16 * h));
        p0 = __builtin_amdgcn_mfma_f32_32x32x16_bf16(a0, qf[s], p0, 0, 0, 0);
        p1 = __builtin_amdgcn_mfma_f32_32x32x16_bf16(a1, qf[s], p1, 0, 0, 0);
    }
    if (MASK) {
#pragma unroll
        for (int i = 0; i < 16; ++i) {
            const int k0 = kpos0 + crow(i, h), k1 = k0 + 32;
            if (k0 > qpos || k0 <= qpos - win || k0 < 0) p0[i] = -INFINITY;
            if (k1 > qpos || k1 <= qpos - win || k1 < 0) p1[i] = -INFINITY;
        }
    }
    float mx = fmaxf(p0[0], p1[0]);
#pragma unroll
    for (int i = 1; i < 16; ++i) mx = fmaxf(mx, fmaxf(p0[i], p1[i]));
    mx = fmaxf(mx, __shfl_xor(mx, 32));
    const float mn = fmaxf(m, mx * c);
    const float ms = (mn == -INFINITY) ? 0.f : mn;
    const float corr = __builtin_amdgcn_exp2f(m - ms);
    m = mn;
    float ls = 0.f;
#pragma unroll
    for (int i = 0; i < 16; ++i) { p0[i] = __builtin_amdgcn_exp2f(fmaf(p0[i], c, -ms)); p1[i] = __builtin_amdgcn_exp2f(fmaf(p1[i], c, -ms)); ls += p0[i] + p1[i]; }
    l = l * corr + ls;
#pragma unroll
    for (int db = 0; db < NDB; ++db) O[db] = O[db] * corr;
    bf16x8 pf[4]; pf[0] = pack8(p0, 0); pf[1] = pack8(p0, 1); pf[2] = pack8(p1, 0); pf[3] = pack8(p1, 1);
#pragma unroll
    for (int db = 0; db < NDB; ++db)
#pragma unroll
        for (int ks = 0; ks < 4; ++ks) {
            const int rowl = (ks >> 1) * 32 + (ks & 1) * 16 + 4 * h + tq, colb = vcb + (db * 32 + 16 * g1 + 4 * tp) * 2;
            const s16x4 lo = vtr(vt + Lay::addr(rowl, colb)), hi = vtr(vt + Lay::addr(rowl + 8, colb));
            const bf16x8 a = __builtin_shufflevector(lo, hi, 0, 1, 2, 3, 4, 5, 6, 7);
            O[db] = __builtin_amdgcn_mfma_f32_32x32x16_bf16(a, pf[ks], O[db], 0, 0, 0);
        }
}
template <int NKS> ATT_DI void load_q(bf16x8 (&qf)[NKS], const bf16_t* qrow  , int h) {
#pragma unroll
    for (int s = 0; s < NKS; ++s) qf[s] = *(const bf16x8*)(qrow + 16 * s + 8 * h);
}
template <int NDB> ATT_DI void store_o(const f32x16 (&O)[NDB], float l, bf16_t* orow, int h) {
    const float il = 1.0f / (l + __shfl_xor(l, 32));
#pragma unroll
    for (int db = 0; db < NDB; ++db)
#pragma unroll
        for (int g = 0; g < 4; ++g) {
            const unsigned w0 = cvtpk(O[db][4 * g] * il, O[db][4 * g + 1] * il), w1 = cvtpk(O[db][4 * g + 2] * il, O[db][4 * g + 3] * il);
            *(unsigned long long*)(orow + db * 32 + 8 * g + 4 * h) = (unsigned long long)w0 | ((unsigned long long)w1 << 32);
        }
}

ATT_DI void xattn_unit(ATT_LAS char* lds, const bf16_t* QX, const bf16_t* MKV, bf16_t* OX, int unit) {
    int tid_l = threadIdx.x; asm volatile("" : "+v"(tid_l));
    const int tid = tid_l, lane = tid & 63, w = tid >> 6, r = lane & 31, h = lane >> 5, g1 = (lane >> 4) & 1, tq = (lane & 15) >> 2, tp = lane & 3;
    const int b = unit >> 4, hd = (unit >> 2) & 3, part = unit & 3;
    __syncthreads();
    for (int cidx = tid; cidx < 256 * 16; cidx += 512) { const int row = cidx >> 4, ch = cidx & 15;
        const bf16_t* src = MKV + (size_t)(b * MEML + row) * 1024 + hd * 128 + ch * 8;
        const u32x4 kv = *(const u32x4*)src, vv = *(const u32x4*)(src + 512);
        *(ATT_LAS u32x4*)(lds + L256::addr(row, ch * 16)) = kv; *(ATT_LAS u32x4*)(lds + 65536 + L256::addr(row, ch * 16)) = vv; }
    __syncthreads();
    const float c = LOG2E * 0.08838834764831845f;
#pragma unroll 1
    for (int qb = 0; qb < 2; ++qb) {
        const size_t tok = (size_t)b * SEQ + part * 512 + qb * 256 + w * 32 + r;
        bf16x8 qf[8]; load_q<8>(qf, QX + tok * 512 + hd * 128, h);
        float m = -INFINITY, l = 0.f; f32x16 O[4];
#pragma unroll
        for (int db = 0; db < 4; ++db)
#pragma unroll
            for (int i = 0; i < 16; ++i) O[db][i] = 0.f;
#pragma unroll 1
        for (int kt = 0; kt < 4; ++kt)
            tile64<8, 4, L256, L256, false>(lds + kt * 64 * 256, lds + 65536 + kt * 64 * 256, 0, 0, qf, m, l, O, c, r, h, g1, tq, tp, 0, 0, 0);
        store_o<4>(O, l, OX + tok * 512 + hd * 128, h);
    }
}
ATT_DI void swa_unit(ATT_LAS char* lds, const bf16_t* P  , const float* sinks, bf16_t* Y, int unit) {
    int tid_l = threadIdx.x; asm volatile("" : "+v"(tid_l));
    const int tid = tid_l, lane = tid & 63, w = tid >> 6, r = lane & 31, h = lane >> 5, g1 = (lane >> 4) & 1, tq = (lane & 15) >> 2, tp = lane & 3;
    const int b = unit >> 5, kvh = (unit >> 3) & 3, qb = unit & 7, q0 = qb * 256;
    constexpr int VOFF = 384 * 144;
    __syncthreads();
    for (int cidx = tid; cidx < 384 * 8; cidx += 512) { const int row = cidx >> 3, ch = cidx & 7; const int kpos = q0 - 128 + row;
        u32x4 kv = (u32x4){0u, 0u, 0u, 0u}, vv = kv;
        if (kpos >= 0) { const bf16_t* src = P + (size_t)(b * SEQ + kpos) * 1536 + 1024 + kvh * 64 + ch * 8; kv = *(const u32x4*)src; vv = *(const u32x4*)(src + 256); }
        *(ATT_LAS u32x4*)(lds + LPAD::addr(row, ch * 16)) = kv; *(ATT_LAS u32x4*)(lds + VOFF + LPAD::addr(row, ch * 16)) = vv; }
    __syncthreads();
    const float c = LOG2E * 0.125f;
    const int qpos = q0 + w * 32 + r; const size_t tok = (size_t)b * SEQ + qpos;
    const int t0 = (32 * w + 1) >> 6;
#pragma unroll 1
    for (int g = 0; g < 4; ++g) {
        const int hq = kvh * 4 + g;
        bf16x8 qf[4]; load_q<4>(qf, P + tok * 1536 + hq * 64, h);
        float m = sinks[hq] * LOG2E, l = (h == 0) ? 1.f : 0.f; f32x16 O[2];
#pragma unroll
        for (int db = 0; db < 2; ++db)
#pragma unroll
            for (int i = 0; i < 16; ++i) O[db][i] = 0.f;
#pragma unroll 1
        for (int t = t0; t < t0 + 3; ++t)
            tile64<4, 2, LPAD, LPAD, true>(lds + t * 64 * 144, lds + VOFF + t * 64 * 144, 0, 0, qf, m, l, O, c, r, h, g1, tq, tp, qpos, q0 - 128 + t * 64, 128);
        store_o<2>(O, l, Y + tok * 1024 + hq * 64, h);
    }
}
constexpr int DKB = 64 * 144, DBUF = DKB + 16384;
ATT_DI void diff_pass(ATT_LAS char* lds, const bf16_t* P, int b, int hd, int qb, int mp, f32x16 (&O)[4], float& lsum) {
    int tid_l = threadIdx.x; asm volatile("" : "+v"(tid_l));
    const int tid = tid_l, lane = tid & 63, w = tid >> 6, r = lane & 31, h = lane >> 5, g1 = (lane >> 4) & 1, tq = (lane & 15) >> 2, tp = lane & 3;
    const int q0 = qb * 256, NT = 4 * (qb + 1);
    const int qpos = q0 + w * 32 + r; const size_t tok = (size_t)b * SEQ + qpos;
    const int qmax_w = q0 + w * 32 + 31, qmin_w = q0 + w * 32;
    const float c = LOG2E * 0.125f;
    bf16x8 qf[4]; load_q<4>(qf, P + tok * 3072 + 1536 + hd * 128 + mp * 64, h);
    float m = -INFINITY, l = 0.f;
#pragma unroll
    for (int db = 0; db < 4; ++db)
#pragma unroll
        for (int i = 0; i < 16; ++i) O[db][i] = 0.f;
    const int srow = tid >> 3, sc1 = tid & 7;
    const bf16_t* sbase = P + (size_t)(b * SEQ + srow) * 3072 + hd * 128;
    u32x4 st[3];
    st[0] = *(const u32x4*)(sbase + 2048 + mp * 64 + sc1 * 8); st[1] = *(const u32x4*)(sbase + 2560 + sc1 * 16); st[2] = *(const u32x4*)(sbase + 2560 + sc1 * 16 + 8);
    __syncthreads();
    *(ATT_LAS u32x4*)(lds + LPAD::addr(srow, sc1 * 16)) = st[0];
    *(ATT_LAS u32x4*)(lds + DKB + L256::addr(srow, sc1 * 32)) = st[1]; *(ATT_LAS u32x4*)(lds + DKB + L256::addr(srow, sc1 * 32 + 16)) = st[2];
    __syncthreads();
#pragma unroll 1
    for (int kt = 0; kt < NT; ++kt) {
        const bool more = (kt + 1 < NT);
        if (more) { const bf16_t* s2 = sbase + (size_t)(kt + 1) * 64 * 3072;
            st[0] = *(const u32x4*)(s2 + 2048 + mp * 64 + sc1 * 8); st[1] = *(const u32x4*)(s2 + 2560 + sc1 * 16); st[2] = *(const u32x4*)(s2 + 2560 + sc1 * 16 + 8); }
        const ATT_LAS char* kb = lds + (kt & 1) * DBUF; const ATT_LAS char* vb = kb + DKB;
        if (kt * 64 <= qmax_w) {
            if (kt * 64 + 63 > qmin_w) tile64<4, 4, LPAD, L256, true>(kb, vb, 0, 0, qf, m, l, O, c, r, h, g1, tq, tp, qpos, kt * 64, 1 << 30);
            else                       tile64<4, 4, LPAD, L256, false>(kb, vb, 0, 0, qf, m, l, O, c, r, h, g1, tq, tp, qpos, kt * 64, 1 << 30);
        }
        if (more) { ATT_LAS char* d = lds + ((kt + 1) & 1) * DBUF;
            *(ATT_LAS u32x4*)(d + LPAD::addr(srow, sc1 * 16)) = st[0];
            *(ATT_LAS u32x4*)(d + DKB + L256::addr(srow, sc1 * 32)) = st[1]; *(ATT_LAS u32x4*)(d + DKB + L256::addr(srow, sc1 * 32 + 16)) = st[2]; }
        __syncthreads();
    }
    lsum = l + __shfl_xor(l, 32);
}
ATT_DI void diff_unit(ATT_LAS char* lds, const bf16_t* P  , const float* subln, float lam, bf16_t* Y, float* park  , int b, int hd, int qb) {
    int tid_l = threadIdx.x; asm volatile("" : "+v"(tid_l));
    const int tid = tid_l, lane = tid & 63, w = tid >> 6, r = lane & 31, h = lane >> 5;
    const size_t tok = (size_t)b * SEQ + qb * 256 + w * 32 + r;
    f32x4* pk = (f32x4*)(park + ((tok * 4 + hd) * 2 + h) * 64);
    f32x16 O0[4], O1[4]; float l0, l1;
    diff_pass(lds, P, b, hd, qb, 0, O0, l0);
    { const float i0 = 1.0f / l0;
#pragma unroll
      for (int db = 0; db < 4; ++db)
#pragma unroll
          for (int g = 0; g < 4; ++g) pk[db * 4 + g] = (f32x4){O0[db][4 * g] * i0, O0[db][4 * g + 1] * i0, O0[db][4 * g + 2] * i0, O0[db][4 * g + 3] * i0}; }
    diff_pass(lds, P, b, hd, qb, 1, O1, l1);
#pragma unroll
    for (int db = 0; db < 4; ++db)
#pragma unroll
        for (int g = 0; g < 4; ++g) { const f32x4 v = pk[db * 4 + g]; O0[db][4 * g] = v.x; O0[db][4 * g + 1] = v.y; O0[db][4 * g + 2] = v.z; O0[db][4 * g + 3] = v.w; }
    const float i1 = lam / l1;
    float ss = 0.f;
#pragma unroll
    for (int db = 0; db < 4; ++db)
#pragma unroll
        for (int i = 0; i < 16; ++i) { const float o = O0[db][i] - O1[db][i] * i1; O0[db][i] = o; ss += o * o; }
    ss += __shfl_xor(ss, 32);
    const float rs = 0.8f / sqrtf(ss * (1.0f / 128.0f) + EPS);
    bf16_t* orow = Y + tok * 1024 + 512 + hd * 128;
#pragma unroll
    for (int db = 0; db < 4; ++db)
#pragma unroll
        for (int g = 0; g < 4; ++g) { const int d = db * 32 + 8 * g + 4 * h; const f32x4 gg = *(const f32x4*)(subln + d);
            const unsigned w0 = cvtpk(O0[db][4 * g] * rs * gg.x, O0[db][4 * g + 1] * rs * gg.y), w1 = cvtpk(O0[db][4 * g + 2] * rs * gg.z, O0[db][4 * g + 3] * rs * gg.w);
            *(unsigned long long*)(orow + d) = (unsigned long long)w0 | ((unsigned long long)w1 << 32); }
}
ATT_DI void conv_tokens(const bf16_t* P, const float* convw, bf16_t* Y, int tok0  ) {
    int tid_l = threadIdx.x; asm volatile("" : "+v"(tid_l));
    const int tid = tid_l, cg = tid & 63, run = tid >> 6, c0 = cg * 8;
    float w[3][8];
#pragma unroll
    for (int j = 0; j < 3; ++j) { const f32x4 a = *(const f32x4*)(convw + j * 512 + c0), b2 = *(const f32x4*)(convw + j * 512 + c0 + 4);
        w[j][0] = a.x; w[j][1] = a.y; w[j][2] = a.z; w[j][3] = a.w; w[j][4] = b2.x; w[j][5] = b2.y; w[j][6] = b2.z; w[j][7] = b2.w; }
    const int tfirst = tok0 + run * 16;
    float z1[8], z2[8];
#pragma unroll
    for (int i = 0; i < 8; ++i) { z1[i] = 0.f; z2[i] = 0.f; }
#pragma unroll 1
    for (int tt = -2; tt < 16; ++tt) {
        const int tok = tfirst + tt;
        float z0[8];
        const bool inseq = ((tfirst & (SEQ - 1)) + tt) >= 0;
        if (inseq) { const bf16_t* pr = P + (size_t)tok * 3072; const u32x4 gc = *(const u32x4*)(pr + 512 + c0), uu = *(const u32x4*)(pr + 1024 + c0);
            z0[0] = bflo(gc.x) * bflo(uu.x); z0[1] = bfhi(gc.x) * bfhi(uu.x); z0[2] = bflo(gc.y) * bflo(uu.y); z0[3] = bfhi(gc.y) * bfhi(uu.y);
            z0[4] = bflo(gc.z) * bflo(uu.z); z0[5] = bfhi(gc.z) * bfhi(uu.z); z0[6] = bflo(gc.w) * bflo(uu.w); z0[7] = bfhi(gc.w) * bfhi(uu.w); }
        else {
#pragma unroll
            for (int i = 0; i < 8; ++i) z0[i] = 0.f; }
        if (tt >= 0) { const u32x4 gb = *(const u32x4*)(P + (size_t)tok * 3072 + c0); float y[8];
            const float gbf[8] = {bflo(gb.x), bfhi(gb.x), bflo(gb.y), bfhi(gb.y), bflo(gb.z), bfhi(gb.z), bflo(gb.w), bfhi(gb.w)};
#pragma unroll
            for (int i = 0; i < 8; ++i) y[i] = gbf[i] * (w[0][i] * z2[i] + w[1][i] * z1[i] + w[2][i] * z0[i]);
            u32x4 o; o.x = pk2(y[0], y[1]); o.y = pk2(y[2], y[3]); o.z = pk2(y[4], y[5]); o.w = pk2(y[6], y[7]);
            *(u32x4*)(Y + (size_t)tok * 1024 + c0) = o; }
#pragma unroll
        for (int i = 0; i < 8; ++i) { z2[i] = z1[i]; z1[i] = z0[i]; }
    }
}
}

#define LAS __attribute__((address_space(3)))
constexpr int LDS_BYTES = 147456, LDSCTL_OFF = 131072;
constexpr int LC_MISC = 0, LC_HIST = 64, LC_LBASE = 128, LC_RSV = 192, LC_SLOTS = 256, LC_JOBS_BYTE = 4096;
constexpr int CW_BAR = 4096;
constexpr size_t WS_WRT = 9 * MiB;

#define XB_TMO      128
#define XB_XCNT(j)  (256  + 64 * (j))
#define XB_XSUB(j)  (1280 + 64 * (j))
#define XB_XGEN(j)  (2304 + 64 * (j))
#define XB_TOP      3328
#define XB_TOPGEN   3392
#define XCD_BAR_WORDS 3456
#define XB_SPIN_CAP (1u << 18)
__device__ __forceinline__ unsigned xb_ld(unsigned* p)              { return __hip_atomic_load(p, __ATOMIC_RELAXED, __HIP_MEMORY_SCOPE_AGENT); }
__device__ __forceinline__ unsigned xb_add(unsigned* p, unsigned v) { return __hip_atomic_fetch_add(p, v, __ATOMIC_RELAXED, __HIP_MEMORY_SCOPE_AGENT); }
__device__ __forceinline__ unsigned xb_xcc_id() { return (unsigned)__builtin_amdgcn_s_getreg((3 << 11) | 20) & 0xFu; }
#define XB_SPIN(cond, bar) do { unsigned _sp = 0; while (cond) { __builtin_amdgcn_s_sleep(1); \
    if ((++_sp & 255u) == 0u) { if (xb_ld(&(bar)[XB_TMO])) break; if (_sp > XB_SPIN_CAP) { atomicAdd(&(bar)[XB_TMO], 1u); break; } } } } while (0)
struct XcdBarrier { unsigned* bar; unsigned x; volatile LAS unsigned* st; };
__device__ __forceinline__ XcdBarrier xcd_barrier_post(unsigned* bar, volatile LAS unsigned* st) {
    XcdBarrier b; b.bar = bar; b.x = xb_xcc_id(); b.st = st;
    if (threadIdx.x == 0) (void)xb_add(&bar[XB_XCNT(b.x)], 1u);
    return b;
}
__device__ __forceinline__ void xcd_barrier_complete(unsigned* bar, unsigned x, unsigned& nloc, unsigned& nx) {
    const unsigned G = gridDim.x * gridDim.y * gridDim.z;
    unsigned sum, cnt, mine, sp = 0u;
    for (;;) {
        sum = 0u; cnt = 0u; mine = 0u;
#pragma unroll
        for (unsigned j = 0; j < 16; ++j) { const unsigned c = xb_ld(&bar[XB_XCNT(j)]); sum += c; cnt += (c > 0u) ? 1u : 0u; mine = (j == x) ? c : mine; }
        if (sum == G) break;
        __builtin_amdgcn_s_sleep(1);
        if ((++sp & 255u) == 0u) { if (xb_ld(&bar[XB_TMO])) break; if (sp > XB_SPIN_CAP) { atomicAdd(&bar[XB_TMO], 1u); break; } }
    }
    nloc = mine > 0u ? mine : 1u; nx = cnt > 0u ? cnt : 1u;
}
__device__ __forceinline__ void xcd_barrier(const XcdBarrier& b) {
    asm volatile("s_waitcnt vmcnt(0)" ::: "memory");
    __syncthreads();
    if (threadIdx.x == 0) {
        unsigned* bar = b.bar;
        __builtin_amdgcn_s_waitcnt(0);
        unsigned nloc = b.st[0], nx = b.st[1];
        if (nloc == 0u) { xcd_barrier_complete(bar, b.x, nloc, nx); b.st[0] = nloc; b.st[1] = nx; }
        const unsigned old = xb_add(&bar[XB_XSUB(b.x)], 1u);
        const unsigned gen = old / nloc;
        if (old + 1u == (gen + 1u) * nloc) {
            __builtin_amdgcn_fence(__ATOMIC_RELEASE, "agent");
            asm volatile("s_waitcnt vmcnt(0)" ::: "memory");
            const unsigned og = xb_add(&bar[XB_TOP], 1u);
            const unsigned tg = og / nx;
            if (og + 1u == (tg + 1u) * nx) xb_add(&bar[XB_TOPGEN], 1u);
            else XB_SPIN(xb_ld(&bar[XB_TOPGEN]) == tg, bar);
            __builtin_amdgcn_fence(__ATOMIC_ACQUIRE, "agent");
            xb_add(&bar[XB_XGEN(b.x)], 1u);
            asm volatile("s_waitcnt vmcnt(0)" ::: "memory");
        } else {
            XB_SPIN(xb_ld(&bar[XB_XGEN(b.x)]) == gen, bar);
            __builtin_amdgcn_fence(__ATOMIC_ACQUIRE, "agent");
            asm volatile("s_waitcnt vmcnt(0)" ::: "memory");
        }
    }
    __syncthreads();
}

struct WJob { const float* src; bf16_t* dst; const float* gain; int K, N, ipm, first, nitems, perm; };
__device__ __forceinline__ void wt_item(const float* W, int K, int N, const float* gain, bf16_t* WT, int perm, LAS float* scr, int item, int lane) {
    const int nblk = N / 32, kb = item / nblk, nb = item % nblk, k0 = 64 * kb, n0 = 32 * nb;
    const int lr = lane >> 3, lc = (lane & 7) * 4;
    f32x4 v[8];
#pragma unroll
    for (int i = 0; i < 8; ++i) v[i] = *(const f32x4*)(W + (size_t)(k0 + 8 * i + lr) * N + n0 + lc);
    const int c = lane & 7;
    f32x4 g0 = (f32x4){1.f, 1.f, 1.f, 1.f}, g1 = g0;
    if (gain) { g0 = *(const f32x4*)(gain + k0 + 8 * c); g1 = *(const f32x4*)(gain + k0 + 8 * c + 4); }
#pragma unroll
    for (int i = 0; i < 8; ++i) { LAS float* d = scr + (8 * i + lr) * 33 + lc; d[0] = v[i].x; d[1] = v[i].y; d[2] = v[i].z; d[3] = v[i].w; }
    asm volatile("s_waitcnt lgkmcnt(0)" ::: "memory");
#pragma unroll
    for (int j = 0; j < 4; ++j) { const int n = (lane >> 3) + 8 * j; const LAS float* s = scr + (8 * c) * 33 + n;
        u32x4 o; o.x = pk2(s[0 * 33] * g0.x, s[1 * 33] * g0.y); o.y = pk2(s[2 * 33] * g0.z, s[3 * 33] * g0.w); o.z = pk2(s[4 * 33] * g1.x, s[5 * 33] * g1.y); o.w = pk2(s[6 * 33] * g1.z, s[7 * 33] * g1.w);
        const int ns = n0 + n; int nd = ns;
        if (perm) { const int half = ns >> 9, jj = ns & 511; nd = (jj >> 7) * 256 + half * 128 + (jj & 127); }
        *(u32x4*)(WT + (size_t)nd * K + k0 + 8 * c) = o; }
    asm volatile("s_waitcnt lgkmcnt(0)" ::: "memory");
}
__device__ __forceinline__ void rowprep_rows(const float* x, bf16_t* xb, float* ssq, int rows, int gw, int ngw, int lane) {
    for (int row = gw; row < rows; row += ngw) {
        const f32x4* xr = (const f32x4*)(x + (size_t)row * DM) + lane; float s = 0.f;
        unsigned long long* o8 = (unsigned long long*)(xb + (size_t)row * DM) + lane;
#pragma unroll
        for (int jx = 0; jx < 4; ++jx) { const f32x4 v = xr[64 * jx]; s += (v.x * v.x + v.y * v.y) + (v.z * v.z + v.w * v.w);
            o8[64 * jx] = (unsigned long long)pk2(v.x, v.y) | ((unsigned long long)pk2(v.z, v.w) << 32); }
        s = wave_sum(s);
        if (lane < 16) ssq[(size_t)row * 16 + lane] = (lane == 0) ? s : 0.f;
    }
}
__device__ __forceinline__ void sincos_d(double a, float& c, float& s) {
    const double TWO_PI = 6.283185307179586476925286766559;
    const double n = __builtin_rint(a / TWO_PI); const double r = a - n * TWO_PI;
    const double r2 = r * r;
    double sp = 1.0, cp = 1.0;
#pragma unroll
    for (int k = 15; k >= 1; --k) { sp = 1.0 - r2 / (double)((2 * k) * (2 * k + 1)) * sp; cp = 1.0 - r2 / (double)((2 * k - 1) * (2 * k)) * cp; }
    s = (float)(r * sp); c = (float)cp;
}

typedef float f32x16r __attribute__((ext_vector_type(16)));
typedef short bf16x8r __attribute__((ext_vector_type(8)));
__device__ __forceinline__ void route_group(const bf16_t* xb, const float* ssq, const bf16_t* WRh  , const float* bg, const float* br, int tok0, LAS float* S  , LAS int* hist,
                                            int* route_e, float* route_w, float* rs_tok, int lane) {
    const int r = lane & 31, kk = lane >> 5;
    f32x16r a0, a1;
#pragma unroll
    for (int i = 0; i < 16; ++i) { a0[i] = 0.f; a1[i] = 0.f; }
    const bf16x8r* xa = (const bf16x8r*)(xb + (size_t)(tok0 + r) * DM + 8 * kk);
    const bf16x8r* h0 = (const bf16x8r*)(WRh + (size_t)r * DM + 8 * kk);
    const bf16x8r* h1 = (const bf16x8r*)(WRh + (size_t)(32 + r) * DM + 8 * kk);
    const bf16x8r* l0 = (const bf16x8r*)(WRh + (size_t)(64 + r) * DM + 8 * kk);
    const bf16x8r* l1 = (const bf16x8r*)(WRh + (size_t)(96 + r) * DM + 8 * kk);
#pragma unroll 4
    for (int s = 0; s < 64; ++s) {
        const bf16x8r av = xa[2 * s], bh0 = h0[2 * s], bh1 = h1[2 * s], bl0 = l0[2 * s], bl1 = l1[2 * s];
        a0 = __builtin_amdgcn_mfma_f32_32x32x16_bf16(av, bh0, a0, 0, 0, 0); a1 = __builtin_amdgcn_mfma_f32_32x32x16_bf16(av, bh1, a1, 0, 0, 0);
        a0 = __builtin_amdgcn_mfma_f32_32x32x16_bf16(av, bl0, a0, 0, 0, 0); a1 = __builtin_amdgcn_mfma_f32_32x32x16_bf16(av, bl1, a1, 0, 0, 0);
    }
#pragma unroll
    for (int i = 0; i < 16; ++i) { const int trow = (i & 3) + 8 * (i >> 2) + 4 * kk; S[trow * 68 + r] = a0[i]; if (r < 4) S[trow * 68 + 32 + r] = a1[i]; }
    asm volatile("s_waitcnt lgkmcnt(0)" ::: "memory");
    if (lane < 32) {
        const int tok = tok0 + lane; const LAS float* sr = S + lane * 68;
        const float rs = row_rs(ssq, tok);
        float lg[4];
#pragma unroll
        for (int g = 0; g < 4; ++g) lg[g] = sr[g] * rs + bg[g];
        int gs = 0; float gm = lg[0];
#pragma unroll
        for (int g = 1; g < 4; ++g) if (lg[g] > gm) { gm = lg[g]; gs = g; }
        float gsum = 0.f;
#pragma unroll
        for (int g = 0; g < 4; ++g) gsum += expf(lg[g] - gm);
        const float p_g = 1.0f / gsum;
        float le[8];
#pragma unroll
        for (int e = 0; e < 8; ++e) le[e] = sr[4 + gs * 8 + e] * rs + br[gs * 8 + e];
        int i1 = 0; float m1 = le[0];
#pragma unroll
        for (int e = 1; e < 8; ++e) if (le[e] > m1) { m1 = le[e]; i1 = e; }
        int i2 = -1; float m2 = -INFINITY;
#pragma unroll
        for (int e = 0; e < 8; ++e) if (e != i1 && le[e] > m2) { m2 = le[e]; i2 = e; }
        const float e2 = expf(m2 - m1); const float w1v = p_g / (1.0f + e2), w2v = p_g * e2 / (1.0f + e2);
        const int ex1 = gs * 8 + i1, ex2 = gs * 8 + i2;
        route_e[tok * 2] = ex1; route_e[tok * 2 + 1] = ex2; route_w[tok * 2] = w1v; route_w[tok * 2 + 1] = w2v; rs_tok[tok] = rs;
        __hip_atomic_fetch_add(hist + ex1, 1, __ATOMIC_RELAXED, __HIP_MEMORY_SCOPE_WORKGROUP);
        __hip_atomic_fetch_add(hist + 32 + ex2, 1, __ATOMIC_RELAXED, __HIP_MEMORY_SCOPE_WORKGROUP);
    }
    asm volatile("s_waitcnt lgkmcnt(0)" ::: "memory");
}

#define PHASE_PTRS \
    unsigned char* ws = args.ws; int z_ = 0; int tid = threadIdx.x; asm volatile("" : "+s"(ws), "+s"(z_), "+v"(tid)); \
    const int lane = tid & 63, wave = __builtin_amdgcn_readfirstlane(tid >> 6), gw = bx * 8 + wave; (void)lane; (void)gw; \
    const float* x = args.in[0 + z_]; const float* mem = args.in[1 + z_]; const float* mem_norm = args.in[2 + z_]; const float* mem_w_kv = args.in[3 + z_]; \
    const float* norm_mix = args.in[4 + z_]; const float* norm_xattn = args.in[5 + z_]; const float* norm_ffn = args.in[6 + z_]; \
    const float* hyb_w_in = args.in[7 + z_]; const float* hyb_conv_w = args.in[8 + z_]; const float* diff_lambda = args.in[9 + z_]; const float* diff_subln = args.in[10 + z_]; \
    const float* hyb_w_out = args.in[11 + z_]; const float* swa_w_qkv = args.in[12 + z_]; const float* swa_b_qkv = args.in[13 + z_]; const float* swa_sinks = args.in[14 + z_]; \
    const float* swa_w_out = args.in[15 + z_]; const float* swa_b_out = args.in[16 + z_]; const float* xattn_w_q = args.in[17 + z_]; const float* xattn_w_o = args.in[18 + z_]; \
    const float* moe_w_group = args.in[19 + z_]; const float* moe_b_group = args.in[20 + z_]; const float* moe_w_router = args.in[21 + z_]; const float* moe_b_router = args.in[22 + z_]; \
    const float* moe_w_gate_up = args.in[23 + z_]; const float* moe_w_down = args.in[24 + z_]; const float* final_norm = args.in[25 + z_]; \
    float* ropeC = (float*)(ws + WS_ROPEC); float* ropeS = (float*)(ws + WS_ROPES); bf16_t* WRt = (bf16_t*)(ws + WS_WRT); float* lam = (float*)(ws + WS_LAM); \
    float* ssq = (float*)(ws + WS_SSQ); float* ssqm = (float*)(ws + WS_SSQM); \
    int* tok_of_slot = (int*)(ws + WS_TOKSLOT); float* w_of_slot = (float*)(ws + WS_WSLOT); float* rs_of_slot = (float*)(ws + WS_RSSLOT); \
    int* route_e = (int*)(ws + WS_ROUTE_E); float* route_w = (float*)(ws + WS_ROUTE_W); float* rs_tok = (float*)(ws + WS_RSTOK); \
    bf16_t* memb = (bf16_t*)(ws + WS_MEMB); bf16_t* mkv = (bf16_t*)(ws + WS_MKV); \
    bf16_t* Wmem = (bf16_t*)(ws + WS_WMEM); bf16_t* Win = (bf16_t*)(ws + WS_WIN); bf16_t* Wout0 = (bf16_t*)(ws + WS_WOUT0); bf16_t* Wqkv = (bf16_t*)(ws + WS_WQKV); bf16_t* Wout1 = (bf16_t*)(ws + WS_WOUT1); \
    bf16_t* Wq = (bf16_t*)(ws + WS_WQ); bf16_t* Wo = (bf16_t*)(ws + WS_WO); bf16_t* Wgu = (bf16_t*)(ws + WS_WGU); bf16_t* Wdn = (bf16_t*)(ws + WS_WDN); \
    float* XA = (float*)(ws + WS_XA); bf16_t* XBF = (bf16_t*)(ws + WS_XBF); bf16_t* Y = (bf16_t*)(ws + WS_Y); bf16_t* QX = (bf16_t*)(ws + WS_QX); bf16_t* OX = (bf16_t*)(ws + WS_OX); \
    bf16_t* P = (bf16_t*)(ws + WS_U1); bf16_t* XS = (bf16_t*)(ws + WS_U1); float* PARK = (float*)(ws + WS_U2); bf16_t* HID = (bf16_t*)(ws + WS_U2); \
    (void)0

struct MegaArgs { const float* in[26]; float* out; unsigned char* ws; double inv[8]; int ph_lo, ph_hi, probe_phase, probe_reps; };
constexpr int N_PHASES = 24;
__global__ void __launch_bounds__(512, 2) mega_fwd(MegaArgs args) {
    extern __shared__ __attribute__((aligned(16))) unsigned char lds_raw[];
    LAS unsigned char* lds = (LAS unsigned char*)lds_raw;
    LAS int* LC = (LAS int*)(lds + LDSCTL_OFF);
    const int G = (int)gridDim.x, bx = (int)blockIdx.x, ngw = G * 8;
    int* ctl = (int*)(args.ws + WS_CTL);
    for (int u = threadIdx.x; u < 1024; u += 512) LC[u] = 0;
    __syncthreads();
    const int lo = args.ph_lo, hi = args.ph_hi;
    const bool multi = (hi - lo) > 1;
    XcdBarrier bar; bar.bar = (unsigned*)(ctl + CW_BAR); bar.x = 0; bar.st = nullptr;
    if (multi) bar = xcd_barrier_post((unsigned*)(ctl + CW_BAR), (volatile LAS unsigned*)(LC + LC_MISC + 8));
#define IN(k) (lo <= (k) && (k) < hi)
#define REPS(k) (((k) == args.probe_phase) ? 1 + args.probe_reps : 1)
#define BAR(k) do { if (IN(k) && IN((k) + 1)) xcd_barrier(bar); } while (0)

    if (IN(0)) for (int rep_ = 0; rep_ < REPS(0); ++rep_) { PHASE_PTRS; const bool dry = rep_ > 0; (void)dry;
        LAS unsigned long long* jp = (LAS unsigned long long*)(lds + LDSCTL_OFF + LC_JOBS_BYTE);
        LAS int* ji = (LAS int*)(lds + LDSCTL_OFF + LC_JOBS_BYTE + 1024);
        if (tid == 0) {
            int first = 0, nj = 0;
#define ADDJOB(SRC, DST, GAIN, KK, NN, NB, PERM) do { jp[3 * nj] = (unsigned long long)(uintptr_t)(SRC); jp[3 * nj + 1] = (unsigned long long)(uintptr_t)(DST); jp[3 * nj + 2] = (unsigned long long)(uintptr_t)(GAIN); \
            const int ipm_ = ((KK) / 64) * ((NN) / 32); ji[8 * nj] = (KK); ji[8 * nj + 1] = (NN); ji[8 * nj + 2] = ipm_; ji[8 * nj + 3] = first; ji[8 * nj + 4] = ipm_ * (NB); ji[8 * nj + 5] = (PERM); first += ipm_ * (NB); ++nj; } while (0)
            ADDJOB(moe_w_gate_up, Wgu, norm_ffn, 1024, 1024, 32, 1);
            ADDJOB(moe_w_gate_up + (size_t)32 * 1024 * 1024, Wgu + (size_t)32 * 1024 * 1024, norm_ffn + 1024, 1024, 1024, 32, 1);
            ADDJOB(moe_w_down, Wdn, (const float*)nullptr, 512, 1024, 32, 0);
            ADDJOB(moe_w_down + (size_t)32 * 512 * 1024, Wdn + (size_t)32 * 512 * 1024, (const float*)nullptr, 512, 1024, 32, 0);
            ADDJOB(mem_w_kv, Wmem, mem_norm, 1024, 1024, 1, 0);
            ADDJOB(hyb_w_in, Win, norm_mix, 1024, 3072, 1, 0);
            ADDJOB(hyb_w_out, Wout0, (const float*)nullptr, 1024, 1024, 1, 0);
            ADDJOB(swa_w_qkv, Wqkv, norm_mix + 1024, 1024, 1536, 1, 0);
            ADDJOB(swa_w_out, Wout1, (const float*)nullptr, 1024, 1024, 1, 0);
            ADDJOB(xattn_w_q, Wq, norm_xattn, 1024, 512, 1, 0);
            ADDJOB(xattn_w_q + (size_t)1024 * 512, Wq + (size_t)512 * 1024, norm_xattn + 1024, 1024, 512, 1, 0);
            ADDJOB(xattn_w_o, Wo, (const float*)nullptr, 512, 1024, 1, 0);
            ADDJOB(xattn_w_o + (size_t)512 * 1024, Wo + (size_t)1024 * 512, (const float*)nullptr, 512, 1024, 1, 0);
#undef ADDJOB
        }
        __syncthreads();
        LAS float* scr = (LAS float*)(lds + wave * 16384);
#pragma unroll 1
        for (int j = 0; j < 13; ++j) {
            const float* jsrc = (const float*)(uintptr_t)jp[3 * j]; bf16_t* jdst = (bf16_t*)(uintptr_t)jp[3 * j + 1]; const float* jgain = (const float*)(uintptr_t)jp[3 * j + 2];
            const int jK = ji[8 * j], jN = ji[8 * j + 1], jipm = ji[8 * j + 2], jfirst = ji[8 * j + 3], jn = ji[8 * j + 4], jperm = ji[8 * j + 5];
            int loc = (gw - jfirst) % ngw; if (loc < 0) loc += ngw;
            for (; loc < jn; loc += ngw) { const int bidx = loc / jipm, item = loc - bidx * jipm; const size_t mo = (size_t)bidx * jK * jN;
                wt_item(jsrc + mo, jK, jN, jgain, jdst + mo, jperm, scr, item, lane); }
        }
        { const int gid = bx * 512 + tid, nth = G * 512;
          for (int i = gid; i < SEQ * 8; i += nth) { const int pos = i >> 3, jx = i & 7; float c, s; sincos_d((double)pos * args.inv[jx], c, s); ropeC[i] = c; ropeS[i] = s; }
          for (int i = gid; i < 2 * 64 * 1024; i += nth) { const int l = i >> 16, c = (i >> 10) & 63, k = i & 1023; const float g = norm_ffn[l * 1024 + k];
              const float wv = (c < 4) ? g * moe_w_group[(size_t)(l * 1024 + k) * 4 + c] : (c < 36) ? g * moe_w_router[(size_t)(l * 1024 + k) * 32 + (c - 4)] : 0.f;
              const unsigned hb = f2bf(wv); const float rem = wv - bf2f((bf16_t)hb);
              WRt[(size_t)l * 2 * 65536 + (i & 65535)] = (bf16_t)hb; WRt[(size_t)l * 2 * 65536 + 65536 + (i & 65535)] = (bf16_t)f2bf(rem); }
          if (gid == 0) { float s01 = 0.f, s23 = 0.f; for (int d = 0; d < 64; ++d) { s01 += diff_lambda[d] * diff_lambda[64 + d]; s23 += diff_lambda[128 + d] * diff_lambda[192 + d]; }
              lam[0] = expf(s01) - expf(s23) + 0.2f; } }
        rowprep_rows(x, XBF, ssq, T_TOK, gw, ngw, lane);
        rowprep_rows(mem, memb, ssqm, TMEM, gw, ngw, lane);
    }
    BAR(0);
    if (IN(1)) for (int rep_ = 0; rep_ < REPS(1); ++rep_) { PHASE_PTRS; const bool dry = rep_ > 0; (void)dry;
        { pg8::Gemm g{memb, Wmem, TMEM, 1024, 1024, 0}; pg8::StaticOrder S; S.init(TMEM, 1024, G, (bx + 64) % G);
          EpiProj E; E.O = mkv; E.ssq = ssqm; E.bias = nullptr; E.ropeC = ropeC; E.ropeS = ropeS; E.ldc = 1024; E.rope_lo = 0; E.rope_hi = 0; E.pad = 0;
          pg8::gemm_phase<EpiProj, pg8::StaticOrder, true, true>(lds, g, S, E); }
        __syncthreads();
        { pg8::Gemm g{XBF, Win, T_TOK, 3072, 1024, 0}; pg8::StaticOrder S; S.init(T_TOK, 3072, G, bx);
          EpiProj E; E.O = P; E.ssq = ssq; E.bias = nullptr; E.ropeC = ropeC; E.ropeS = ropeS; E.ldc = 3072; E.rope_lo = 1536; E.rope_hi = 2560; E.pad = 0;
          pg8::gemm_phase<EpiProj, pg8::StaticOrder, true, true>(lds, g, S, E); }
    }
    BAR(1);
    if (IN(2)) for (int rep_ = 0; rep_ < REPS(2); ++rep_) { PHASE_PTRS; const bool dry = rep_ > 0; (void)dry;
        const float lamv = lam[0];
        for (int cu = bx; cu < 256; cu += G) {
            const int bh = cu >> 2, j = cu & 3;
            att::diff_unit((ATT_LAS char*)lds, P, diff_subln, lamv, Y, PARK, bh >> 2, bh & 3, 7 - j);
            att::diff_unit((ATT_LAS char*)lds, P, diff_subln, lamv, Y, PARK, bh >> 2, bh & 3, j);
            att::conv_tokens(P, hyb_conv_w, Y, cu * 128);
        }
    }
    BAR(2);
    if (IN(3)) for (int rep_ = 0; rep_ < REPS(3); ++rep_) { PHASE_PTRS; const bool dry = rep_ > 0; (void)dry;
        pg8::Gemm g{Y, Wout0, T_TOK, 1024, 1024, 0}; pg8::StaticOrder S; S.init(T_TOK, 1024, G, bx);
        EpiResid E; E.xin = XBF; E.xout = XBF; E.ssq = ssq; E.bias = nullptr;
        pg8::gemm_phase<EpiResid, pg8::StaticOrder, true, true>(lds, g, S, E);
    }
    BAR(3);
#pragma unroll 1
    for (int l = 0; l < 2; ++l) {
        int* lctl = ctl + l * CI_STRIDE;
        if (l == 1) {
            if (IN(12)) for (int rep_ = 0; rep_ < REPS(12); ++rep_) { PHASE_PTRS; const bool dry = rep_ > 0; (void)dry;
                pg8::Gemm g{XBF, Wqkv, T_TOK, 1536, 1024, 0}; pg8::StaticOrder S; S.init(T_TOK, 1536, G, bx);
                EpiProj E; E.O = P; E.ssq = ssq; E.bias = swa_b_qkv; E.ropeC = ropeC; E.ropeS = ropeS; E.ldc = 1536; E.rope_lo = 0; E.rope_hi = 1280; E.pad = 0;
                pg8::gemm_phase<EpiProj, pg8::StaticOrder, true, true>(lds, g, S, E);
            }
            BAR(12);
            if (IN(13)) for (int rep_ = 0; rep_ < REPS(13); ++rep_) { PHASE_PTRS; const bool dry = rep_ > 0; (void)dry; for (int u = bx; u < 512; u += G) att::swa_unit((ATT_LAS char*)lds, P, swa_sinks, Y, u); }
            BAR(13);
            if (IN(14)) for (int rep_ = 0; rep_ < REPS(14); ++rep_) { PHASE_PTRS; const bool dry = rep_ > 0; (void)dry;
                pg8::Gemm g{Y, Wout1, T_TOK, 1024, 1024, 0}; pg8::StaticOrder S; S.init(T_TOK, 1024, G, bx);
                EpiResid E; E.xin = XBF; E.xout = dry ? QX : XBF; E.ssq = dry ? (float*)(ws + WS_U1 + 160 * MiB) : ssq; E.bias = swa_b_out;
                pg8::gemm_phase<EpiResid, pg8::StaticOrder, true, true>(lds, g, S, E);
            }
            BAR(14);
        }
        const int cb = l ? 15 : 4;
        if (IN(cb)) for (int rep_ = 0; rep_ < REPS(cb); ++rep_) { PHASE_PTRS; const bool dry = rep_ > 0; (void)dry;
            pg8::Gemm g{XBF, Wq + (size_t)l * 512 * 1024, T_TOK, 512, 1024, 0}; pg8::StaticOrder S; S.init(T_TOK, 512, G, bx);
            EpiProj E; E.O = QX; E.ssq = ssq; E.bias = nullptr; E.ropeC = ropeC; E.ropeS = ropeS; E.ldc = 512; E.rope_lo = 0; E.rope_hi = 0; E.pad = 0;
            pg8::gemm_phase<EpiProj, pg8::StaticOrder, true, true>(lds, g, S, E);
        }
        BAR(cb);
        if (IN(cb + 1)) for (int rep_ = 0; rep_ < REPS(cb + 1); ++rep_) { PHASE_PTRS; const bool dry = rep_ > 0; (void)dry; for (int u = bx; u < 256; u += G) att::xattn_unit((ATT_LAS char*)lds, QX, mkv, OX, u); }
        BAR(cb + 1);
        if (IN(cb + 2)) for (int rep_ = 0; rep_ < REPS(cb + 2); ++rep_) { PHASE_PTRS; const bool dry = rep_ > 0; (void)dry;
            pg8::Gemm g{OX, Wo + (size_t)l * 1024 * 512, T_TOK, 1024, 512, 0}; pg8::StaticOrder S; S.init(T_TOK, 1024, G, bx);
            EpiResid E; E.xin = XBF; E.xout = dry ? Y : XBF; E.ssq = dry ? (float*)(ws + WS_U1 + 160 * MiB) : ssq; E.bias = nullptr;
            pg8::gemm_phase<EpiResid, pg8::StaticOrder, true, true>(lds, g, S, E);
        }
        BAR(cb + 2);
        if (IN(cb + 3)) for (int rep_ = 0; rep_ < REPS(cb + 3); ++rep_) { PHASE_PTRS; const bool dry = rep_ > 0; (void)dry;
            __syncthreads();
            if (tid < 64) LC[LC_HIST + tid] = 0;
            { int gl = G; asm volatile("" : "+s"(gl));
              for (int i = bx * 512 + tid; i < SPAD; i += gl * 512) tok_of_slot[i] = -1; }
            __syncthreads();
            for (int grp = wave * G + bx; grp < T_TOK / 32; grp += 8 * G)
                route_group(XBF, ssq, WRt + (size_t)l * 2 * 65536, moe_b_group + l * 4, moe_b_router + l * 32, grp * 32, (LAS float*)(lds + wave * 16384), LC + LC_HIST, route_e, route_w, rs_tok, lane);
            __syncthreads();
            if (tid < 64) { const int c = LC[LC_HIST + tid]; if (c > 0) atomicAdd((dry ? ctl + 2 * CI_STRIDE : lctl) + CI_CNT + tid, c); }
        }
        BAR(cb + 3);
        if (IN(cb + 4)) { PHASE_PTRS;
            __syncthreads();
            if (wave == 0) {
                const int cnt = lctl[CI_CNT + lane]; const int tiles = (cnt + 255) >> 8;
                int incl = tiles;
#pragma unroll
                for (int o = 1; o < 64; o <<= 1) { const int t = __shfl_up(incl, o); if (lane >= o) incl += t; }
                const int base = incl - tiles;
                LC[LC_LBASE + lane] = base * 256;
                if (bx == 0) {
                    for (int i = 0; i < tiles; ++i) lctl[CI_TEXP + base + i] = lane & 31;
                    if (lane == 31) lctl[CI_NT] = incl;
                    if (lane == 63) lctl[CI_NT + 1] = incl;
                }
            }
            for (int chunk = bx; chunk < T_TOK / 128; chunk += G) {
                __syncthreads();
                if (tid < 64) LC[LC_HIST + tid] = 0;
                __syncthreads();
                int L = 0, rank = 0; const int tokp = chunk * 128 + (tid >> 1), kq = tid & 1;
                if (tid < 256) { L = kq * 32 + route_e[tokp * 2 + kq]; rank = __hip_atomic_fetch_add(LC + LC_HIST + L, 1, __ATOMIC_RELAXED, __HIP_MEMORY_SCOPE_WORKGROUP); }
                __syncthreads();
                if (tid < 64) { const int c = LC[LC_HIST + tid]; LC[LC_RSV + tid] = (c > 0) ? atomicAdd(lctl + CI_CUR + tid, c) : 0; }
                __syncthreads();
                if (tid < 256) { const int slot = LC[LC_LBASE + L] + LC[LC_RSV + L] + rank; LC[LC_SLOTS + tid] = slot;
                    tok_of_slot[slot] = tokp; w_of_slot[slot] = route_w[tokp * 2 + kq]; rs_of_slot[slot] = rs_tok[tokp]; }
                __syncthreads();
                for (int pr = wave * 32; pr < wave * 32 + 32; ++pr) { const int slot = LC[LC_SLOTS + pr]; const int tk = chunk * 128 + (pr >> 1);
                    const u32x4* src = (const u32x4*)(XBF + (size_t)tk * DM); u32x4* dst = (u32x4*)(XS + (size_t)slot * DM);
                    dst[lane] = src[lane]; dst[lane + 64] = src[lane + 64]; }
            }
        }
        BAR(cb + 4);
        if (IN(cb + 5)) for (int rep_ = 0; rep_ < REPS(cb + 5); ++rep_) { PHASE_PTRS; const bool dry = rep_ > 0; (void)dry;
            pg8::Gemm g{XS, Wgu + (size_t)l * 32 * 1024 * 1024, SPAD, 1024, 1024, 0};
            GroupedOrder S; S.tile_expert = lctl + CI_TEXP; S.nN = 4; S.G = G; S.c = bx; S.tiles_per_expert = 4; S.t_lo = 0; S.t_hi = lctl[CI_NT + 1];
            EpiGateUp E; E.hid = HID; E.rs_slot = rs_of_slot;
            pg8::gemm_phase<EpiGateUp, GroupedOrder, true, true>(lds, g, S, E);
        }
        BAR(cb + 5);
#pragma unroll 1
        for (int pass = 0; pass < 2; ++pass) {
            if (IN(cb + 6 + pass)) for (int rep_ = 0; rep_ < REPS(cb + 6 + pass); ++rep_) { PHASE_PTRS; const bool dry = rep_ > 0; (void)dry;
                pg8::Gemm g{HID, Wdn + (size_t)l * 32 * 1024 * 512, SPAD, 1024, 512, 0};
                const int nt0 = lctl[CI_NT], nt1 = lctl[CI_NT + 1];
                GroupedOrder S; S.tile_expert = lctl + CI_TEXP; S.nN = 4; S.G = G; S.c = bx; S.tiles_per_expert = 4; S.t_lo = pass ? nt0 : 0; S.t_hi = pass ? nt1 : nt0;
                EpiDown E; E.xin = XBF; E.xout = dry ? Y : XBF; E.ssq = dry ? (float*)(ws + WS_U1 + 160 * MiB) : ssq; E.tok_of_slot = tok_of_slot; E.w_of_slot = w_of_slot; E.last = pass; E.pad = 0;
                pg8::gemm_phase<EpiDown, GroupedOrder, true, true>(lds, g, S, E);
            }
            BAR(cb + 6 + pass);
        }
    }
    if (IN(23)) for (int rep_ = 0; rep_ < REPS(23); ++rep_) { PHASE_PTRS; const bool dry = rep_ > 0; (void)dry;
        for (int row = gw; row < T_TOK; row += ngw) {
            const unsigned long long* xr = (const unsigned long long*)(XBF + (size_t)row * DM) + lane; f32x4 v[4]; float s = 0.f;
#pragma unroll
            for (int jx = 0; jx < 4; ++jx) { const unsigned long long q = xr[64 * jx]; const unsigned qa = (unsigned)q, qb = (unsigned)(q >> 32); v[jx] = (f32x4){bflo(qa), bfhi(qa), bflo(qb), bfhi(qb)};
                s += (v[jx].x * v[jx].x + v[jx].y * v[jx].y) + (v[jx].z * v[jx].z + v[jx].w * v[jx].w); }
            const float rs = 1.0f / sqrtf(wave_sum(s) * (1.0f / 1024.0f) + EPS);
            f32x4* orow = (f32x4*)(args.out + (size_t)row * DM) + lane; const f32x4* gr = (const f32x4*)final_norm + lane;
#pragma unroll
            for (int jx = 0; jx < 4; ++jx) orow[64 * jx] = v[jx] * rs * gr[64 * jx];
        }
    }
#undef IN
#undef BAR
}

#ifndef MK_PROBE_PHASE
#define MK_PROBE_PHASE (-1)
#define MK_PROBE_REPS 0
#endif
#ifndef MK_PER_PHASE
#define MK_PER_PHASE 0
#endif
extern "C" void kernel_launch(void* const* d_in, const int* in_sizes, int n_in, void* d_out, int out_size, void* d_ws, size_t ws_size, hipStream_t stream) {
    static int grid = 0;
    if (grid == 0) {
        if (n_in != 26 || ws_size < WS_END || out_size != T_TOK * DM) { fprintf(stderr, "kernel_launch: unexpected n_in %d / out %d / ws %zu\n", n_in, out_size, ws_size); grid = -1; return; }
        int dev = 0, cus = 0, per_cu = 0;
        if (hipGetDevice(&dev) != hipSuccess || hipDeviceGetAttribute(&cus, hipDeviceAttributeMultiprocessorCount, dev) != hipSuccess) { grid = -1; return; }
        if (hipFuncSetAttribute((const void*)mega_fwd, hipFuncAttributeMaxDynamicSharedMemorySize, LDS_BYTES) != hipSuccess) { fprintf(stderr, "kernel_launch: hipFuncSetAttribute failed\n"); grid = -1; return; }
        if (hipOccupancyMaxActiveBlocksPerMultiprocessor(&per_cu, (const void*)mega_fwd, 512, LDS_BYTES) != hipSuccess || per_cu < 1) { fprintf(stderr, "kernel_launch: occupancy query says %d\n", per_cu); per_cu = 1; }
        (void)hipGetLastError();
        grid = cus;
    }
    if (grid < 0) return;
    (void)hipMemsetAsync((char*)d_ws + WS_CTL, 0, CTL_ZERO_BYTES, stream);
    MegaArgs a{};
    for (int i = 0; i < 26; ++i) a.in[i] = (const float*)d_in[i];
    a.out = (float*)d_out; a.ws = (unsigned char*)d_ws;
    for (int jx = 0; jx < 8; ++jx) a.inv[jx] = pow(500000.0, -(double)(2 * jx) / 16.0);
#if MK_PER_PHASE
    a.probe_phase = MK_PROBE_PHASE; a.probe_reps = MK_PROBE_REPS;
    for (int ph = 0; ph < N_PHASES; ++ph) { a.ph_lo = ph; a.ph_hi = ph + 1; hipLaunchKernelGGL(mega_fwd, dim3(grid), dim3(512), LDS_BYTES, stream, a); }
#else
    a.ph_lo = 0; a.ph_hi = N_PHASES; a.probe_phase = MK_PROBE_PHASE; a.probe_reps = MK_PROBE_REPS;
    hipLaunchKernelGGL(mega_fwd, dim3(grid), dim3(512), LDS_BYTES, stream, a);
#endif
}
```

```cpp
#include <hip/hip_runtime.h>
#include <cstdio>
#include <cstdint>
#include <cmath>
namespace pg8 {
#define PG8_LAS __attribute__((address_space(3)))
typedef unsigned short bf16_t;
typedef short bf16x8 __attribute__((ext_vector_type(8)));
typedef float f32x4 __attribute__((ext_vector_type(4)));
typedef unsigned u32x4 __attribute__((ext_vector_type(4)));
constexpr int BM = 256, BK = 64, HALF = 128, HTB = HALF * BK * 2  , STAGE_BYTES = 8 * HTB, NXCD = 8, WGM = 8;

__host__ __device__ __forceinline__ int lds_byte(int r, int c) { const int st = (r >> 4) * 2 + (c >> 5), rr = r & 15, cc = c & 31, ob = rr * 64 + cc * 2; return st * 1024 + (ob ^ (((ob >> 9) & 1) << 5)); }
__host__ __device__ __forceinline__ void stage_rc(int b, int& R, int& C) { const int st = b / 1024, sb = b % 1024, swz = sb ^ (((sb >> 9) & 1) << 5); R = (st >> 1) * 16 + swz / 64; C = (st & 1) * 32 + (swz % 64) / 2; }
__host__ __device__ __forceinline__ int perm32(int rho) { const int n = rho >> 4, i = rho & 15; return 8 * (i >> 2) + 4 * n + (i & 3); }

struct Unit { int pm, pn, brow; };
struct Gemm { const bf16_t* A; const bf16_t* Bt; int M, N, K, pad; };

struct StaticOrder {
    static constexpr bool GATHER = false;
    int nM, nN, nwg, G, c;
    __host__ __device__ void init(int M, int N, int G_, int c_) { nM = M / BM; nN = N / BM; nwg = nM * nN; G = G_; c = c_; }
    __host__ __device__ bool next(int i, Unit& u) const {
        const long L = (long)i * G + c; if (L >= nwg) return false;
        int wgid = (int)L; { const int q = nwg / NXCD, r = nwg % NXCD, xcd = wgid % NXCD, off = wgid / NXCD; wgid = (xcd < r ? xcd * (q + 1) : r * (q + 1) + (xcd - r) * q) + off; }
        const int nig = WGM * nN, gid = wgid / nig, fm = gid * WGM, gsz = (nM - fm) < WGM ? (nM - fm) : WGM;
        u.pm = fm + ((wgid % nig) % gsz); u.pn = (wgid % nig) / gsz; u.brow = 0; return true;
    }
    __device__ __forceinline__ void a_ready(const Unit&) const {}
    __device__ __forceinline__ void done(const Unit&) const {}
};

__device__ __forceinline__ unsigned cvt_pk_bf16(float lo, float hi) { unsigned r; asm volatile("v_cvt_pk_bf16_f32 %0, %1, %2" : "=v"(r) : "v"(lo), "v"(hi)); return r; }
template <class Epi, class Sched, bool ALIGN_EPI = false, bool SP2 = false>
__device__ __forceinline__ void gemm_phase(PG8_LAS unsigned char* lds, const Gemm g, const Sched& S, const Epi& E) {
    int tid_l = threadIdx.x; asm volatile("" : "+v"(tid_l));
    const int tid = tid_l, wid = __builtin_amdgcn_readfirstlane(tid >> 6), lane = tid & 63, wr = wid >> 2, wc = wid & 3, fr = lane & 15, fq = lane >> 4;
    const int K = g.K, nt = K / BK;
    unsigned voffA[2], voffB[2];
    unsigned gc0[2], gc1[2], gn0[2], gn1[2];
    int gR[2], gC[2];
#pragma unroll
    for (int i = 0; i < 2; ++i) { int R, C; stage_rc(tid * 16 + i * 8192, R, C); const int Rb = Epi::PERM ? ((R & ~31) + perm32(R & 31)) : R;
        voffA[i] = (unsigned)(R * K + C) * 2u; voffB[i] = (unsigned)(Rb * K + C) * 2u; gR[i] = R; gC[i] = C; }
#define PG8_GOFF(u_, o0_, o1_) do { _Pragma("unroll") for (int _i = 0; _i < 2; ++_i) { int r0_ = S.rows[(u_).pm * BM + gR[_i]], r1_ = S.rows[(u_).pm * BM + HALF + gR[_i]]; r0_ = r0_ < 0 ? 0 : r0_; r1_ = r1_ < 0 ? 0 : r1_; \
        (o0_)[_i] = (unsigned)(r0_ * K + gC[_i]) * 2u; (o1_)[_i] = (unsigned)(r1_ * K + gC[_i]) * 2u; } } while (0)
    const size_t kstep = (size_t)(BK * 2);
    const size_t hstep = (size_t)HALF * K * 2;
    const size_t tstep = 2 * hstep;
    const unsigned ldsw = (unsigned)wid * 1024u;
    const int aoff = lds_byte(wr * 64 + fr, fq * 8), boff = lds_byte(wc * 32 + fr, fq * 8);
#define PG8_SA(b, h) (((b) * 2 + (h)) * HTB)
#define PG8_SB(b, h) ((4 + (b) * 2 + (h)) * HTB)
#define PG8_STAGE(bufoff, gbase, voff) do { _Pragma("unroll") for (int _i = 0; _i < 2; ++_i) \
        __builtin_amdgcn_global_load_lds((const unsigned*)((const char*)(gbase) + (voff)[_i]), (PG8_LAS unsigned*)(lds + (bufoff) + ldsw + _i * 8192), 16, 0, 0); } while (0)
#define PG8_LDA(dst, b, h) do { _Pragma("unroll") for (int m = 0; m < 4; ++m) _Pragma("unroll") for (int k = 0; k < 2; ++k) dst[m][k] = *(const PG8_LAS bf16x8*)(lds + PG8_SA(b, h) + aoff + m * 2048 + k * 1024); } while (0)
#define PG8_LDB(dst, b, h) do { _Pragma("unroll") for (int n = 0; n < 2; ++n) _Pragma("unroll") for (int k = 0; k < 2; ++k) dst[n][k] = *(const PG8_LAS bf16x8*)(lds + PG8_SB(b, h) + boff + n * 2048 + k * 1024); } while (0)
#define PG8_MMA(ai, bj, At, Bt) do { __builtin_amdgcn_s_setprio(1); _Pragma("unroll") for (int m = 0; m < 4; ++m) _Pragma("unroll") for (int n = 0; n < 2; ++n) _Pragma("unroll") for (int k = 0; k < 2; ++k) \
        acc[ai][bj][m][n] = __builtin_amdgcn_mfma_f32_16x16x32_bf16(Bt[n][k], At[m][k], acc[ai][bj][m][n], 0, 0, 0); __builtin_amdgcn_s_setprio(0); } while (0)
#define PG8_WAIT_V(n) asm volatile("s_waitcnt vmcnt(" #n ")" ::: "memory")
#define PG8_WAIT_L(n) asm volatile("s_waitcnt lgkmcnt(" #n ")" ::: "memory")
#define PG8_BAR __builtin_amdgcn_s_barrier()
#define PG8_SCHED __builtin_amdgcn_sched_barrier(0)
    Unit cur, nxt; int ui = 0;
    if (!S.next(0, cur)) return;
    f32x4 acc[2][2][4][2];
#pragma unroll
    for (int a = 0; a < 2; ++a)
#pragma unroll
        for (int b = 0; b < 2; ++b)
#pragma unroll
            for (int m = 0; m < 4; ++m)
#pragma unroll
                for (int n = 0; n < 2; ++n) acc[a][b][m][n] = (f32x4){0.f, 0.f, 0.f, 0.f};
    bf16x8 At[4][2], B0[2][2], B1[2][2];
    const char* cA = (const char*)g.A + (size_t)cur.pm * tstep; const char* cB = (const char*)g.Bt + (size_t)(cur.brow + cur.pn) * tstep;
    S.a_ready(cur);
    if constexpr (SP2) {
        if constexpr (Sched::GATHER) { PG8_GOFF(cur, gc0, gc1); }
        PG8_STAGE(PG8_SB(0, 0), cB, voffB); PG8_STAGE(PG8_SB(0, 1), cB + hstep, voffB);
        if constexpr (Sched::GATHER) { PG8_STAGE(PG8_SA(0, 0), (const char*)g.A, gc0); PG8_STAGE(PG8_SA(0, 1), (const char*)g.A, gc1); }
        else { PG8_STAGE(PG8_SA(0, 0), cA, voffA); PG8_STAGE(PG8_SA(0, 1), cA + hstep, voffA); }
        if (wr == 1) PG8_BAR;
        PG8_WAIT_V(2); PG8_BAR;
        PG8_STAGE(PG8_SB(1, 0), cB + kstep, voffB);
        if constexpr (Sched::GATHER) { PG8_STAGE(PG8_SA(1, 0), (const char*)g.A + kstep, gc0); } else { PG8_STAGE(PG8_SA(1, 0), cA + kstep, voffA); }
        PG8_STAGE(PG8_SB(1, 1), cB + hstep + kstep, voffB);
        PG8_WAIT_V(6); PG8_BAR;
    } else {
        PG8_STAGE(PG8_SB(0, 0), cB, voffB); PG8_STAGE(PG8_SA(0, 0), cA, voffA); PG8_STAGE(PG8_SB(0, 1), cB + hstep, voffB); PG8_STAGE(PG8_SA(0, 1), cA + hstep, voffA);
        if (wr == 1) PG8_BAR;
        PG8_WAIT_V(4); PG8_BAR;
        PG8_STAGE(PG8_SB(1, 0), cB + kstep, voffB); PG8_STAGE(PG8_SA(1, 0), cA + kstep, voffA); PG8_STAGE(PG8_SB(1, 1), cB + hstep + kstep, voffB);
        PG8_WAIT_V(6); PG8_BAR;
    }
    for (;;) {
        const bool has_next = S.next(ui + 1, nxt);
        if constexpr (Sched::GATHER) { if (has_next) { PG8_GOFF(nxt, gn0, gn1); } else { gn0[0] = gc0[0]; gn0[1] = gc0[1]; gn1[0] = gc1[0]; gn1[1] = gc1[1]; } }
        const char* nA = has_next ? (const char*)g.A + (size_t)nxt.pm * tstep : cA; const char* nB = has_next ? (const char*)g.Bt + (size_t)(nxt.brow + nxt.pn) * tstep : cB;
        for (int t = 0; t < nt; t += 2) {
            const bool last = (t == nt - 2);
            const char* a1 = cA + (size_t)(t + 1) * kstep;
            const char* a2 = last ? nA : cA + (size_t)(t + 2) * kstep; const char* b2 = last ? nB : cB + (size_t)(t + 2) * kstep;
            const char* a3 = a2 + kstep; const char* b3 = b2 + kstep;
            const char* ga1 = (const char*)g.A + (size_t)(t + 1) * kstep; const char* ga2 = (const char*)g.A + (last ? (size_t)0 : (size_t)(t + 2) * kstep); const char* ga3 = ga2 + kstep;
            unsigned s0[2], s1[2];
            if constexpr (Sched::GATHER) { s0[0] = last ? gn0[0] : gc0[0]; s0[1] = last ? gn0[1] : gc0[1]; s1[0] = last ? gn1[0] : gc1[0]; s1[1] = last ? gn1[1] : gc1[1]; }
            if (last && has_next) S.a_ready(nxt);
            if constexpr (SP2) {
            PG8_LDB(B0, 0, 0); PG8_LDB(B1, 0, 1); PG8_SCHED; PG8_LDA(At, 0, 0); if constexpr (Sched::GATHER) { PG8_STAGE(PG8_SA(1, 1), ga1, gc1); } else { PG8_STAGE(PG8_SA(1, 1), a1 + hstep, voffA); }
            PG8_WAIT_V(8); PG8_WAIT_L(0); PG8_BAR; PG8_MMA(0, 0, At, B0); PG8_MMA(0, 1, At, B1); PG8_BAR; PG8_SCHED;
            PG8_LDA(At, 0, 1); PG8_STAGE(PG8_SB(0, 0), b2, voffB); PG8_STAGE(PG8_SB(0, 1), b2 + hstep, voffB); if constexpr (Sched::GATHER) { PG8_STAGE(PG8_SA(0, 0), ga2, s0); } else { PG8_STAGE(PG8_SA(0, 0), a2, voffA); }
            PG8_WAIT_V(8); PG8_WAIT_L(0); PG8_BAR; PG8_MMA(1, 0, At, B0); PG8_MMA(1, 1, At, B1); PG8_BAR; PG8_SCHED;
            PG8_LDB(B0, 1, 0); PG8_LDB(B1, 1, 1); PG8_SCHED; PG8_LDA(At, 1, 0); if constexpr (Sched::GATHER) { PG8_STAGE(PG8_SA(0, 1), ga2, s1); } else { PG8_STAGE(PG8_SA(0, 1), a2 + hstep, voffA); }
            PG8_WAIT_V(8); PG8_WAIT_L(0); PG8_BAR; PG8_MMA(0, 0, At, B0); PG8_MMA(0, 1, At, B1); PG8_BAR; PG8_SCHED;
            PG8_LDA(At, 1, 1); PG8_STAGE(PG8_SB(1, 0), b3, voffB); PG8_STAGE(PG8_SB(1, 1), b3 + hstep, voffB); if constexpr (Sched::GATHER) { PG8_STAGE(PG8_SA(1, 0), ga3, s0); } else { PG8_STAGE(PG8_SA(1, 0), a3, voffA); }
            PG8_WAIT_V(8); PG8_WAIT_L(0); PG8_BAR; PG8_MMA(1, 0, At, B0); PG8_MMA(1, 1, At, B1); PG8_BAR; PG8_SCHED;
            } else {
            PG8_LDB(B0, 0, 0); PG8_SCHED; PG8_LDA(At, 0, 0); PG8_STAGE(PG8_SA(1, 1), a1 + hstep, voffA);
            PG8_WAIT_L(8); PG8_BAR; PG8_WAIT_L(0); PG8_MMA(0, 0, At, B0); PG8_BAR; PG8_SCHED;
            PG8_LDB(B1, 0, 1); PG8_STAGE(PG8_SB(0, 0), b2, voffB);
            PG8_BAR; PG8_WAIT_L(0); PG8_MMA(0, 1, At, B1); PG8_BAR;
            PG8_LDA(At, 0, 1); PG8_STAGE(PG8_SA(0, 0), a2, voffA);
            PG8_BAR; PG8_WAIT_L(0); PG8_MMA(1, 0, At, B0); PG8_BAR; PG8_SCHED;
            PG8_STAGE(PG8_SB(0, 1), b2 + hstep, voffB);
            PG8_WAIT_V(6); PG8_BAR; PG8_MMA(1, 1, At, B1); PG8_BAR;
            PG8_LDB(B0, 1, 0); PG8_SCHED; PG8_LDA(At, 1, 0); PG8_STAGE(PG8_SA(0, 1), a2 + hstep, voffA);
            PG8_WAIT_L(8); PG8_BAR; PG8_WAIT_L(0); PG8_MMA(0, 0, At, B0); PG8_BAR; PG8_SCHED;
            PG8_LDB(B1, 1, 1); PG8_STAGE(PG8_SB(1, 0), b3, voffB);
            PG8_BAR; PG8_WAIT_L(0); PG8_MMA(0, 1, At, B1); PG8_BAR;
            PG8_LDA(At, 1, 1); PG8_STAGE(PG8_SA(1, 0), a3, voffA);
            PG8_BAR; PG8_WAIT_L(0); PG8_MMA(1, 0, At, B0); PG8_BAR; PG8_SCHED;
            PG8_STAGE(PG8_SB(1, 1), b3 + hstep, voffB);
            PG8_WAIT_V(6); PG8_BAR; PG8_MMA(1, 1, At, B1); PG8_BAR;
            }
        }
        if constexpr (ALIGN_EPI) { if (wr == 0) PG8_BAR; }
        if constexpr (!Epi::AFTER_DRAIN) { E(acc, cur, wr, wc, fr, fq); S.done(cur); }
        if (!has_next) break;
#pragma unroll
        for (int a = 0; a < 2; ++a)
#pragma unroll
            for (int b = 0; b < 2; ++b)
#pragma unroll
                for (int m = 0; m < 4; ++m)
#pragma unroll
                    for (int n = 0; n < 2; ++n) acc[a][b][m][n] = (f32x4){0.f, 0.f, 0.f, 0.f};
        cur = nxt; cA = nA; cB = nB; ++ui;
        if constexpr (Sched::GATHER) { gc0[0] = gn0[0]; gc0[1] = gn0[1]; gc1[0] = gn1[0]; gc1[1] = gn1[1]; }
        if constexpr (ALIGN_EPI) { if (wr == 1) PG8_BAR; }
    }
    PG8_WAIT_V(0);
    if constexpr (!ALIGN_EPI) { if (wr == 0) PG8_BAR; }
    PG8_BAR;
    if constexpr (Epi::AFTER_DRAIN) { E.fused(acc, cur, wr, wc, fr, fq, lds, wid, lane); S.done(cur); }
#undef PG8_GOFF
#undef PG8_SA
#undef PG8_SB
#undef PG8_STAGE
#undef PG8_LDA
#undef PG8_LDB
#undef PG8_MMA
#undef PG8_WAIT_V
#undef PG8_WAIT_L
#undef PG8_BAR
#undef PG8_SCHED
}
}

using pg8::bf16_t; using pg8::f32x4; using pg8::u32x4; using pg8::Unit;
constexpr int T_TOK = 32768, DM = 1024, SEQ = 2048, NBATCH = 16, MEML = 256, TMEM = 4096, SPAD = 81920;
constexpr float EPS = 1e-6f;
constexpr float LOG2E = 1.4426950408889634f;
constexpr size_t MiB = 1u << 20;
constexpr size_t WS_CTL = 0, CTL_ZERO_BYTES = 64 * 1024;
constexpr size_t WS_ROPEC = 1 * MiB, WS_ROPES = 1 * MiB + 64 * 1024, WS_WR = 1 * MiB + 128 * 1024  , WS_LAM = 1 * MiB + 512 * 1024;
constexpr size_t WS_SSQ = 2 * MiB, WS_SSQM = 4 * MiB;
constexpr size_t WS_TOKSLOT = 5 * MiB, WS_WSLOT = 5 * MiB + 512 * 1024, WS_RSSLOT = 6 * MiB;
constexpr size_t WS_ROUTE_E = 7 * MiB, WS_ROUTE_W = 7 * MiB + 512 * 1024, WS_RSTOK = 8 * MiB;
constexpr size_t WS_MEMB = 10 * MiB, WS_MKV = 18 * MiB;
constexpr size_t WS_WMEM = 26 * MiB, WS_WIN = 28 * MiB, WS_WOUT0 = 34 * MiB, WS_WQKV = 36 * MiB, WS_WOUT1 = 39 * MiB, WS_WQ = 41 * MiB, WS_WO = 43 * MiB,
                 WS_WGU = 45 * MiB, WS_WDN = 173 * MiB;
constexpr size_t WS_XA = 240 * MiB, WS_XBF = 368 * MiB, WS_Y = 432 * MiB, WS_QX = 496 * MiB, WS_OX = 528 * MiB, WS_U1 = 560 * MiB, WS_U2 = 752 * MiB, WS_END = 880 * MiB;
constexpr int CI_CNT = 0, CI_CUR = 64, CI_LBASE = 128, CI_NT = 192, CI_TEXP = 256, CI_STRIDE = 1024;

__device__ __forceinline__ unsigned f2bf(float f) { unsigned u = __builtin_bit_cast(unsigned, f); return (u + 0x7fffu + ((u >> 16) & 1u)) >> 16; }
typedef float f32x2_hw __attribute__((ext_vector_type(2))); typedef __bf16 bf16x2_hw __attribute__((ext_vector_type(2)));
__device__ __forceinline__ unsigned pk2(float lo, float hi) { f32x2_hw v = {lo, hi}; bf16x2_hw b = __builtin_convertvector(v, bf16x2_hw); return __builtin_bit_cast(unsigned, b); }
__device__ __forceinline__ float bflo(unsigned w) { return __builtin_bit_cast(float, w << 16); }
__device__ __forceinline__ float bfhi(unsigned w) { return __builtin_bit_cast(float, w & 0xffff0000u); }
__device__ __forceinline__ float bf2f(bf16_t h) { return __builtin_bit_cast(float, (unsigned)h << 16); }
__device__ __forceinline__ float wave_sum(float v) {
#pragma unroll
    for (int o = 1; o < 64; o <<= 1) v += __shfl_xor(v, o);
    return v;
}
__device__ __forceinline__ float row_rs(const float* ssq, int row) {
    const f32x4* p = (const f32x4*)(ssq + (size_t)row * 16);
    const f32x4 a = p[0], b = p[1], c = p[2], d = p[3];
    const float s = (((a.x + a.y) + (a.z + a.w)) + ((b.x + b.y) + (b.z + b.w))) + (((c.x + c.y) + (c.z + c.w)) + ((d.x + d.y) + (d.z + d.w)));
    return 1.0f / sqrtf(s * (1.0f / 1024.0f) + EPS);
}

struct EpiProj {
    static constexpr bool PERM = true, AFTER_DRAIN = false;
    bf16_t* O; const float* ssq; const float* bias; const float* ropeC; const float* ropeS; int ldc, rope_lo, rope_hi, pad;
    __device__ __forceinline__ void operator()(f32x4 (&acc)[2][2][4][2], const Unit& u, int wr, int wc, int fr, int fq) const {
        const int colw = u.pn * 256 + wc * 32 + 8 * fq;
        const bool rope_tile = (u.pn * 256 < rope_hi) && (u.pn * 256 + 256 > rope_lo);
#pragma unroll
        for (int ai = 0; ai < 2; ++ai) {
            const int row0 = u.pm * 256 + ai * 128 + wr * 64 + fr;
            float rsv[4];
#pragma unroll
            for (int m = 0; m < 4; ++m) rsv[m] = row_rs(ssq, row0 + m * 16);
#pragma unroll
            for (int bj = 0; bj < 2; ++bj) {
                f32x4 b0 = (f32x4){0.f, 0.f, 0.f, 0.f}, b1 = b0;
                if (bias) { b0 = *(const f32x4*)(bias + colw + bj * 128); b1 = *(const f32x4*)(bias + colw + bj * 128 + 4); }
#pragma unroll
                for (int m = 0; m < 4; ++m) { acc[ai][bj][m][0] = acc[ai][bj][m][0] * rsv[m] + b0; acc[ai][bj][m][1] = acc[ai][bj][m][1] * rsv[m] + b1; }
            }
            if (rope_tile) {
#pragma unroll
                for (int m = 0; m < 4; ++m) {
                    const int pos = (row0 + m * 16) & (SEQ - 1);
                    const f32x4 c0 = *(const f32x4*)(ropeC + pos * 8), c1 = *(const f32x4*)(ropeC + pos * 8 + 4);
                    const f32x4 s0 = *(const f32x4*)(ropeS + pos * 8), s1 = *(const f32x4*)(ropeS + pos * 8 + 4);
#pragma unroll
                    for (int bj = 0; bj < 2; ++bj) {
                        const int col = colw + bj * 128;
                        f32x4 p0, p1;
#pragma unroll
                        for (int i = 0; i < 4; ++i) { p0[i] = __shfl_xor(acc[ai][bj][m][0][i], 16); p1[i] = __shfl_xor(acc[ai][bj][m][1][i], 16); }
                        if (col >= rope_lo && col < rope_hi && (col & 63) < 16) {
                            const float sg = (col & 8) ? 1.0f : -1.0f;
                            acc[ai][bj][m][0] = acc[ai][bj][m][0] * c0 + p0 * s0 * sg; acc[ai][bj][m][1] = acc[ai][bj][m][1] * c1 + p1 * s1 * sg;
                        }
                    }
                }
            }
#pragma unroll
            for (int m = 0; m < 4; ++m)
#pragma unroll
                for (int bj = 0; bj < 2; ++bj) { const f32x4 v0 = acc[ai][bj][m][0], v1 = acc[ai][bj][m][1];
                    u32x4 w; w.x = pk2(v0[0], v0[1]); w.y = pk2(v0[2], v0[3]); w.z = pk2(v1[0], v1[1]); w.w = pk2(v1[2], v1[3]);
                    *(u32x4*)(O + (size_t)(row0 + m * 16) * ldc + colw + bj * 128) = w; }
        }
    }
};
struct EpiResid {
    static constexpr bool PERM = true, AFTER_DRAIN = false;
    const bf16_t* xin; bf16_t* xout; float* ssq; const float* bias;
    __device__ __forceinline__ void operator()(f32x4 (&acc)[2][2][4][2], const Unit& u, int wr, int wc, int fr, int fq) const {
        const int colw = u.pn * 256 + wc * 32 + 8 * fq;
#pragma unroll
        for (int ai = 0; ai < 2; ++ai) {
            const int row0 = u.pm * 256 + ai * 128 + wr * 64 + fr;
            float ssv[4]; u32x4 wv[4][2];
#pragma unroll
            for (int m = 0; m < 4; ++m)
#pragma unroll
                for (int bj = 0; bj < 2; ++bj) wv[m][bj] = *(const u32x4*)(xin + (size_t)(row0 + m * 16) * DM + colw + bj * 128);
#pragma unroll
            for (int m = 0; m < 4; ++m) {
                float ss = 0.f;
#pragma unroll
                for (int bj = 0; bj < 2; ++bj) {
                    const u32x4 xi = wv[m][bj];
                    f32x4 x0 = (f32x4){bflo(xi.x), bfhi(xi.x), bflo(xi.y), bfhi(xi.y)} + acc[ai][bj][m][0], x1 = (f32x4){bflo(xi.z), bfhi(xi.z), bflo(xi.w), bfhi(xi.w)} + acc[ai][bj][m][1];
                    if (bias) { x0 += *(const f32x4*)(bias + colw + bj * 128); x1 += *(const f32x4*)(bias + colw + bj * 128 + 4); }
                    u32x4 w; w.x = pk2(x0[0], x0[1]); w.y = pk2(x0[2], x0[3]); w.z = pk2(x1[0], x1[1]); w.w = pk2(x1[2], x1[3]);
                    wv[m][bj] = w;
                    const float r0 = bflo(w.x), r1 = bfhi(w.x), r2 = bflo(w.y), r3 = bfhi(w.y), r4 = bflo(w.z), r5 = bfhi(w.z), r6 = bflo(w.w), r7 = bfhi(w.w);
                    ss += (r0 * r0 + r1 * r1) + (r2 * r2 + r3 * r3) + (r4 * r4 + r5 * r5) + (r6 * r6 + r7 * r7);
                }
                ss += __shfl_xor(ss, 16); ss += __shfl_xor(ss, 32); ssv[m] = ss;
            }
#pragma unroll
            for (int m = 0; m < 4; ++m) {
                const int row = row0 + m * 16;
#pragma unroll
                for (int bj = 0; bj < 2; ++bj) *(u32x4*)(xout + (size_t)row * DM + colw + bj * 128) = wv[m][bj];
                if (fq == 0) ssq[(size_t)row * 16 + u.pn * 4 + wc] = ssv[m];
            }
        }
    }
};
struct EpiGateUp {
    static constexpr bool PERM = true, AFTER_DRAIN = false;
    bf16_t* hid; const float* rs_slot;
    __device__ __forceinline__ void operator()(f32x4 (&acc)[2][2][4][2], const Unit& u, int wr, int wc, int fr, int fq) const {
        const int row0 = u.pm * 256 + wr * 64 + fr;
        float rsv[2][4];
#pragma unroll
        for (int ai = 0; ai < 2; ++ai)
#pragma unroll
            for (int m = 0; m < 4; ++m) rsv[ai][m] = rs_slot[row0 + ai * 128 + m * 16];
#pragma unroll
        for (int ai = 0; ai < 2; ++ai)
#pragma unroll
            for (int m = 0; m < 4; ++m) {
                const int row = row0 + ai * 128 + m * 16;
                const float rs = rsv[ai][m];
                float h[8];
#pragma unroll
                for (int i = 0; i < 8; ++i) { const float g = acc[ai][0][m][i >> 2][i & 3] * rs, up = acc[ai][1][m][i >> 2][i & 3] * rs; h[i] = g / (1.0f + __expf(-g)) * up; }
                u32x4 w; w.x = pk2(h[0], h[1]); w.y = pk2(h[2], h[3]); w.z = pk2(h[4], h[5]); w.w = pk2(h[6], h[7]);
                *(u32x4*)(hid + (size_t)row * 512 + u.pn * 128 + wc * 32 + 8 * fq) = w;
            }
    }
};
struct EpiDown {
    static constexpr bool PERM = true, AFTER_DRAIN = false;
    const bf16_t* xin; bf16_t* xout; float* ssq; const int* tok_of_slot; const float* w_of_slot; int last, pad;
    __device__ __forceinline__ void operator()(f32x4 (&acc)[2][2][4][2], const Unit& u, int wr, int wc, int fr, int fq) const {
        const int colw = u.pn * 256 + wc * 32 + 8 * fq;
        int tokv[2][4]; float wtv[2][4];
#pragma unroll
        for (int ai = 0; ai < 2; ++ai)
#pragma unroll
            for (int m = 0; m < 4; ++m) { const int slot = u.pm * 256 + ai * 128 + wr * 64 + fr + m * 16; tokv[ai][m] = tok_of_slot[slot]; wtv[ai][m] = w_of_slot[slot]; }
#pragma unroll
        for (int ai = 0; ai < 2; ++ai) {
            float ssv[4]; u32x4 wv[4][2];
#pragma unroll
            for (int m = 0; m < 4; ++m)
#pragma unroll
                for (int bj = 0; bj < 2; ++bj) wv[m][bj] = *(const u32x4*)(xin + (size_t)(tokv[ai][m] < 0 ? 0 : tokv[ai][m]) * DM + colw + bj * 128);
#pragma unroll
            for (int m = 0; m < 4; ++m) {
                const float wt = wtv[ai][m];
                float ss = 0.f;
#pragma unroll
                for (int bj = 0; bj < 2; ++bj) {
                    const u32x4 xi = wv[m][bj];
                    const f32x4 x0 = (f32x4){bflo(xi.x), bfhi(xi.x), bflo(xi.y), bfhi(xi.y)} + acc[ai][bj][m][0] * wt, x1 = (f32x4){bflo(xi.z), bfhi(xi.z), bflo(xi.w), bfhi(xi.w)} + acc[ai][bj][m][1] * wt;
                    u32x4 w; w.x = pk2(x0[0], x0[1]); w.y = pk2(x0[2], x0[3]); w.z = pk2(x1[0], x1[1]); w.w = pk2(x1[2], x1[3]);
                    wv[m][bj] = w;
                    const float r0 = bflo(w.x), r1 = bfhi(w.x), r2 = bflo(w.y), r3 = bfhi(w.y), r4 = bflo(w.z), r5 = bfhi(w.z), r6 = bflo(w.w), r7 = bfhi(w.w);
                    ss += (r0 * r0 + r1 * r1) + (r2 * r2 + r3 * r3) + (r4 * r4 + r5 * r5) + (r6 * r6 + r7 * r7);
                }
                ss += __shfl_xor(ss, 16); ss += __shfl_xor(ss, 32); ssv[m] = ss;
            }
#pragma unroll
            for (int m = 0; m < 4; ++m) {
                const int tok = tokv[ai][m];
                if (tok >= 0) {
#pragma unroll
                    for (int bj = 0; bj < 2; ++bj) *(u32x4*)(xout + (size_t)tok * DM + colw + bj * 128) = wv[m][bj];
                    if (last && fq == 0) ssq[(size_t)tok * 16 + u.pn * 4 + wc] = ssv[m];
                }
            }
        }
    }
};

template <bool GATHER_>
struct GroupedOrderT {
    static constexpr bool GATHER = GATHER_;
    const int* tile_expert; const int* rows; int t_lo, t_hi, nN, G, c, tiles_per_expert;
    __device__ __forceinline__ bool next(int i, Unit& u) const {
        const long L = (long)i * G + c; const long n = (long)(t_hi - t_lo) * nN; if (L >= n) return false;
        u.pm = t_lo + (int)(L / nN); u.pn = (int)(L % nN); u.brow = tile_expert[u.pm] * tiles_per_expert; return true;
    }
    __device__ __forceinline__ void a_ready(const Unit&) const {}
    __device__ __forceinline__ void done(const Unit&) const {}
};
typedef GroupedOrderT<false> GroupedOrder;
typedef GroupedOrderT<true> GroupedGather;

namespace att {
#define ATT_LAS __attribute__((address_space(3)))
#define ATT_DI __device__ __forceinline__
typedef short bf16x8 __attribute__((ext_vector_type(8)));
typedef short s16x4 __attribute__((ext_vector_type(4)));
typedef float f32x16 __attribute__((ext_vector_type(16)));
typedef short v4i16_t __attribute__((ext_vector_type(4)));
typedef float f32x2_t __attribute__((ext_vector_type(2)));
typedef __bf16 bf16x2_t __attribute__((ext_vector_type(2)));
ATT_DI int crow(int reg, int h) { return (reg & 3) + 8 * (reg >> 2) + 4 * h; }
ATT_DI unsigned cvtpk(float lo, float hi) { f32x2_t v = {lo, hi}; bf16x2_t b = __builtin_convertvector(v, bf16x2_t); return __builtin_bit_cast(unsigned, b); }
ATT_DI s16x4 vtr(const ATT_LAS char* p) { return __builtin_bit_cast(s16x4, __builtin_amdgcn_ds_read_tr16_b64_v4i16((ATT_LAS v4i16_t*)p)); }
ATT_DI bf16x8 pack8(const f32x16& x, int s) {
    u32x4 p; p.x = cvtpk(x[8 * s + 0], x[8 * s + 1]); p.y = cvtpk(x[8 * s + 2], x[8 * s + 3]); p.z = cvtpk(x[8 * s + 4], x[8 * s + 5]); p.w = cvtpk(x[8 * s + 6], x[8 * s + 7]);
    return __builtin_bit_cast(bf16x8, p);
}
struct L256 { static constexpr int PITCH = 256; static ATT_DI int addr(int row, int byte) { return row * 256 + ((((byte >> 4) ^ (row & 15)) << 4) | (byte & 15)); }
    static ATT_DI int vbase(int db, int h, int tq, int g1, int tp) { return (4 * h + tq) * 256 + ((((2 * g1 + (tp >> 1)) ^ (4 * h + tq)) ^ (4 * (db & 1))) << 4) + 8 * (tp & 1); }
    static constexpr int vimm(int kb, int s, int hi, int db) { return (32 * kb + 16 * s + 8 * hi) * 256 + 128 * ((db >> 1) ^ hi); } };
struct LV256 { static constexpr int PITCH = 256; static ATT_DI int addr(int row, int byte) { return row * 256 + (byte ^ ((row & 3) << 6)); }
    static ATT_DI int vbase(int db, int h, int tq, int g1, int tp) { return (4 * h + tq) * 256 + (((db & 3) ^ tq) << 6) + 32 * g1 + 8 * tp; }
    static constexpr int vimm(int kb, int s, int hi, int db) { return (32 * kb + 16 * s + 8 * hi) * 256; } };
struct LPAD { static constexpr int PITCH = 144; static ATT_DI int addr(int row, int byte) { return row * 144 + byte; }
    static ATT_DI int vbase(int db, int h, int tq, int g1, int tp) { return (4 * h + tq) * 144 + 32 * g1 + 8 * tp; }
    static constexpr int vimm(int kb, int s, int hi, int db) { return (32 * kb + 16 * s + 8 * hi) * 144 + 64 * db; } };

template <int NKS, int NDB, class KLay, class Lay, bool MASK>
ATT_DI void tile64(const ATT_LAS char* kt, const ATT_LAS char* vt, int kcb, int vcb, const bf16x8 (&qf)[NKS], float& m, float& l, f32x16 (&O)[NDB], float c,
                   int r, int h, int g1, int tq, int tp, int qpos, int kpos0, int win) {
    f32x16 p0, p1;
#pragma unroll
    for (int i = 0; i < 16; ++i) { p0[i] = 0.f; p1[i] = 0.f; }
#pragma unroll
    for (int s = 0; s < NKS; ++s) {
        const bf16x8 a0 = *(const ATT_LAS bf16x8*)(kt + KLay::addr(r, kcb + 32 * s + 16 * h));
        const bf16x8 a1 = *(const ATT_LAS bf16x8*)(kt + KLay::addr(32 + r, kcb + 32 * s + 16 * h));
        p0 = __builtin_amdgcn_mfma_f32_32x32x16_bf16(a0, qf[s], p0, 0, 0, 0);
        p1 = __builtin_amdgcn_mfma_f32_32x32x16_bf16(a1, qf[s], p1, 0, 0, 0);
    }
    if (MASK) {
#pragma unroll
        for (int i = 0; i < 16; ++i) {
            const int k0 = kpos0 + crow(i, h), k1 = k0 + 32;
            if (k0 > qpos || k0 <= qpos - win || k0 < 0) p0[i] = -INFINITY;
            if (k1 > qpos || k1 <= qpos - win || k1 < 0) p1[i] = -INFINITY;
        }
    }
    float mx = fmaxf(p0[0], p1[0]);
#pragma unroll
    for (int i = 1; i < 16; ++i) mx = fmaxf(mx, fmaxf(p0[i], p1[i]));
    mx = fmaxf(mx, __shfl_xor(mx, 32));
    const float mn = fmaxf(m, mx * c);
    const float ms = (mn == -INFINITY) ? 0.f : mn;
    const float corr = __builtin_amdgcn_exp2f(m - ms);
    m = mn;
    float ls = 0.f;
#pragma unroll
    for (int i = 0; i < 16; ++i) { p0[i] = __builtin_amdgcn_exp2f(fmaf(p0[i], c, -ms)); p1[i] = __builtin_amdgcn_exp2f(fmaf(p1[i], c, -ms)); ls += p0[i] + p1[i]; }
    l = l * corr + ls;
#pragma unroll
    for (int db = 0; db < NDB; ++db) O[db] = O[db] * corr;
    bf16x8 pf[4]; pf[0] = pack8(p0, 0); pf[1] = pack8(p0, 1); pf[2] = pack8(p1, 0); pf[3] = pack8(p1, 1);
    const unsigned vb_ = (unsigned)(uintptr_t)vt + (unsigned)vcb;
    unsigned va[NDB];
#pragma unroll
    for (int db = 0; db < NDB; ++db) va[db] = vb_ + (unsigned)Lay::vbase(db, h, tq, g1, tp);
#pragma unroll
    for (int db = 0; db < NDB; ++db) {
        s16x4 lo[4], hi[4];
#pragma unroll
        for (int ks = 0; ks < 4; ++ks) {
            asm volatile("ds_read_b64_tr_b16 %0, %1 offset:%c2" : "=&v"(lo[ks]) : "v"(va[db]), "i"(Lay::vimm(ks >> 1, ks & 1, 0, db)) : "memory");
            asm volatile("ds_read_b64_tr_b16 %0, %1 offset:%c2" : "=&v"(hi[ks]) : "v"(va[db]), "i"(Lay::vimm(ks >> 1, ks & 1, 1, db)) : "memory");
        }
        asm volatile("s_waitcnt lgkmcnt(0)" : "+v"(lo[0]), "+v"(lo[1]), "+v"(lo[2]), "+v"(lo[3]), "+v"(hi[0]), "+v"(hi[1]), "+v"(hi[2]), "+v"(hi[3]) :: "memory");
#pragma unroll
        for (int ks = 0; ks < 4; ++ks) {
            const bf16x8 av = __builtin_shufflevector(lo[ks], hi[ks], 0, 1, 2, 3, 4, 5, 6, 7);
            O[db] = __builtin_amdgcn_mfma_f32_32x32x16_bf16(av, pf[ks], O[db], 0, 0, 0);
        }
    }
}
template <int NKS, class KLay>
ATT_DI void st_qk(const ATT_LAS char* kt, int kcb, const bf16x8 (&qf)[NKS], f32x16& p0, f32x16& p1, int r, int h, bool domask, int qpos, int kpos0, int win) {
#pragma unroll
    for (int i = 0; i < 16; ++i) { p0[i] = 0.f; p1[i] = 0.f; }
#pragma unroll
    for (int s = 0; s < NKS; ++s) {
        const bf16x8 a0 = *(const ATT_LAS bf16x8*)(kt + KLay::addr(r, kcb + 32 * s + 16 * h));
        const bf16x8 a1 = *(const ATT_LAS bf16x8*)(kt + KLay::addr(32 + r, kcb + 32 * s + 16 * h));
        p0 = __builtin_amdgcn_mfma_f32_32x32x16_bf16(a0, qf[s], p0, 0, 0, 0);
        p1 = __builtin_amdgcn_mfma_f32_32x32x16_bf16(a1, qf[s], p1, 0, 0, 0);
    }
    if (domask) {
#pragma unroll
        for (int i = 0; i < 16; ++i) {
            const int k0 = kpos0 + crow(i, h), k1 = k0 + 32;
            if (k0 > qpos || k0 <= qpos - win || k0 < 0) p0[i] = -INFINITY;
            if (k1 > qpos || k1 <= qpos - win || k1 < 0) p1[i] = -INFINITY;
        }
    }
}
template <int NDB>
ATT_DI void st_soft(f32x16& p0, f32x16& p1, float& m, float& l, f32x16 (&O)[NDB], bf16x8 (&pf)[4], float c) {
    float mx = fmaxf(fmaxf(p0[0], p1[0]), fmaxf(p0[1], p1[1]));
#pragma unroll
    for (int i = 2; i < 16; i += 2) mx = fmaxf(mx, fmaxf(fmaxf(p0[i], p1[i]), fmaxf(p0[i + 1], p1[i + 1])));
    mx = fmaxf(mx, __shfl_xor(mx, 32));
    const float mc = mx * c;
    if (__any(mc > m + 6.0f)) {
        const float mn = fmaxf(m, mc);
        const float msafe = (mn == -INFINITY) ? 0.f : mn;
        const float corr = __builtin_amdgcn_exp2f(m - msafe);
        m = mn; l *= corr;
#pragma unroll
        for (int db = 0; db < NDB; ++db) O[db] = O[db] * corr;
    }
    const float ms = (m == -INFINITY) ? 0.f : m;
    float ls = 0.f;
#pragma unroll
    for (int i = 0; i < 16; ++i) { p0[i] = __builtin_amdgcn_exp2f(fmaf(p0[i], c, -ms)); p1[i] = __builtin_amdgcn_exp2f(fmaf(p1[i], c, -ms)); ls += p0[i] + p1[i]; }
    l += ls;
    pf[0] = pack8(p0, 0); pf[1] = pack8(p0, 1); pf[2] = pack8(p1, 0); pf[3] = pack8(p1, 1);
}
template <int NDB, class Lay>
ATT_DI void st_pv(const ATT_LAS char* vt, const bf16x8 (&pf)[4], f32x16 (&O)[NDB], int h, int g1, int tq, int tp) {
    const unsigned vb_ = (unsigned)(uintptr_t)vt;
    unsigned va[NDB];
#pragma unroll
    for (int db = 0; db < NDB; ++db) va[db] = vb_ + (unsigned)Lay::vbase(db, h, tq, g1, tp);
#pragma unroll
    for (int db = 0; db < NDB; ++db) {
        s16x4 lo[4], hi[4];
#pragma unroll
        for (int ks = 0; ks < 4; ++ks) {
            asm volatile("ds_read_b64_tr_b16 %0, %1 offset:%c2" : "=&v"(lo[ks]) : "v"(va[db]), "i"(Lay::vimm(ks >> 1, ks & 1, 0, db)) : "memory");
            asm volatile("ds_read_b64_tr_b16 %0, %1 offset:%c2" : "=&v"(hi[ks]) : "v"(va[db]), "i"(Lay::vimm(ks >> 1, ks & 1, 1, db)) : "memory");
        }
        asm volatile("s_waitcnt lgkmcnt(0)" : "+v"(lo[0]), "+v"(lo[1]), "+v"(lo[2]), "+v"(lo[3]), "+v"(hi[0]), "+v"(hi[1]), "+v"(hi[2]), "+v"(hi[3]) :: "memory");
#pragma unroll
        for (int ks = 0; ks < 4; ++ks) {
            const bf16x8 av = __builtin_shufflevector(lo[ks], hi[ks], 0, 1, 2, 3, 4, 5, 6, 7);
            O[db] = __builtin_amdgcn_mfma_f32_32x32x16_bf16(av, pf[ks], O[db], 0, 0, 0);
        }
    }
}
template <int NKS> ATT_DI void load_q(bf16x8 (&qf)[NKS], const bf16_t* qrow  , int h) {
#pragma unroll
    for (int s = 0; s < NKS; ++s) qf[s] = *(const bf16x8*)(qrow + 16 * s + 8 * h);
}
template <int NDB> ATT_DI void store_o(const f32x16 (&O)[NDB], float l, bf16_t* orow, int h) {
    const float il = 1.0f / (l + __shfl_xor(l, 32));
#pragma unroll
    for (int db = 0; db < NDB; ++db)
#pragma unroll
        for (int g = 0; g < 4; ++g) {
            const unsigned w0 = cvtpk(O[db][4 * g] * il, O[db][4 * g + 1] * il), w1 = cvtpk(O[db][4 * g + 2] * il, O[db][4 * g + 3] * il);
            *(unsigned long long*)(orow + db * 32 + 8 * g + 4 * h) = (unsigned long long)w0 | ((unsigned long long)w1 << 32);
        }
}

ATT_DI void xattn_unit(ATT_LAS char* lds, const bf16_t* QX, const bf16_t* MKV, bf16_t* OX, int unit) {
    int tid_l = threadIdx.x; asm volatile("" : "+v"(tid_l));
    const int tid = tid_l, lane = tid & 63, w = tid >> 6, r = lane & 31, h = lane >> 5, g1 = (lane >> 4) & 1, tq = (lane & 15) >> 2, tp = lane & 3;
    const int b = unit >> 4, hd = (unit >> 2) & 3, part = unit & 3;
    __syncthreads();
    for (int cidx = tid; cidx < 256 * 16; cidx += 512) { const int row = cidx >> 4, ch = cidx & 15;
        const bf16_t* src = MKV + (size_t)(b * MEML + row) * 1024 + hd * 128 + ch * 8;
        const u32x4 kv = *(const u32x4*)src, vv = *(const u32x4*)(src + 512);
        *(ATT_LAS u32x4*)(lds + L256::addr(row, ch * 16)) = kv; *(ATT_LAS u32x4*)(lds + 65536 + LV256::addr(row, ch * 16)) = vv; }
    __syncthreads();
    const float c = LOG2E * 0.08838834764831845f;
#pragma unroll 1
    for (int qb = 0; qb < 2; ++qb) {
        const size_t tok = (size_t)b * SEQ + part * 512 + qb * 256 + w * 32 + r;
        bf16x8 qf[8]; load_q<8>(qf, QX + tok * 512 + hd * 128, h);
        float m = -INFINITY, l = 0.f; f32x16 O[4];
#pragma unroll
        for (int db = 0; db < 4; ++db)
#pragma unroll
            for (int i = 0; i < 16; ++i) O[db][i] = 0.f;
#pragma unroll 1
        for (int kt = 0; kt < 4; ++kt)
            tile64<8, 4, L256, LV256, false>(lds + kt * 64 * 256, lds + 65536 + kt * 64 * 256, 0, 0, qf, m, l, O, c, r, h, g1, tq, tp, 0, 0, 0);
        store_o<4>(O, l, OX + tok * 512 + hd * 128, h);
    }
}
ATT_DI void swa_unit(ATT_LAS char* lds, const bf16_t* P  , const float* sinks, bf16_t* Y, int unit) {
    int tid_l = threadIdx.x; asm volatile("" : "+v"(tid_l));
    const int tid = tid_l, lane = tid & 63, w = tid >> 6, r = lane & 31, h = lane >> 5, g1 = (lane >> 4) & 1, tq = (lane & 15) >> 2, tp = lane & 3;
    const int b = unit >> 5, kvh = (unit >> 3) & 3, qb = unit & 7, q0 = qb * 256;
    constexpr int VOFF = 384 * 144;
    __syncthreads();
    for (int cidx = tid; cidx < 384 * 8; cidx += 512) { const int row = cidx >> 3, ch = cidx & 7; const int kpos = q0 - 128 + row;
        u32x4 kv = (u32x4){0u, 0u, 0u, 0u}, vv = kv;
        if (kpos >= 0) { const bf16_t* src = P + (size_t)(b * SEQ + kpos) * 1536 + 1024 + kvh * 64 + ch * 8; kv = *(const u32x4*)src; vv = *(const u32x4*)(src + 256); }
        *(ATT_LAS u32x4*)(lds + LPAD::addr(row, ch * 16)) = kv; *(ATT_LAS u32x4*)(lds + VOFF + LPAD::addr(row, ch * 16)) = vv; }
    __syncthreads();
    const float c = LOG2E * 0.125f;
    const int qpos = q0 + w * 32 + r; const size_t tok = (size_t)b * SEQ + qpos;
    const int t0 = (32 * w + 1) >> 6;
#pragma unroll 1
    for (int g = 0; g < 4; ++g) {
        const int hq = kvh * 4 + g;
        bf16x8 qf[4]; load_q<4>(qf, P + tok * 1536 + hq * 64, h);
        float m = sinks[hq] * LOG2E, l = (h == 0) ? 1.f : 0.f; f32x16 O[2];
#pragma unroll
        for (int db = 0; db < 2; ++db)
#pragma unroll
            for (int i = 0; i < 16; ++i) O[db][i] = 0.f;
#pragma unroll 1
        for (int t = t0; t < t0 + 3; ++t)
            tile64<4, 2, LPAD, LPAD, true>(lds + t * 64 * 144, lds + VOFF + t * 64 * 144, 0, 0, qf, m, l, O, c, r, h, g1, tq, tp, qpos, q0 - 128 + t * 64, 128);
        store_o<2>(O, l, Y + tok * 1024 + hq * 64, h);
    }
}
ATT_DI void dma16(const void* g, ATT_LAS char* l) { __builtin_amdgcn_global_load_lds((const unsigned*)g, (ATT_LAS unsigned*)l, 16, 0, 0); }
constexpr float RESCALE_THR = 6.0f;
template <int NKS, int NDB, class KLay, bool MASK>
ATT_DI void qk_soft(const ATT_LAS char* kt, int kcb, const bf16x8 (&qf)[NKS], float& m, float& l, f32x16 (&O)[NDB], bf16x8 (&pf)[4], float c, int r, int h, int qpos, int kpos0, int win) {
    f32x16 p0, p1;
#pragma unroll
    for (int i = 0; i < 16; ++i) { p0[i] = 0.f; p1[i] = 0.f; }
#pragma unroll
    for (int s = 0; s < NKS; ++s) {
        const bf16x8 a0 = *(const ATT_LAS bf16x8*)(kt + KLay::addr(r, kcb + 32 * s + 16 * h));
        const bf16x8 a1 = *(const ATT_LAS bf16x8*)(kt + KLay::addr(32 + r, kcb + 32 * s + 16 * h));
        p0 = __builtin_amdgcn_mfma_f32_32x32x16_bf16(a0, qf[s], p0, 0, 0, 0);
        p1 = __builtin_amdgcn_mfma_f32_32x32x16_bf16(a1, qf[s], p1, 0, 0, 0);
    }
    if (MASK) {
#pragma unroll
        for (int i = 0; i < 16; ++i) {
            const int k0 = kpos0 + crow(i, h), k1 = k0 + 32;
            if (k0 > qpos || k0 <= qpos - win || k0 < 0) p0[i] = -INFINITY;
            if (k1 > qpos || k1 <= qpos - win || k1 < 0) p1[i] = -INFINITY;
        }
    }
    float mx = fmaxf(p0[0], p1[0]);
#pragma unroll
    for (int i = 1; i < 16; ++i) mx = fmaxf(mx, fmaxf(p0[i], p1[i]));
    mx = fmaxf(mx, __shfl_xor(mx, 32));
    const float mc = mx * c;
    if (__any(mc > m + RESCALE_THR)) {
        const float mn = fmaxf(m, mc);
        const float ms = (mn == -INFINITY) ? 0.f : mn;
        const float corr = __builtin_amdgcn_exp2f(m - ms);
        m = mn; l *= corr;
#pragma unroll
        for (int db = 0; db < NDB; ++db) O[db] = O[db] * corr;
    }
    const float ms = (m == -INFINITY) ? 0.f : m;
    float ls = 0.f;
#pragma unroll
    for (int i = 0; i < 16; ++i) { p0[i] = __builtin_amdgcn_exp2f(fmaf(p0[i], c, -ms)); p1[i] = __builtin_amdgcn_exp2f(fmaf(p1[i], c, -ms)); ls += p0[i] + p1[i]; }
    l += ls;
    pf[0] = pack8(p0, 0); pf[1] = pack8(p0, 1); pf[2] = pack8(p1, 0); pf[3] = pack8(p1, 1);
}
struct L128 { static constexpr int PITCH = 128; static ATT_DI int addr(int row, int byte) { return row * 128 + ((((byte >> 4) ^ ((row >> 1) & 7)) << 4) | (byte & 15)); } };
constexpr int DSLOT = 8192 + 16384;
ATT_DI void diff_pass(ATT_LAS char* lds, const bf16_t* P_, int b, int hd, int qb, int mp, f32x16 (&O)[4], float& lsum, int variant = 0) {
    int tid_l = threadIdx.x; const bf16_t* P = P_; asm volatile("" : "+v"(tid_l), "+v"(P));
    const int tid = tid_l, lane = tid & 63, w = __builtin_amdgcn_readfirstlane(tid >> 6), r = lane & 31, h = lane >> 5, g1 = (lane >> 4) & 1, tq = (lane & 15) >> 2, tp = lane & 3;
    const int q0 = qb * 256, NT = 4 * (qb + 1);
    const int qpos = q0 + w * 32 + r; const size_t tok = (size_t)b * SEQ + qpos;
    const int qmax_w = q0 + w * 32 + 31, qmin_w = q0 + w * 32;
    const float c = LOG2E * 0.125f;
    unsigned soff[3];
    { const int row = 8 * w + (lane >> 3), chunk = (lane & 7) ^ ((row >> 1) & 7); soff[0] = (unsigned)(row * 3072 + 2048 + hd * 128 + mp * 64 + chunk * 8); }
#pragma unroll
    for (int j = 0; j < 2; ++j) { const int row = 8 * w + 4 * j + (lane >> 4), chunk = (lane & 15) ^ ((row & 3) << 2); soff[1 + j] = (unsigned)(row * 3072 + 2560 + hd * 128 + chunk * 8); }
    const bf16_t* gbase = P + (size_t)b * SEQ * 3072;
#define DIFF_DMA(kt_, slot_) do { const bf16_t* gb_ = gbase + (size_t)(kt_) * 64 * 3072; ATT_LAS char* sl_ = lds + (slot_) * DSLOT; \
        dma16(gb_ + soff[0], sl_ + w * 1024); dma16(gb_ + soff[1], sl_ + 8192 + w * 2048); dma16(gb_ + soff[2], sl_ + 8192 + w * 2048 + 1024); } while (0)
    bf16x8 qf[4]; load_q<4>(qf, P + tok * 3072 + 1536 + hd * 128 + mp * 64, h);
    float m = -INFINITY, l = 0.f;
#pragma unroll
    for (int db = 0; db < 4; ++db)
#pragma unroll
        for (int i = 0; i < 16; ++i) O[db][i] = 0.f;
    asm volatile("s_waitcnt vmcnt(0) lgkmcnt(0)" ::: "memory");
    __builtin_amdgcn_s_barrier();
    asm volatile("" ::: "memory");
    DIFF_DMA(0, 0); DIFF_DMA(1, 1);
    int slot = 0;
#pragma unroll 1
    for (int kt = 0; kt < NT; kt += 2) {
        asm volatile("s_waitcnt vmcnt(0) lgkmcnt(0)" ::: "memory");
        __builtin_amdgcn_s_barrier();
        asm volatile("" ::: "memory");
        if (kt + 2 < NT) { DIFF_DMA(kt + 2, slot ^ 2); DIFF_DMA(kt + 3, (slot ^ 2) + 1); }
        const ATT_LAS char* kA = lds + slot * DSLOT; const ATT_LAS char* vA = kA + 8192; const ATT_LAS char* kB = kA + DSLOT; const ATT_LAS char* vB = kB + 8192;
        if (kt * 64 <= qmax_w) {
            int lr = lane; asm volatile("" : "+v"(lr));
            const int r2 = lr & 31, h2 = lr >> 5, g2 = (lr >> 4) & 1, tq2 = (lr & 15) >> 2, tp2 = lr & 3;
            const bool doB = (kt * 64 + 64 <= qmax_w);
            f32x16 a0, a1, b0, b1; bf16x8 pf[4];
            if (variant & 16) {
#pragma unroll
                for (int i = 0; i < 16; ++i) { a0[i] = 0.f; a1[i] = 0.f; b0[i] = 0.f; b1[i] = 0.f; }
            } else {
            st_qk<4, L128>(kA, 0, qf, a0, a1, r2, h2, kt * 64 + 63 > qmin_w, qpos, kt * 64, 1 << 30);
            if (doB) st_qk<4, L128>(kB, 0, qf, b0, b1, r2, h2, kt * 64 + 127 > qmin_w, qpos, kt * 64 + 64, 1 << 30); }
            if (variant & 8) { pf[0] = pack8(a0, 0); pf[1] = pack8(a0, 1); pf[2] = pack8(a1, 0); pf[3] = pack8(a1, 1); l += a0[0]; } else st_soft<4>(a0, a1, m, l, O, pf, c);
            if (!(variant & 4)) st_pv<4, LV256>(vA, pf, O, h2, g2, tq2, tp2);
            if (doB) { if (variant & 8) { pf[0] = pack8(b0, 0); pf[1] = pack8(b0, 1); pf[2] = pack8(b1, 0); pf[3] = pack8(b1, 1); l += b0[0]; } else st_soft<4>(b0, b1, m, l, O, pf, c);
                       if (!(variant & 4)) st_pv<4, LV256>(vB, pf, O, h2, g2, tq2, tp2); }
        }
        slot ^= 2;
    }
#undef DIFF_DMA
    lsum = l + __shfl_xor(l, 32);
}
ATT_DI void diff_unit(ATT_LAS char* lds, const bf16_t* P  , const float* subln, float lam, bf16_t* Y, float* park_  , int b, int hd, int qb, int variant = 0) {
    f32x16 O0[4], O1[4]; float l0, l1;
    diff_pass(lds, P, b, hd, qb, 0, O0, l0, variant);
    { int t2 = threadIdx.x; float* park = park_; asm volatile("" : "+v"(t2), "+v"(park));
      const size_t tok = (size_t)b * SEQ + qb * 256 + (t2 >> 6) * 32 + (t2 & 31);
      f32x4* pk = (f32x4*)(park + ((tok * 4 + hd) * 2 + ((t2 >> 5) & 1)) * 64);
      const float i0 = 1.0f / l0;
#pragma unroll
      for (int db = 0; db < 4; ++db)
#pragma unroll
          for (int g = 0; g < 4; ++g) pk[db * 4 + g] = (f32x4){O0[db][4 * g] * i0, O0[db][4 * g + 1] * i0, O0[db][4 * g + 2] * i0, O0[db][4 * g + 3] * i0}; }
    diff_pass(lds, P, b, hd, qb, 1, O1, l1, variant);
    int t3 = threadIdx.x; float* park = park_; asm volatile("" : "+v"(t3), "+v"(park));
    const int h = (t3 >> 5) & 1;
    const size_t tok = (size_t)b * SEQ + qb * 256 + (t3 >> 6) * 32 + (t3 & 31);
    { const f32x4* pk = (const f32x4*)(park + ((tok * 4 + hd) * 2 + h) * 64);
#pragma unroll
      for (int db = 0; db < 4; ++db)
#pragma unroll
          for (int g = 0; g < 4; ++g) { const f32x4 v = pk[db * 4 + g]; O0[db][4 * g] = v.x; O0[db][4 * g + 1] = v.y; O0[db][4 * g + 2] = v.z; O0[db][4 * g + 3] = v.w; } }
    const float i1 = lam / l1;
    float ss = 0.f;
#pragma unroll
    for (int db = 0; db < 4; ++db)
#pragma unroll
        for (int i = 0; i < 16; ++i) { const float o = O0[db][i] - O1[db][i] * i1; O0[db][i] = o; ss += o * o; }
    ss += __shfl_xor(ss, 32);
    const float rs = 0.8f / sqrtf(ss * (1.0f / 128.0f) + EPS);
    bf16_t* orow = Y + tok * 1024 + 512 + hd * 128;
#pragma unroll
    for (int db = 0; db < 4; ++db)
#pragma unroll
        for (int g = 0; g < 4; ++g) { const int d = db * 32 + 8 * g + 4 * h; const f32x4 gg = *(const f32x4*)(subln + d);
            const unsigned w0 = cvtpk(O0[db][4 * g] * rs * gg.x, O0[db][4 * g + 1] * rs * gg.y), w1 = cvtpk(O0[db][4 * g + 2] * rs * gg.z, O0[db][4 * g + 3] * rs * gg.w);
            *(unsigned long long*)(orow + d) = (unsigned long long)w0 | ((unsigned long long)w1 << 32); }
}
ATT_DI void conv_tokens(const bf16_t* P_, const float* convw, bf16_t* Y_, int tok0  ) {
    int tid_l = threadIdx.x; const bf16_t* P = P_; bf16_t* Y = Y_; asm volatile("" : "+v"(tid_l), "+v"(P), "+v"(Y));
    const int tid = tid_l, cg = tid & 63, run = tid >> 6, c0 = cg * 8;
    float w[3][8];
#pragma unroll
    for (int j = 0; j < 3; ++j) { const f32x4 a = *(const f32x4*)(convw + j * 512 + c0), b2 = *(const f32x4*)(convw + j * 512 + c0 + 4);
        w[j][0] = a.x; w[j][1] = a.y; w[j][2] = a.z; w[j][3] = a.w; w[j][4] = b2.x; w[j][5] = b2.y; w[j][6] = b2.z; w[j][7] = b2.w; }
    const int tfirst = tok0 + run * 16;
    float z1[8], z2[8];
#pragma unroll
    for (int i = 0; i < 8; ++i) { z1[i] = 0.f; z2[i] = 0.f; }
#pragma unroll 1
    for (int tt = -2; tt < 16; ++tt) {
        const int tok = tfirst + tt;
        float z0[8];
        const bool inseq = ((tfirst & (SEQ - 1)) + tt) >= 0;
        if (inseq) { const bf16_t* pr = P + (size_t)tok * 3072; const u32x4 gc = *(const u32x4*)(pr + 512 + c0), uu = *(const u32x4*)(pr + 1024 + c0);
            z0[0] = bflo(gc.x) * bflo(uu.x); z0[1] = bfhi(gc.x) * bfhi(uu.x); z0[2] = bflo(gc.y) * bflo(uu.y); z0[3] = bfhi(gc.y) * bfhi(uu.y);
            z0[4] = bflo(gc.z) * bflo(uu.z); z0[5] = bfhi(gc.z) * bfhi(uu.z); z0[6] = bflo(gc.w) * bflo(uu.w); z0[7] = bfhi(gc.w) * bfhi(uu.w); }
        else {
#pragma unroll
            for (int i = 0; i < 8; ++i) z0[i] = 0.f; }
        if (tt >= 0) { const u32x4 gb = *(const u32x4*)(P + (size_t)tok * 3072 + c0); float y[8];
            const float gbf[8] = {bflo(gb.x), bfhi(gb.x), bflo(gb.y), bfhi(gb.y), bflo(gb.z), bfhi(gb.z), bflo(gb.w), bfhi(gb.w)};
#pragma unroll
            for (int i = 0; i < 8; ++i) y[i] = gbf[i] * (w[0][i] * z2[i] + w[1][i] * z1[i] + w[2][i] * z0[i]);
            u32x4 o; o.x = pk2(y[0], y[1]); o.y = pk2(y[2], y[3]); o.z = pk2(y[4], y[5]); o.w = pk2(y[6], y[7]);
            *(u32x4*)(Y + (size_t)tok * 1024 + c0) = o; }
#pragma unroll
        for (int i = 0; i < 8; ++i) { z2[i] = z1[i]; z1[i] = z0[i]; }
    }
}
}
#ifndef MK_P2_VARIANT
#define MK_P2_VARIANT 0
#endif

#define LAS __attribute__((address_space(3)))
constexpr int LDS_BYTES = 147456, LDSCTL_OFF = 131072;
constexpr int LC_MISC = 0, LC_HIST = 64, LC_LBASE = 128, LC_RSV = 192, LC_SLOTS = 256, LC_JOBS_BYTE = 4096;
constexpr int CW_BAR = 4096;
constexpr size_t WS_WRT = 9 * MiB;

#define XB_TMO      128
#define XB_XCNT(j)  (256  + 64 * (j))
#define XB_XSUB(j)  (1280 + 64 * (j))
#define XB_XGEN(j)  (2304 + 64 * (j))
#define XB_TOP      3328
#define XB_TOPGEN   3392
#define XCD_BAR_WORDS 3456
#define XB_SPIN_CAP (1u << 18)
__device__ __forceinline__ unsigned xb_ld(unsigned* p)              { return __hip_atomic_load(p, __ATOMIC_RELAXED, __HIP_MEMORY_SCOPE_AGENT); }
__device__ __forceinline__ unsigned xb_add(unsigned* p, unsigned v) { return __hip_atomic_fetch_add(p, v, __ATOMIC_RELAXED, __HIP_MEMORY_SCOPE_AGENT); }
__device__ __forceinline__ unsigned xb_xcc_id() { return (unsigned)__builtin_amdgcn_s_getreg((3 << 11) | 20) & 0xFu; }
#define XB_SPIN(cond, bar) do { unsigned _sp = 0; while (cond) { __builtin_amdgcn_s_sleep(1); \
    if ((++_sp & 255u) == 0u) { if (xb_ld(&(bar)[XB_TMO])) break; if (_sp > XB_SPIN_CAP) { atomicAdd(&(bar)[XB_TMO], 1u); break; } } } } while (0)
struct XcdBarrier { unsigned* bar; unsigned x; volatile LAS unsigned* st; };
__device__ __forceinline__ XcdBarrier xcd_barrier_post(unsigned* bar, volatile LAS unsigned* st) {
    XcdBarrier b; b.bar = bar; b.x = xb_xcc_id(); b.st = st;
    if (threadIdx.x == 0) (void)xb_add(&bar[XB_XCNT(b.x)], 1u);
    return b;
}
__device__ __forceinline__ void xcd_barrier_complete(unsigned* bar, unsigned x, unsigned& nloc, unsigned& nx) {
    const unsigned G = gridDim.x * gridDim.y * gridDim.z;
    unsigned sum, cnt, mine, sp = 0u;
    for (;;) {
        sum = 0u; cnt = 0u; mine = 0u;
#pragma unroll
        for (unsigned j = 0; j < 16; ++j) { const unsigned c = xb_ld(&bar[XB_XCNT(j)]); sum += c; cnt += (c > 0u) ? 1u : 0u; mine = (j == x) ? c : mine; }
        if (sum == G) break;
        __builtin_amdgcn_s_sleep(1);
        if ((++sp & 255u) == 0u) { if (xb_ld(&bar[XB_TMO])) break; if (sp > XB_SPIN_CAP) { atomicAdd(&bar[XB_TMO], 1u); break; } }
    }
    nloc = mine > 0u ? mine : 1u; nx = cnt > 0u ? cnt : 1u;
}
__device__ __forceinline__ void xcd_barrier(const XcdBarrier& b) {
    asm volatile("s_waitcnt vmcnt(0)" ::: "memory");
    __syncthreads();
    if (threadIdx.x == 0) {
        unsigned* bar = b.bar;
        __builtin_amdgcn_s_waitcnt(0);
        unsigned nloc = b.st[0], nx = b.st[1];
        if (nloc == 0u) { xcd_barrier_complete(bar, b.x, nloc, nx); b.st[0] = nloc; b.st[1] = nx; }
        const unsigned old = xb_add(&bar[XB_XSUB(b.x)], 1u);
        const unsigned gen = old / nloc;
        if (old + 1u == (gen + 1u) * nloc) {
            __builtin_amdgcn_fence(__ATOMIC_RELEASE, "agent");
            asm volatile("s_waitcnt vmcnt(0)" ::: "memory");
            const unsigned og = xb_add(&bar[XB_TOP], 1u);
            const unsigned tg = og / nx;
            if (og + 1u == (tg + 1u) * nx) xb_add(&bar[XB_TOPGEN], 1u);
            else XB_SPIN(xb_ld(&bar[XB_TOPGEN]) == tg, bar);
            __builtin_amdgcn_fence(__ATOMIC_ACQUIRE, "agent");
            xb_add(&bar[XB_XGEN(b.x)], 1u);
            asm volatile("s_waitcnt vmcnt(0)" ::: "memory");
        } else {
            XB_SPIN(xb_ld(&bar[XB_XGEN(b.x)]) == gen, bar);
            __builtin_amdgcn_fence(__ATOMIC_ACQUIRE, "agent");
            asm volatile("s_waitcnt vmcnt(0)" ::: "memory");
        }
    }
    __syncthreads();
}

struct WJob { const float* src; bf16_t* dst; const float* gain; int K, N, ipm, first, nitems, perm; };
__device__ __forceinline__ void wt_item(const float* W, int K, int N, const float* gain, bf16_t* WT, int perm, LAS float* scr, int item, int lane) {
    const int nblk = N / 32, kb = item / nblk, nb = item % nblk, k0 = 64 * kb, n0 = 32 * nb;
    const int lr = lane >> 3, lc = (lane & 7) * 4;
    f32x4 v[8];
#pragma unroll
    for (int i = 0; i < 8; ++i) v[i] = *(const f32x4*)(W + (size_t)(k0 + 8 * i + lr) * N + n0 + lc);
    const int c = lane & 7;
    f32x4 g0 = (f32x4){1.f, 1.f, 1.f, 1.f}, g1 = g0;
    if (gain) { g0 = *(const f32x4*)(gain + k0 + 8 * c); g1 = *(const f32x4*)(gain + k0 + 8 * c + 4); }
#pragma unroll
    for (int i = 0; i < 8; ++i) { LAS float* d = scr + (8 * i + lr) * 33 + lc; d[0] = v[i].x; d[1] = v[i].y; d[2] = v[i].z; d[3] = v[i].w; }
    asm volatile("s_waitcnt lgkmcnt(0)" ::: "memory");
#pragma unroll
    for (int j = 0; j < 4; ++j) { const int n = (lane >> 3) + 8 * j; const LAS float* s = scr + (8 * c) * 33 + n;
        u32x4 o; o.x = pk2(s[0 * 33] * g0.x, s[1 * 33] * g0.y); o.y = pk2(s[2 * 33] * g0.z, s[3 * 33] * g0.w); o.z = pk2(s[4 * 33] * g1.x, s[5 * 33] * g1.y); o.w = pk2(s[6 * 33] * g1.z, s[7 * 33] * g1.w);
        const int ns = n0 + n; int nd = ns;
        if (perm) { const int half = ns >> 9, jj = ns & 511; nd = (jj >> 7) * 256 + half * 128 + (jj & 127); }
        *(u32x4*)(WT + (size_t)nd * K + k0 + 8 * c) = o; }
    asm volatile("s_waitcnt lgkmcnt(0)" ::: "memory");
}
__device__ __forceinline__ void rowprep_rows(const float* x, bf16_t* xb, float* ssq, int rows, int gw, int ngw, int lane) {
    for (int row = gw; row < rows; row += ngw) {
        const f32x4* xr = (const f32x4*)(x + (size_t)row * DM) + lane; float s = 0.f;
        unsigned long long* o8 = (unsigned long long*)(xb + (size_t)row * DM) + lane;
#pragma unroll
        for (int jx = 0; jx < 4; ++jx) { const f32x4 v = xr[64 * jx]; s += (v.x * v.x + v.y * v.y) + (v.z * v.z + v.w * v.w);
            o8[64 * jx] = (unsigned long long)pk2(v.x, v.y) | ((unsigned long long)pk2(v.z, v.w) << 32); }
        s = wave_sum(s);
        if (lane < 16) ssq[(size_t)row * 16 + lane] = (lane == 0) ? s : 0.f;
    }
}
__device__ __forceinline__ void sincos_d(double a, float& c, float& s) {
    const double TWO_PI = 6.283185307179586476925286766559;
    const double n = __builtin_rint(a / TWO_PI); const double r = a - n * TWO_PI;
    const double r2 = r * r;
    double sp = 1.0, cp = 1.0;
#pragma unroll
    for (int k = 15; k >= 1; --k) { sp = 1.0 - r2 / (double)((2 * k) * (2 * k + 1)) * sp; cp = 1.0 - r2 / (double)((2 * k - 1) * (2 * k)) * cp; }
    s = (float)(r * sp); c = (float)cp;
}

typedef float f32x16r __attribute__((ext_vector_type(16)));
typedef short bf16x8r __attribute__((ext_vector_type(8)));
__device__ __forceinline__ void route_group(const bf16_t* xb, const float* ssq, const bf16_t* WRh  , const float* bg, const float* br, int tok0, LAS float* S  , LAS int* hist,
                                            int* route_e, float* route_w, float* rs_tok, int lane) {
    const int r = lane & 31, kk = lane >> 5;
    f32x16r a0, a1;
#pragma unroll
    for (int i = 0; i < 16; ++i) { a0[i] = 0.f; a1[i] = 0.f; }
    const bf16x8r* xa = (const bf16x8r*)(xb + (size_t)(tok0 + r) * DM + 8 * kk);
    const bf16x8r* h0 = (const bf16x8r*)(WRh + (size_t)r * DM + 8 * kk);
    const bf16x8r* h1 = (const bf16x8r*)(WRh + (size_t)(32 + r) * DM + 8 * kk);
    const bf16x8r* l0 = (const bf16x8r*)(WRh + (size_t)(64 + r) * DM + 8 * kk);
    const bf16x8r* l1 = (const bf16x8r*)(WRh + (size_t)(96 + r) * DM + 8 * kk);
#pragma unroll 4
    for (int s = 0; s < 64; ++s) {
        const bf16x8r av = xa[2 * s], bh0 = h0[2 * s], bh1 = h1[2 * s], bl0 = l0[2 * s], bl1 = l1[2 * s];
        a0 = __builtin_amdgcn_mfma_f32_32x32x16_bf16(av, bh0, a0, 0, 0, 0); a1 = __builtin_amdgcn_mfma_f32_32x32x16_bf16(av, bh1, a1, 0, 0, 0);
        a0 = __builtin_amdgcn_mfma_f32_32x32x16_bf16(av, bl0, a0, 0, 0, 0); a1 = __builtin_amdgcn_mfma_f32_32x32x16_bf16(av, bl1, a1, 0, 0, 0);
    }
#pragma unroll
    for (int i = 0; i < 16; ++i) { const int trow = (i & 3) + 8 * (i >> 2) + 4 * kk; S[trow * 68 + r] = a0[i]; if (r < 4) S[trow * 68 + 32 + r] = a1[i]; }
    asm volatile("s_waitcnt lgkmcnt(0)" ::: "memory");
    if (lane < 32) {
        const int tok = tok0 + lane; const LAS float* sr = S + lane * 68;
        const float rs = row_rs(ssq, tok);
        float lg[4];
#pragma unroll
        for (int g = 0; g < 4; ++g) lg[g] = sr[g] * rs + bg[g];
        int gs = 0; float gm = lg[0];
#pragma unroll
        for (int g = 1; g < 4; ++g) if (lg[g] > gm) { gm = lg[g]; gs = g; }
        float gsum = 0.f;
#pragma unroll
        for (int g = 0; g < 4; ++g) gsum += expf(lg[g] - gm);
        const float p_g = 1.0f / gsum;
        float le[8];
#pragma unroll
        for (int e = 0; e < 8; ++e) le[e] = sr[4 + gs * 8 + e] * rs + br[gs * 8 + e];
        int i1 = 0; float m1 = le[0];
#pragma unroll
        for (int e = 1; e < 8; ++e) if (le[e] > m1) { m1 = le[e]; i1 = e; }
        int i2 = -1; float m2 = -INFINITY;
#pragma unroll
        for (int e = 0; e < 8; ++e) if (e != i1 && le[e] > m2) { m2 = le[e]; i2 = e; }
        const float e2 = expf(m2 - m1); const float w1v = p_g / (1.0f + e2), w2v = p_g * e2 / (1.0f + e2);
        const int ex1 = gs * 8 + i1, ex2 = gs * 8 + i2;
        route_e[tok * 2] = ex1; route_e[tok * 2 + 1] = ex2; route_w[tok * 2] = w1v; route_w[tok * 2 + 1] = w2v; rs_tok[tok] = rs;
        __hip_atomic_fetch_add(hist + ex1, 1, __ATOMIC_RELAXED, __HIP_MEMORY_SCOPE_WORKGROUP);
        __hip_atomic_fetch_add(hist + 32 + ex2, 1, __ATOMIC_RELAXED, __HIP_MEMORY_SCOPE_WORKGROUP);
    }
    asm volatile("s_waitcnt lgkmcnt(0)" ::: "memory");
}

#define PHASE_PTRS \
    unsigned char* ws = args.ws; int z_ = 0; int tid = threadIdx.x; asm volatile("" : "+s"(ws), "+s"(z_), "+v"(tid)); \
    const int lane = tid & 63, wave = __builtin_amdgcn_readfirstlane(tid >> 6), gw = bx * 8 + wave; (void)lane; (void)gw; \
    const float* x = args.in[0 + z_]; const float* mem = args.in[1 + z_]; const float* mem_norm = args.in[2 + z_]; const float* mem_w_kv = args.in[3 + z_]; \
    const float* norm_mix = args.in[4 + z_]; const float* norm_xattn = args.in[5 + z_]; const float* norm_ffn = args.in[6 + z_]; \
    const float* hyb_w_in = args.in[7 + z_]; const float* hyb_conv_w = args.in[8 + z_]; const float* diff_lambda = args.in[9 + z_]; const float* diff_subln = args.in[10 + z_]; \
    const float* hyb_w_out = args.in[11 + z_]; const float* swa_w_qkv = args.in[12 + z_]; const float* swa_b_qkv = args.in[13 + z_]; const float* swa_sinks = args.in[14 + z_]; \
    const float* swa_w_out = args.in[15 + z_]; const float* swa_b_out = args.in[16 + z_]; const float* xattn_w_q = args.in[17 + z_]; const float* xattn_w_o = args.in[18 + z_]; \
    const float* moe_w_group = args.in[19 + z_]; const float* moe_b_group = args.in[20 + z_]; const float* moe_w_router = args.in[21 + z_]; const float* moe_b_router = args.in[22 + z_]; \
    const float* moe_w_gate_up = args.in[23 + z_]; const float* moe_w_down = args.in[24 + z_]; const float* final_norm = args.in[25 + z_]; \
    float* ropeC = (float*)(ws + WS_ROPEC); float* ropeS = (float*)(ws + WS_ROPES); bf16_t* WRt = (bf16_t*)(ws + WS_WRT); float* lam = (float*)(ws + WS_LAM); \
    float* ssq = (float*)(ws + WS_SSQ); float* ssqm = (float*)(ws + WS_SSQM); \
    int* tok_of_slot = (int*)(ws + WS_TOKSLOT); float* w_of_slot = (float*)(ws + WS_WSLOT); float* rs_of_slot = (float*)(ws + WS_RSSLOT); \
    int* route_e = (int*)(ws + WS_ROUTE_E); float* route_w = (float*)(ws + WS_ROUTE_W); float* rs_tok = (float*)(ws + WS_RSTOK); \
    bf16_t* memb = (bf16_t*)(ws + WS_MEMB); bf16_t* mkv = (bf16_t*)(ws + WS_MKV); \
    bf16_t* Wmem = (bf16_t*)(ws + WS_WMEM); bf16_t* Win = (bf16_t*)(ws + WS_WIN); bf16_t* Wout0 = (bf16_t*)(ws + WS_WOUT0); bf16_t* Wqkv = (bf16_t*)(ws + WS_WQKV); bf16_t* Wout1 = (bf16_t*)(ws + WS_WOUT1); \
    bf16_t* Wq = (bf16_t*)(ws + WS_WQ); bf16_t* Wo = (bf16_t*)(ws + WS_WO); bf16_t* Wgu = (bf16_t*)(ws + WS_WGU); bf16_t* Wdn = (bf16_t*)(ws + WS_WDN); \
    float* XA = (float*)(ws + WS_XA); bf16_t* XBF = (bf16_t*)(ws + WS_XBF); bf16_t* Y = (bf16_t*)(ws + WS_Y); bf16_t* QX = (bf16_t*)(ws + WS_QX); bf16_t* OX = (bf16_t*)(ws + WS_OX); \
    bf16_t* P = (bf16_t*)(ws + WS_U1); bf16_t* XS = (bf16_t*)(ws + WS_U1); float* PARK = (float*)(ws + WS_U2); bf16_t* HID = (bf16_t*)(ws + WS_U2); \
    (void)0

struct MegaArgs { const float* in[26]; float* out; unsigned char* ws; double inv[8]; int ph_lo, ph_hi, probe_phase, probe_reps; };
constexpr int N_PHASES = 24;
__global__ void __launch_bounds__(512, 2) mega_fwd(MegaArgs args) {
    extern __shared__ __attribute__((aligned(16))) unsigned char lds_raw[];
    LAS unsigned char* lds = (LAS unsigned char*)lds_raw;
    LAS int* LC = (LAS int*)(lds + LDSCTL_OFF);
    const int G = (int)gridDim.x, bx = (int)blockIdx.x, ngw = G * 8;
    int* ctl = (int*)(args.ws + WS_CTL);
    for (int u = threadIdx.x; u < 1024; u += 512) LC[u] = 0;
    __syncthreads();
    const int lo = args.ph_lo, hi = args.ph_hi;
    const bool multi = (hi - lo) > 1;
    XcdBarrier bar; bar.bar = (unsigned*)(ctl + CW_BAR); bar.x = 0; bar.st = nullptr;
    if (multi) bar = xcd_barrier_post((unsigned*)(ctl + CW_BAR), (volatile LAS unsigned*)(LC + LC_MISC + 8));
#define IN(k) (lo <= (k) && (k) < hi)
#define REPS(k) (((k) == args.probe_phase) ? 1 + args.probe_reps : 1)
#define BAR(k) do { if (IN(k) && IN((k) + 1)) xcd_barrier(bar); } while (0)

    if (IN(0)) for (int rep_ = 0; rep_ < REPS(0); ++rep_) { PHASE_PTRS; const bool dry = rep_ > 0; (void)dry;
        LAS unsigned long long* jp = (LAS unsigned long long*)(lds + LDSCTL_OFF + LC_JOBS_BYTE);
        LAS int* ji = (LAS int*)(lds + LDSCTL_OFF + LC_JOBS_BYTE + 1024);
        if (tid == 0) {
            int first = 0, nj = 0;
#define ADDJOB(SRC, DST, GAIN, KK, NN, NB, PERM) do { jp[3 * nj] = (unsigned long long)(uintptr_t)(SRC); jp[3 * nj + 1] = (unsigned long long)(uintptr_t)(DST); jp[3 * nj + 2] = (unsigned long long)(uintptr_t)(GAIN); \
            const int ipm_ = ((KK) / 64) * ((NN) / 32); ji[8 * nj] = (KK); ji[8 * nj + 1] = (NN); ji[8 * nj + 2] = ipm_; ji[8 * nj + 3] = first; ji[8 * nj + 4] = ipm_ * (NB); ji[8 * nj + 5] = (PERM); first += ipm_ * (NB); ++nj; } while (0)
            ADDJOB(moe_w_gate_up, Wgu, norm_ffn, 1024, 1024, 32, 1);
            ADDJOB(moe_w_gate_up + (size_t)32 * 1024 * 1024, Wgu + (size_t)32 * 1024 * 1024, norm_ffn + 1024, 1024, 1024, 32, 1);
            ADDJOB(moe_w_down, Wdn, (const float*)nullptr, 512, 1024, 32, 0);
            ADDJOB(moe_w_down + (size_t)32 * 512 * 1024, Wdn + (size_t)32 * 512 * 1024, (const float*)nullptr, 512, 1024, 32, 0);
            ADDJOB(mem_w_kv, Wmem, mem_norm, 1024, 1024, 1, 0);
            ADDJOB(hyb_w_in, Win, norm_mix, 1024, 3072, 1, 0);
            ADDJOB(hyb_w_out, Wout0, (const float*)nullptr, 1024, 1024, 1, 0);
            ADDJOB(swa_w_qkv, Wqkv, norm_mix + 1024, 1024, 1536, 1, 0);
            ADDJOB(swa_w_out, Wout1, (const float*)nullptr, 1024, 1024, 1, 0);
            ADDJOB(xattn_w_q, Wq, norm_xattn, 1024, 512, 1, 0);
            ADDJOB(xattn_w_q + (size_t)1024 * 512, Wq + (size_t)512 * 1024, norm_xattn + 1024, 1024, 512, 1, 0);
            ADDJOB(xattn_w_o, Wo, (const float*)nullptr, 512, 1024, 1, 0);
            ADDJOB(xattn_w_o + (size_t)512 * 1024, Wo + (size_t)1024 * 512, (const float*)nullptr, 512, 1024, 1, 0);
#undef ADDJOB
        }
        __syncthreads();
        LAS float* scr = (LAS float*)(lds + wave * 16384);
#pragma unroll 1
        for (int j = 0; j < 13; ++j) {
            const float* jsrc = (const float*)(uintptr_t)jp[3 * j]; bf16_t* jdst = (bf16_t*)(uintptr_t)jp[3 * j + 1]; const float* jgain = (const float*)(uintptr_t)jp[3 * j + 2];
            const int jK = ji[8 * j], jN = ji[8 * j + 1], jipm = ji[8 * j + 2], jfirst = ji[8 * j + 3], jn = ji[8 * j + 4], jperm = ji[8 * j + 5];
            int loc = (gw - jfirst) % ngw; if (loc < 0) loc += ngw;
            for (; loc < jn; loc += ngw) { const int bidx = loc / jipm, item = loc - bidx * jipm; const size_t mo = (size_t)bidx * jK * jN;
                wt_item(jsrc + mo, jK, jN, jgain, jdst + mo, jperm, scr, item, lane); }
        }
        { const int gid = bx * 512 + tid, nth = G * 512;
          for (int i = gid; i < SEQ * 8; i += nth) { const int pos = i >> 3, jx = i & 7; float c, s; sincos_d((double)pos * args.inv[jx], c, s); ropeC[i] = c; ropeS[i] = s; }
          for (int i = gid; i < 2 * 64 * 1024; i += nth) { const int l = i >> 16, c = (i >> 10) & 63, k = i & 1023; const float g = norm_ffn[l * 1024 + k];
              const float wv = (c < 4) ? g * moe_w_group[(size_t)(l * 1024 + k) * 4 + c] : (c < 36) ? g * moe_w_router[(size_t)(l * 1024 + k) * 32 + (c - 4)] : 0.f;
              const unsigned hb = f2bf(wv); const float rem = wv - bf2f((bf16_t)hb);
              WRt[(size_t)l * 2 * 65536 + (i & 65535)] = (bf16_t)hb; WRt[(size_t)l * 2 * 65536 + 65536 + (i & 65535)] = (bf16_t)f2bf(rem); }
          if (gid == 0) { float s01 = 0.f, s23 = 0.f; for (int d = 0; d < 64; ++d) { s01 += diff_lambda[d] * diff_lambda[64 + d]; s23 += diff_lambda[128 + d] * diff_lambda[192 + d]; }
              lam[0] = expf(s01) - expf(s23) + 0.2f; } }
        rowprep_rows(x, XBF, ssq, T_TOK, gw, ngw, lane);
        rowprep_rows(mem, memb, ssqm, TMEM, gw, ngw, lane);
    }
    BAR(0);
    if (IN(1)) for (int rep_ = 0; rep_ < REPS(1); ++rep_) { PHASE_PTRS; const bool dry = rep_ > 0; (void)dry;
        { pg8::Gemm g{memb, Wmem, TMEM, 1024, 1024, 0}; pg8::StaticOrder S; S.init(TMEM, 1024, G, (bx + 64) % G);
          EpiProj E; E.O = mkv; E.ssq = ssqm; E.bias = nullptr; E.ropeC = ropeC; E.ropeS = ropeS; E.ldc = 1024; E.rope_lo = 0; E.rope_hi = 0; E.pad = 0;
          pg8::gemm_phase<EpiProj, pg8::StaticOrder, true, true>(lds, g, S, E); }
        __syncthreads();
        { pg8::Gemm g{XBF, Win, T_TOK, 3072, 1024, 0}; pg8::StaticOrder S; S.init(T_TOK, 3072, G, bx);
          EpiProj E; E.O = P; E.ssq = ssq; E.bias = nullptr; E.ropeC = ropeC; E.ropeS = ropeS; E.ldc = 3072; E.rope_lo = 1536; E.rope_hi = 2560; E.pad = 0;
          pg8::gemm_phase<EpiProj, pg8::StaticOrder, true, true>(lds, g, S, E); }
    }
    BAR(1);
    if (IN(2)) for (int rep_ = 0; rep_ < REPS(2); ++rep_) { PHASE_PTRS; const bool dry = rep_ > 0; (void)dry;
        const float lamv = lam[0];
        for (int cu = bx; cu < 256; cu += G) {
            const int bh = cu >> 2, j = cu & 3;
            if (!(dry && (MK_P2_VARIANT & 1))) {
            att::diff_unit((ATT_LAS char*)lds, P, diff_subln, lamv, dry ? QX : Y, PARK, bh >> 2, bh & 3, 7 - j, dry ? (MK_P2_VARIANT & ~3) : 0);
            att::diff_unit((ATT_LAS char*)lds, P, diff_subln, lamv, dry ? QX : Y, PARK, bh >> 2, bh & 3, j, dry ? (MK_P2_VARIANT & ~3) : 0); }
            if (!(dry && (MK_P2_VARIANT & 2))) att::conv_tokens(P, hyb_conv_w, dry ? QX : Y, cu * 128);
        }
    }
    BAR(2);
    if (IN(3)) for (int rep_ = 0; rep_ < REPS(3); ++rep_) { PHASE_PTRS; const bool dry = rep_ > 0; (void)dry;
        pg8::Gemm g{Y, Wout0, T_TOK, 1024, 1024, 0}; pg8::StaticOrder S; S.init(T_TOK, 1024, G, bx);
        EpiResid E; E.xin = XBF; E.xout = XBF; E.ssq = ssq; E.bias = nullptr;
        pg8::gemm_phase<EpiResid, pg8::StaticOrder, true, true>(lds, g, S, E);
    }
    BAR(3);
#pragma unroll 1
    for (int l = 0; l < 2; ++l) {
        int* lctl = ctl + l * CI_STRIDE;
        if (l == 1) {
            if (IN(12)) for (int rep_ = 0; rep_ < REPS(12); ++rep_) { PHASE_PTRS; const bool dry = rep_ > 0; (void)dry;
                pg8::Gemm g{XBF, Wqkv, T_TOK, 1536, 1024, 0}; pg8::StaticOrder S; S.init(T_TOK, 1536, G, bx);
                EpiProj E; E.O = P; E.ssq = ssq; E.bias = (dry && (MK_P2_VARIANT & 32)) ? nullptr : swa_b_qkv; E.ropeC = ropeC; E.ropeS = ropeS; E.ldc = 1536; E.rope_lo = 0; E.rope_hi = (dry && (MK_P2_VARIANT & 32)) ? 0 : 1280; E.pad = 0;
                pg8::gemm_phase<EpiProj, pg8::StaticOrder, true, true>(lds, g, S, E);
            }
            BAR(12);
            if (IN(13)) for (int rep_ = 0; rep_ < REPS(13); ++rep_) { PHASE_PTRS; const bool dry = rep_ > 0; (void)dry; for (int u = bx; u < 512; u += G) att::swa_unit((ATT_LAS char*)lds, P, swa_sinks, Y, u); }
            BAR(13);
            if (IN(14)) for (int rep_ = 0; rep_ < REPS(14); ++rep_) { PHASE_PTRS; const bool dry = rep_ > 0; (void)dry;
                pg8::Gemm g{Y, Wout1, T_TOK, 1024, 1024, 0}; pg8::StaticOrder S; S.init(T_TOK, 1024, G, bx);
                EpiResid E; E.xin = XBF; E.xout = dry ? QX : XBF; E.ssq = dry ? (float*)(ws + WS_U1 + 160 * MiB) : ssq; E.bias = swa_b_out;
                pg8::gemm_phase<EpiResid, pg8::StaticOrder, true, true>(lds, g, S, E);
            }
            BAR(14);
        }
        const int cb = l ? 15 : 4;
        if (IN(cb)) for (int rep_ = 0; rep_ < REPS(cb); ++rep_) { PHASE_PTRS; const bool dry = rep_ > 0; (void)dry;
            pg8::Gemm g{XBF, Wq + (size_t)l * 512 * 1024, T_TOK, 512, 1024, 0}; pg8::StaticOrder S; S.init(T_TOK, 512, G, bx);
            EpiProj E; E.O = QX; E.ssq = ssq; E.bias = nullptr; E.ropeC = ropeC; E.ropeS = ropeS; E.ldc = 512; E.rope_lo = 0; E.rope_hi = 0; E.pad = 0;
            pg8::gemm_phase<EpiProj, pg8::StaticOrder, true, true>(lds, g, S, E);
        }
        BAR(cb);
        if (IN(cb + 1)) for (int rep_ = 0; rep_ < REPS(cb + 1); ++rep_) { PHASE_PTRS; const bool dry = rep_ > 0; (void)dry; for (int u = bx; u < 256; u += G) att::xattn_unit((ATT_LAS char*)lds, QX, mkv, OX, u); }
        BAR(cb + 1);
        if (IN(cb + 2)) for (int rep_ = 0; rep_ < REPS(cb + 2); ++rep_) { PHASE_PTRS; const bool dry = rep_ > 0; (void)dry;
            pg8::Gemm g{OX, Wo + (size_t)l * 1024 * 512, T_TOK, 1024, 512, 0}; pg8::StaticOrder S; S.init(T_TOK, 1024, G, bx);
            EpiResid E; E.xin = XBF; E.xout = dry ? Y : XBF; E.ssq = dry ? (float*)(ws + WS_U1 + 160 * MiB) : ssq; E.bias = nullptr;
            pg8::gemm_phase<EpiResid, pg8::StaticOrder, true, true>(lds, g, S, E);
        }
        BAR(cb + 2);
        if (IN(cb + 3)) for (int rep_ = 0; rep_ < REPS(cb + 3); ++rep_) { PHASE_PTRS; const bool dry = rep_ > 0; (void)dry;
            __syncthreads();
            if (tid < 64) LC[LC_HIST + tid] = 0;
            { int gl = G; asm volatile("" : "+s"(gl));
              for (int i = bx * 512 + tid; i < SPAD; i += gl * 512) tok_of_slot[i] = -1; }
            __syncthreads();
            for (int grp = wave * G + bx; grp < T_TOK / 32; grp += 8 * G)
                route_group(XBF, ssq, WRt + (size_t)l * 2 * 65536, moe_b_group + l * 4, moe_b_router + l * 32, grp * 32, (LAS float*)(lds + wave * 16384), LC + LC_HIST, route_e, route_w, rs_tok, lane);
            __syncthreads();
            if (tid < 64) { const int c = LC[LC_HIST + tid]; if (c > 0) atomicAdd((dry ? ctl + 2 * CI_STRIDE : lctl) + CI_CNT + tid, c); }
        }
        BAR(cb + 3);
        if (IN(cb + 4)) { PHASE_PTRS;
            __syncthreads();
            if (wave == 0) {
                const int cnt = lctl[CI_CNT + lane]; const int tiles = (cnt + 255) >> 8;
                int incl = tiles;
#pragma unroll
                for (int o = 1; o < 64; o <<= 1) { const int t = __shfl_up(incl, o); if (lane >= o) incl += t; }
                const int base = incl - tiles;
                LC[LC_LBASE + lane] = base * 256;
                if (bx == 0) {
                    for (int i = 0; i < tiles; ++i) lctl[CI_TEXP + base + i] = lane & 31;
                    if (lane == 31) lctl[CI_NT] = incl;
                    if (lane == 63) lctl[CI_NT + 1] = incl;
                }
            }
            for (int chunk = bx; chunk < T_TOK / 128; chunk += G) {
                __syncthreads();
                if (tid < 64) LC[LC_HIST + tid] = 0;
                __syncthreads();
                int L = 0, rank = 0; const int tokp = chunk * 128 + (tid >> 1), kq = tid & 1;
                if (tid < 256) { L = kq * 32 + route_e[tokp * 2 + kq]; rank = __hip_atomic_fetch_add(LC + LC_HIST + L, 1, __ATOMIC_RELAXED, __HIP_MEMORY_SCOPE_WORKGROUP); }
                __syncthreads();
                if (tid < 64) { const int c = LC[LC_HIST + tid]; LC[LC_RSV + tid] = (c > 0) ? atomicAdd(lctl + CI_CUR + tid, c) : 0; }
                __syncthreads();
                if (tid < 256) { const int slot = LC[LC_LBASE + L] + LC[LC_RSV + L] + rank;
                    tok_of_slot[slot] = tokp; w_of_slot[slot] = route_w[tokp * 2 + kq]; rs_of_slot[slot] = rs_tok[tokp]; }
            }
        }
        BAR(cb + 4);
        if (IN(cb + 5)) for (int rep_ = 0; rep_ < REPS(cb + 5); ++rep_) { PHASE_PTRS; const bool dry = rep_ > 0; (void)dry;
            pg8::Gemm g{XBF, Wgu + (size_t)l * 32 * 1024 * 1024, SPAD, 1024, 1024, 0};
            GroupedGather S; S.tile_expert = lctl + CI_TEXP; S.rows = tok_of_slot; S.nN = 4; S.G = G; S.c = bx; S.tiles_per_expert = 4; S.t_lo = 0; S.t_hi = lctl[CI_NT + 1];
            EpiGateUp E; E.hid = HID; E.rs_slot = rs_of_slot;
            pg8::gemm_phase<EpiGateUp, GroupedGather, true, true>(lds, g, S, E);
        }
        BAR(cb + 5);
#pragma unroll 1
        for (int pass = 0; pass < 2; ++pass) {
            if (IN(cb + 6 + pass)) for (int rep_ = 0; rep_ < REPS(cb + 6 + pass); ++rep_) { PHASE_PTRS; const bool dry = rep_ > 0; (void)dry;
                pg8::Gemm g{HID, Wdn + (size_t)l * 32 * 1024 * 512, SPAD, 1024, 512, 0};
                const int nt0 = lctl[CI_NT], nt1 = lctl[CI_NT + 1];
                GroupedOrder S; S.tile_expert = lctl + CI_TEXP; S.rows = nullptr; S.nN = 4; S.G = G; S.c = bx; S.tiles_per_expert = 4; S.t_lo = pass ? nt0 : 0; S.t_hi = pass ? nt1 : nt0;
                EpiDown E; E.xin = XBF; E.xout = dry ? Y : XBF; E.ssq = dry ? (float*)(ws + WS_U1 + 160 * MiB) : ssq; E.tok_of_slot = tok_of_slot; E.w_of_slot = w_of_slot; E.last = pass; E.pad = 0;
                pg8::gemm_phase<EpiDown, GroupedOrder, true, true>(lds, g, S, E);
            }
            BAR(cb + 6 + pass);
        }
    }
    if (IN(23)) for (int rep_ = 0; rep_ < REPS(23); ++rep_) { PHASE_PTRS; const bool dry = rep_ > 0; (void)dry;
        for (int row = gw; row < T_TOK; row += ngw) {
            const unsigned long long* xr = (const unsigned long long*)(XBF + (size_t)row * DM) + lane; f32x4 v[4]; float s = 0.f;
#pragma unroll
            for (int jx = 0; jx < 4; ++jx) { const unsigned long long q = xr[64 * jx]; const unsigned qa = (unsigned)q, qb = (unsigned)(q >> 32); v[jx] = (f32x4){bflo(qa), bfhi(qa), bflo(qb), bfhi(qb)};
                s += (v[jx].x * v[jx].x + v[jx].y * v[jx].y) + (v[jx].z * v[jx].z + v[jx].w * v[jx].w); }
            const float rs = 1.0f / sqrtf(wave_sum(s) * (1.0f / 1024.0f) + EPS);
            f32x4* orow = (f32x4*)(args.out + (size_t)row * DM) + lane; const f32x4* gr = (const f32x4*)final_norm + lane;
#pragma unroll
            for (int jx = 0; jx < 4; ++jx) orow[64 * jx] = v[jx] * rs * gr[64 * jx];
        }
    }
#undef IN
#undef BAR
}

#ifndef MK_PROBE_PHASE
#define MK_PROBE_PHASE (-1)
#define MK_PROBE_REPS 0
#endif
#ifndef MK_PER_PHASE
#define MK_PER_PHASE 0
#endif
extern "C" void kernel_launch(void* const* d_in, const int* in_sizes, int n_in, void* d_out, int out_size, void* d_ws, size_t ws_size, hipStream_t stream) {
    static int grid = 0;
    if (grid == 0) {
        if (n_in != 26 || ws_size < WS_END || out_size != T_TOK * DM) { fprintf(stderr, "kernel_launch: unexpected n_in %d / out %d / ws %zu\n", n_in, out_size, ws_size); grid = -1; return; }
        int dev = 0, cus = 0, per_cu = 0;
        if (hipGetDevice(&dev) != hipSuccess || hipDeviceGetAttribute(&cus, hipDeviceAttributeMultiprocessorCount, dev) != hipSuccess) { grid = -1; return; }
        if (hipFuncSetAttribute((const void*)mega_fwd, hipFuncAttributeMaxDynamicSharedMemorySize, LDS_BYTES) != hipSuccess) { fprintf(stderr, "kernel_launch: hipFuncSetAttribute failed\n"); grid = -1; return; }
        if (hipOccupancyMaxActiveBlocksPerMultiprocessor(&per_cu, (const void*)mega_fwd, 512, LDS_BYTES) != hipSuccess || per_cu < 1) { fprintf(stderr, "kernel_launch: occupancy query says %d\n", per_cu); per_cu = 1; }
        (void)hipGetLastError();
        grid = cus;
    }
    if (grid < 0) return;
    (void)hipMemsetAsync((char*)d_ws + WS_CTL, 0, CTL_ZERO_BYTES, stream);
    MegaArgs a{};
    for (int i = 0; i < 26; ++i) a.in[i] = (const float*)d_in[i];
    a.out = (float*)d_out; a.ws = (unsigned char*)d_ws;
    for (int jx = 0; jx < 8; ++jx) a.inv[jx] = pow(500000.0, -(double)(2 * jx) / 16.0);
#if MK_PER_PHASE
    a.probe_phase = MK_PROBE_PHASE; a.probe_reps = MK_PROBE_REPS;
    for (int ph = 0; ph < N_PHASES; ++ph) { a.ph_lo = ph; a.ph_hi = ph + 1; hipLaunchKernelGGL(mega_fwd, dim3(grid), dim3(512), LDS_BYTES, stream, a); }
#else
    a.ph_lo = 0; a.ph_hi = N_PHASES; a.probe_phase = MK_PROBE_PHASE; a.probe_reps = MK_PROBE_REPS;
    hipLaunchKernelGGL(mega_fwd, dim3(grid), dim3(512), LDS_BYTES, stream, a);
#endif
}
```
